# Optimizing an MI355X kernel written in HIP

```python
import math, functools
import jax, jax.numpy as jnp
from jax import lax
import numpy as np

D_MODEL = 1024
BATCH = 1
SEQ = 16384
DEPTH = 2
DEC_BATCH = 16
DEC_SEQ = 64
PAST_LEN = 2048

CHUNK = 64
HEAD_DIM = 64
N_HEADS_A = 16
N_KV_A = 2
WINDOW_A = 128
PAST_CHUNKS_A = WINDOW_A // CHUNK
N_HEADS_B = 16
PAST_CHUNKS_B = 8
REL_CLIP_B = 128
T5_BUCKETS = 32
T5_MAX_DIST = 128
WIDTH_A = N_HEADS_A * HEAD_DIM
WIDTH_B = N_HEADS_B * HEAD_DIM
IN_A = 2 * WIDTH_A + 2 * N_KV_A * HEAD_DIM
IN_B = 2 * WIDTH_B + 2 * N_HEADS_B * HEAD_DIM
EPS = 1e-6
NEG_INF = -1e30

kernel_name = 'hybrid_streaming_swa_sink_chunkband_step'


def rms_norm(x, g):
    xf = x.astype(jnp.float32)
    y = xf * lax.rsqrt(jnp.mean(xf * xf, axis=-1, keepdims=True) + EPS)
    return (y * g.astype(jnp.float32)).astype(x.dtype)


def t5_bucket(rel):
    nb = T5_BUCKETS // 2
    max_exact = nb // 2
    ret = jnp.where(rel > 0, nb, 0)
    n = jnp.abs(rel)
    nf = jnp.maximum(n, 1).astype(jnp.float32)
    large = max_exact + (jnp.log(nf / max_exact) / math.log(T5_MAX_DIST / max_exact)
                         * (nb - max_exact)).astype(jnp.int32)
    large = jnp.minimum(large, nb - 1)
    return ret + jnp.where(n < max_exact, n, large)


def t5_bias(table, q_pos, k_pos):
    b = table[t5_bucket(k_pos[None, :] - q_pos[:, None])]
    return jnp.transpose(b, (2, 0, 1)).astype(jnp.float32)


def clipped_rel_bias(table, q_pos, k_pos):
    idx = jnp.clip(q_pos[:, None] - k_pos[None, :], -REL_CLIP_B, REL_CLIP_B) + REL_CLIP_B
    return table[:, idx].astype(jnp.float32)


def attend(q, k, v, bias, valid, sinks):
    b, tq, h, dh = q.shape
    kv = k.shape[2]
    g = h // kv
    tk = k.shape[1]
    qg = q.reshape(b, tq, kv, g, dh)
    s = jnp.einsum('bqkgd,bskd->bkgqs', qg, k).astype(jnp.float32) * (dh ** -0.5)
    s = s + bias.reshape(kv, g, tq, tk)
    if valid is not None:
        s = jnp.where(valid, s, NEG_INF)
    if sinks is not None:
        sink = sinks.astype(jnp.float32).reshape(kv, g, 1, 1)
        m = jnp.maximum(jnp.max(s, axis=-1, keepdims=True), sink)
        p = jnp.exp(s - m)
        p = p / (jnp.sum(p, axis=-1, keepdims=True) + jnp.exp(sink - m))
    else:
        p = jax.nn.softmax(s, axis=-1)
    o = jnp.einsum('bkgqs,bskd->bqkgd', p.astype(v.dtype), v)
    return o.reshape(b, tq, h, dh)


def project(x, norm_g, w_in, q_g, k_g, n_heads, n_kv):
    h = rms_norm(x, norm_g)
    p = h @ w_in
    wq = n_heads * HEAD_DIM
    wkv = n_kv * HEAD_DIM
    q, k, v, gate = jnp.split(p, [wq, wq + wkv, wq + 2 * wkv], axis=-1)
    lead = x.shape[:-1]
    q = rms_norm(q.reshape(*lead, n_heads, HEAD_DIM), q_g)
    k = rms_norm(k.reshape(*lead, n_kv, HEAD_DIM), k_g)
    v = v.reshape(*lead, n_kv, HEAD_DIM)
    return q, k, v, gate


def prompt_band_attention(q, k, v, past_chunks, bias_fn, sinks):
    b, s, h, dh = q.shape
    nc = s // CHUNK
    pad = past_chunks * CHUNK
    band = pad + CHUNK
    kp = jnp.pad(k, ((0, 0), (pad, 0), (0, 0), (0, 0)))
    vp = jnp.pad(v, ((0, 0), (pad, 0), (0, 0), (0, 0)))
    q_pos = pad + jnp.arange(CHUNK, dtype=jnp.int32)
    k_pos = jnp.arange(band, dtype=jnp.int32)
    bias = bias_fn(q_pos, k_pos)

    def one_chunk(c):
        start = c * CHUNK
        qc = lax.dynamic_slice_in_dim(q, start, CHUNK, axis=1)
        kc = lax.dynamic_slice_in_dim(kp, start, band, axis=1)
        vc = lax.dynamic_slice_in_dim(vp, start, band, axis=1)
        valid = (start + k_pos) >= pad
        return attend(qc, kc, vc, bias, valid, sinks)

    o = lax.map(one_chunk, jnp.arange(nc, dtype=jnp.int32))
    return jnp.transpose(o, (1, 0, 2, 3, 4)).reshape(b, s, h * dh)


def sample_band_attention(q, k_new, v_new, k_cache, v_cache, bias_fn, sinks):
    b, tn, h, dh = q.shape
    L = k_cache.shape[1]
    kb = jnp.concatenate([k_cache, k_new], axis=1)
    vb = jnp.concatenate([v_cache, v_new], axis=1)
    q_pos = L + jnp.arange(tn, dtype=jnp.int32)
    k_pos = jnp.arange(L + tn, dtype=jnp.int32)
    o = attend(q, kb, vb, bias_fn(q_pos, k_pos), None, sinks)
    return o.reshape(b, tn, h * dh), kb[:, tn:], vb[:, tn:]


def gated_attention_layer(x_p, x_s, ck, cv, norm_g, w_in, q_g, k_g, w_out,
                          n_heads, n_kv, past_chunks, bias_fn, sinks):
    qp, kp, vp, gp = project(x_p, norm_g, w_in, q_g, k_g, n_heads, n_kv)
    op = prompt_band_attention(qp, kp, vp, past_chunks, bias_fn, sinks)
    y_p = x_p + (op * jax.nn.silu(gp)) @ w_out
    qs, ks, vs, gs = project(x_s, norm_g, w_in, q_g, k_g, n_heads, n_kv)
    os_, nk, nv = sample_band_attention(qs, ks, vs, ck, cv, bias_fn, sinks)
    y_s = x_s + (os_ * jax.nn.silu(gs)) @ w_out
    keep = past_chunks * CHUNK
    return y_p, y_s, kp[:, -keep:], vp[:, -keep:], nk, nv


def setup_inputs(seed: int = 0) -> dict:
    key = jax.random.key(seed)
    ks = jax.random.split(key, 20)
    f32 = jnp.float32
    la = min(WINDOW_A, PAST_LEN)
    lb = min(PAST_CHUNKS_B * CHUNK, PAST_LEN)
    nrm = lambda k, shape, s=1.0: (jax.random.normal(k, shape, f32) * s).astype(f32)
    return {
        'x_prompt': nrm(ks[0], (BATCH, SEQ, D_MODEL)),
        'x_sample': nrm(ks[1], (DEC_BATCH, DEC_SEQ, D_MODEL)),
        'cache_k_a': nrm(ks[2], (DEC_BATCH, la, N_KV_A, HEAD_DIM)),
        'cache_v_a': nrm(ks[3], (DEC_BATCH, la, N_KV_A, HEAD_DIM)),
        'cache_k_b': nrm(ks[4], (DEC_BATCH, lb, N_HEADS_B, HEAD_DIM)),
        'cache_v_b': nrm(ks[5], (DEC_BATCH, lb, N_HEADS_B, HEAD_DIM)),
        't5_table': nrm(ks[6], (T5_BUCKETS, N_HEADS_A), 0.3),
        'norm_a': 1.0 + nrm(ks[7], (D_MODEL,), 0.02),
        'w_in_a': nrm(ks[8], (D_MODEL, IN_A), D_MODEL ** -0.5),
        'q_norm_a': 1.0 + nrm(ks[9], (HEAD_DIM,), 0.02),
        'k_norm_a': 1.0 + nrm(ks[10], (HEAD_DIM,), 0.02),
        'sinks_a': nrm(ks[11], (N_HEADS_A,), 0.5),
        'w_out_a': nrm(ks[12], (WIDTH_A, D_MODEL), WIDTH_A ** -0.5),
        'norm_b': 1.0 + nrm(ks[13], (D_MODEL,), 0.02),
        'w_in_b': nrm(ks[14], (D_MODEL, IN_B), D_MODEL ** -0.5),
        'q_norm_b': 1.0 + nrm(ks[15], (HEAD_DIM,), 0.02),
        'k_norm_b': 1.0 + nrm(ks[16], (HEAD_DIM,), 0.02),
        'rel_bias_b': nrm(ks[17], (N_HEADS_B, 2 * REL_CLIP_B + 1), 0.3),
        'w_out_b': nrm(ks[18], (WIDTH_B, D_MODEL), WIDTH_B ** -0.5),
    }


def reference(x_prompt, x_sample, cache_k_a, cache_v_a, cache_k_b, cache_v_b,
              t5_table, norm_a, w_in_a, q_norm_a, k_norm_a, sinks_a, w_out_a,
              norm_b, w_in_b, q_norm_b, k_norm_b, rel_bias_b, w_out_b):
    bias_a = functools.partial(t5_bias, t5_table)
    bias_b = functools.partial(clipped_rel_bias, rel_bias_b)
    x_p, x_s = x_prompt, x_sample
    for i in range(DEPTH):
        if i % 2 == 0:
            x_p, x_s, k_a_p, v_a_p, k_a_s, v_a_s = gated_attention_layer(
                x_p, x_s, cache_k_a, cache_v_a, norm_a, w_in_a, q_norm_a, k_norm_a,
                w_out_a, N_HEADS_A, N_KV_A, PAST_CHUNKS_A, bias_a, sinks_a)
        else:
            x_p, x_s, k_b_p, v_b_p, k_b_s, v_b_s = gated_attention_layer(
                x_p, x_s, cache_k_b, cache_v_b, norm_b, w_in_b, q_norm_b, k_norm_b,
                w_out_b, N_HEADS_B, N_HEADS_B, PAST_CHUNKS_B, bias_b, None)
    return (x_p, x_s, k_a_p, v_a_p, k_b_p, v_b_p, k_a_s, v_a_s, k_b_s, v_b_s)
```

```cpp
#include <hip/hip_runtime.h>
#include <cstdio>
#include <cstdint>
#include <cmath>
namespace pg8 {
#define PG8_LAS __attribute__((address_space(3)))
typedef unsigned short bf16_t;
typedef short bf16x8 __attribute__((ext_vector_type(8)));
typedef float f32x4 __attribute__((ext_vector_type(4)));
typedef unsigned u32x4 __attribute__((ext_vector_type(4)));
constexpr int BM = 256, BK = 64, HALF = 128, HTB = HALF * BK * 2  , STAGE_BYTES = 8 * HTB, NXCD = 8, WGM = 8;

__host__ __device__ __forceinline__ int lds_byte(int r, int c) { const int st = (r >> 4) * 2 + (c >> 5), rr = r & 15, cc = c & 31, ob = rr * 64 + cc * 2; return st * 1024 + (ob ^ (((ob >> 9) & 1) << 5)); }
__host__ __device__ __forceinline__ void stage_rc(int b, int& R, int& C) { const int st = b / 1024, sb = b % 1024, swz = sb ^ (((sb >> 9) & 1) << 5); R = (st >> 1) * 16 + swz / 64; C = (st & 1) * 32 + (swz % 64) / 2; }
__host__ __device__ __forceinline__ int perm32(int rho) { const int n = rho >> 4, i = rho & 15; return 8 * (i >> 2) + 4 * n + (i & 3); }

struct Unit { int pm, pn; };
struct Gemm { const bf16_t* A; const bf16_t* Bt; int M, N, K; };

struct StaticOrder {
    int nM, nN, nwg, G, c;
    __host__ __device__ void init(int M, int N, int G_, int c_) { nM = M / BM; nN = N / BM; nwg = nM * nN; G = G_; c = c_; }
    __host__ __device__ bool next(int i, Unit& u) const {
        const long L = (long)i * G + c; if (L >= nwg) return false;
        int wgid = (int)L; { const int q = nwg / NXCD, r = nwg % NXCD, xcd = wgid % NXCD, off = wgid / NXCD; wgid = (xcd < r ? xcd * (q + 1) : r * (q + 1) + (xcd - r) * q) + off; }
        const int nig = WGM * nN, gid = wgid / nig, fm = gid * WGM, gsz = (nM - fm) < WGM ? (nM - fm) : WGM;
        u.pm = fm + ((wgid % nig) % gsz); u.pn = (wgid % nig) / gsz; return true;
    }
    __device__ __forceinline__ void a_ready(const Unit&) const {}
    __device__ __forceinline__ void done(const Unit&) const {}
};
__device__ __forceinline__ unsigned cvt_pk_bf16(float lo, float hi) { unsigned r; asm volatile("v_cvt_pk_bf16_f32 %0, %1, %2" : "=v"(r) : "v"(lo), "v"(hi)); return r; }
constexpr int SEQ_ = 16384;
constexpr float NORM_EPS = 1e-6f;
struct EpiIn {
    static constexpr bool PERM = true, AFTER_DRAIN = false;
    int layer;
    bf16_t *Q, *Kb, *Vb, *G; int kvw;
    const float *qg, *kg;
    const float* slab;
    float *okp, *ovp, *oks, *ovs; int keep, nkv;
    float c2;
    template <int TYPE>
    __device__ __forceinline__ void tile(const f32x4 (&acc)[2][2][4][2], int row0, int dcol, int fq, bf16_t* dst, int ld, const float* gp, float sc, float* o_p, float* o_s, int head) const {
        f32x4 gv[2][2];
        if (TYPE < 2) {
#pragma unroll
            for (int bj = 0; bj < 2; ++bj)
#pragma unroll
                for (int n = 0; n < 2; ++n) gv[bj][n] = *(const f32x4*)(gp + 32 * bj + dcol + 4 * n) * sc; }
#pragma unroll
        for (int ai = 0; ai < 2; ++ai)
#pragma unroll
            for (int m = 0; m < 4; ++m) {
                const int row = row0 + ai * HALF + m * 16;
                float rs = 1.f;
                if (slab) { const f32x4 s4 = *(const f32x4*)(slab + (size_t)row * 16 + 4 * fq); float t = (s4[0] + s4[1]) + (s4[2] + s4[3]); t += __shfl_xor(t, 16); t += __shfl_xor(t, 32); rs = rsqrtf(t * (1.f / 1024.f) + NORM_EPS); }
                f32x4 v[2][2];
#pragma unroll
                for (int bj = 0; bj < 2; ++bj)
#pragma unroll
                    for (int n = 0; n < 2; ++n) v[bj][n] = acc[ai][bj][m][n] * rs;
                if (TYPE < 2) {
                    float ss = 0.f;
#pragma unroll
                    for (int bj = 0; bj < 2; ++bj)
#pragma unroll
                        for (int n = 0; n < 2; ++n) { const f32x4 x = v[bj][n]; ss += (x[0] * x[0] + x[1] * x[1]) + (x[2] * x[2] + x[3] * x[3]); }
                    ss += __shfl_xor(ss, 16); ss += __shfl_xor(ss, 32);
                    const float r = rsqrtf(ss * (1.f / 64.f) + NORM_EPS);
#pragma unroll
                    for (int bj = 0; bj < 2; ++bj)
#pragma unroll
                        for (int n = 0; n < 2; ++n) v[bj][n] = v[bj][n] * r * gv[bj][n];
                } else if (TYPE == 3) {
#pragma unroll
                    for (int bj = 0; bj < 2; ++bj)
#pragma unroll
                        for (int n = 0; n < 2; ++n)
#pragma unroll
                            for (int e = 0; e < 4; ++e) { const float x = v[bj][n][e]; v[bj][n][e] = x * __builtin_amdgcn_rcpf(1.f + __builtin_amdgcn_exp2f(-1.4426950408889634f * x)); }
                }
                if ((TYPE == 1 || TYPE == 2) && row >= SEQ_ - keep) {
                    float* op;
                    if (row < SEQ_) op = o_p + ((size_t)(row - (SEQ_ - keep)) * nkv + head) * 64 + dcol;
                    else { const int r_ = row - SEQ_; op = o_s + (((size_t)(r_ >> 6) * keep + (keep - 64) + (r_ & 63)) * nkv + head) * 64 + dcol; }
#pragma unroll
                    for (int bj = 0; bj < 2; ++bj) { *(f32x4*)(op + 32 * bj) = v[bj][0]; *(f32x4*)(op + 32 * bj + 4) = v[bj][1]; }
                }
#pragma unroll
                for (int bj = 0; bj < 2; ++bj) { u32x4 w; w.x = cvt_pk_bf16(v[bj][0][0], v[bj][0][1]); w.y = cvt_pk_bf16(v[bj][0][2], v[bj][0][3]); w.z = cvt_pk_bf16(v[bj][1][0], v[bj][1][1]); w.w = cvt_pk_bf16(v[bj][1][2], v[bj][1][3]);
                    *(u32x4*)(dst + (size_t)row * ld + 32 * bj) = w; }
            }
    }
    __device__ __forceinline__ void operator()(const f32x4 (&acc)[2][2][4][2], const Unit& u, int wr, int wc, int fr, int fq) const {
        int type, head;
        if (layer == 0) { if (u.pn < 4) { type = 0; head = 4 * u.pn + wc; } else if (u.pn == 4) { type = wc < 2 ? 1 : 2; head = wc & 1; } else { type = 3; head = 4 * (u.pn - 5) + wc; } }
        else { type = u.pn >> 2; head = 4 * (u.pn & 3) + wc; }
        const int row0 = u.pm * BM + wr * 64 + fr, dcol = 8 * fq, co = head * 64 + dcol;
        if (type == 0) tile<0>(acc, row0, dcol, fq, Q + co, 1024, qg, c2, nullptr, nullptr, head);
        else if (type == 1) tile<1>(acc, row0, dcol, fq, Kb + co, kvw, kg, 1.f, okp, oks, head);
        else if (type == 2) tile<2>(acc, row0, dcol, fq, Vb + co, kvw, nullptr, 1.f, ovp, ovs, head);
        else tile<3>(acc, row0, dcol, fq, G + co, 1024, nullptr, 1.f, nullptr, nullptr, head);
    }
};
struct EpiOut {
    static constexpr bool PERM = true, AFTER_DRAIN = false;
    const float *base_p, *base_s;
    float* out;
    bf16_t* yb;
    float* slab;
    __device__ __forceinline__ void operator()(const f32x4 (&acc)[2][2][4][2], const Unit& u, int wr, int wc, int fr, int fq) const {
        const int row0 = u.pm * BM + wr * 64 + fr, col0 = u.pn * BM + wc * 32 + 8 * fq;
#pragma unroll
        for (int ai = 0; ai < 2; ++ai)
#pragma unroll
            for (int m = 0; m < 4; ++m) {
                const int row = row0 + ai * HALF + m * 16;
                const float* bp = (row < SEQ_ ? base_p + (size_t)row * 1024 : base_s + (size_t)(row - SEQ_) * 1024) + col0;
                float* op = out + (size_t)row * 1024 + col0;
                float ss = 0.f;
#pragma unroll
                for (int bj = 0; bj < 2; ++bj) {
                    const f32x4 y0 = acc[ai][bj][m][0] + *(const f32x4*)(bp + bj * HALF), y1 = acc[ai][bj][m][1] + *(const f32x4*)(bp + bj * HALF + 4);
                    *(f32x4*)(op + bj * HALF) = y0; *(f32x4*)(op + bj * HALF + 4) = y1;
                    ss += ((y0[0] * y0[0] + y0[1] * y0[1]) + (y0[2] * y0[2] + y0[3] * y0[3])) + ((y1[0] * y1[0] + y1[1] * y1[1]) + (y1[2] * y1[2] + y1[3] * y1[3]));
                    if (yb) { u32x4 w; w.x = cvt_pk_bf16(y0[0], y0[1]); w.y = cvt_pk_bf16(y0[2], y0[3]); w.z = cvt_pk_bf16(y1[0], y1[1]); w.w = cvt_pk_bf16(y1[2], y1[3]);
                        *(u32x4*)(yb + (size_t)row * 1024 + col0 + bj * HALF) = w; }
                }
                if (slab) { ss += __shfl_xor(ss, 16); ss += __shfl_xor(ss, 32); if (fq == 0) slab[(size_t)row * 16 + 4 * u.pn + wc] = ss; }
            }
    }
};
template <class Epi, class Sched, bool ALIGN_EPI = false, bool SP2 = false>
__device__ __forceinline__ void gemm_phase(PG8_LAS unsigned char* lds, const Gemm g, const Sched& S, const Epi& E) {
    int tid_ = threadIdx.x; asm volatile("" : "+v"(tid_));
    const int tid = tid_, wid = __builtin_amdgcn_readfirstlane(tid >> 6), lane = tid & 63, wr = wid >> 2, wc = wid & 3, fr = lane & 15, fq = lane >> 4;
    const int K = g.K, nt = K / BK;
    unsigned voffA[2], voffB[2];
#pragma unroll
    for (int i = 0; i < 2; ++i) { int R, C; stage_rc(tid * 16 + i * 8192, R, C); const int Rb = Epi::PERM ? ((R & ~31) + perm32(R & 31)) : R;
        voffA[i] = (unsigned)(R * K + C) * 2u; voffB[i] = (unsigned)(Rb * K + C) * 2u; }
    const size_t kstep = (size_t)(BK * 2);
    const size_t hstep = (size_t)HALF * K * 2;
    const size_t tstep = 2 * hstep;
    const unsigned ldsw = (unsigned)wid * 1024u;
    const int aoff = lds_byte(wr * 64 + fr, fq * 8), boff = lds_byte(wc * 32 + fr, fq * 8);
#define PG8_SA(b, h) (((b) * 2 + (h)) * HTB)
#define PG8_SB(b, h) ((4 + (b) * 2 + (h)) * HTB)
#define PG8_STAGE(bufoff, gbase, voff) do { _Pragma("unroll") for (int _i = 0; _i < 2; ++_i) \
        __builtin_amdgcn_global_load_lds((const unsigned*)((const char*)(gbase) + (voff)[_i]), (PG8_LAS unsigned*)(lds + (bufoff) + ldsw + _i * 8192), 16, 0, 0); } while (0)
#define PG8_LDA(dst, b, h) do { _Pragma("unroll") for (int m = 0; m < 4; ++m) _Pragma("unroll") for (int k = 0; k < 2; ++k) dst[m][k] = *(const PG8_LAS bf16x8*)(lds + PG8_SA(b, h) + aoff + m * 2048 + k * 1024); } while (0)
#define PG8_LDB(dst, b, h) do { _Pragma("unroll") for (int n = 0; n < 2; ++n) _Pragma("unroll") for (int k = 0; k < 2; ++k) dst[n][k] = *(const PG8_LAS bf16x8*)(lds + PG8_SB(b, h) + boff + n * 2048 + k * 1024); } while (0)
#define PG8_MMA(ai, bj, At, Bt) do { __builtin_amdgcn_s_setprio(1); _Pragma("unroll") for (int m = 0; m < 4; ++m) _Pragma("unroll") for (int n = 0; n < 2; ++n) _Pragma("unroll") for (int k = 0; k < 2; ++k) \
        acc[ai][bj][m][n] = __builtin_amdgcn_mfma_f32_16x16x32_bf16(Bt[n][k], At[m][k], acc[ai][bj][m][n], 0, 0, 0); __builtin_amdgcn_s_setprio(0); } while (0)
#define PG8_WAIT_V(n) asm volatile("s_waitcnt vmcnt(" #n ")" ::: "memory")
#define PG8_WAIT_L(n) asm volatile("s_waitcnt lgkmcnt(" #n ")" ::: "memory")
#define PG8_BAR __builtin_amdgcn_s_barrier()
#define PG8_SCHED __builtin_amdgcn_sched_barrier(0)
    Unit cur, nxt; int ui = 0;
    if (!S.next(0, cur)) return;
    f32x4 acc[2][2][4][2];
#pragma unroll
    for (int a = 0; a < 2; ++a)
#pragma unroll
        for (int b = 0; b < 2; ++b)
#pragma unroll
            for (int m = 0; m < 4; ++m)
#pragma unroll
                for (int n = 0; n < 2; ++n) acc[a][b][m][n] = (f32x4){0.f, 0.f, 0.f, 0.f};
    bf16x8 At[4][2], B0[2][2], B1[2][2];
    const char* cA = (const char*)g.A + (size_t)cur.pm * tstep; const char* cB = (const char*)g.Bt + (size_t)cur.pn * tstep;
    S.a_ready(cur);
    if constexpr (SP2) {
        PG8_STAGE(PG8_SB(0, 0), cB, voffB); PG8_STAGE(PG8_SB(0, 1), cB + hstep, voffB); PG8_STAGE(PG8_SA(0, 0), cA, voffA); PG8_STAGE(PG8_SA(0, 1), cA + hstep, voffA);
        if (wr == 1) PG8_BAR;
        PG8_WAIT_V(2); PG8_BAR;
        PG8_STAGE(PG8_SB(1, 0), cB + kstep, voffB); PG8_STAGE(PG8_SA(1, 0), cA + kstep, voffA); PG8_STAGE(PG8_SB(1, 1), cB + hstep + kstep, voffB);
        PG8_WAIT_V(6); PG8_BAR;
    } else {
        PG8_STAGE(PG8_SB(0, 0), cB, voffB); PG8_STAGE(PG8_SA(0, 0), cA, voffA); PG8_STAGE(PG8_SB(0, 1), cB + hstep, voffB); PG8_STAGE(PG8_SA(0, 1), cA + hstep, voffA);
        if (wr == 1) PG8_BAR;
        PG8_WAIT_V(4); PG8_BAR;
        PG8_STAGE(PG8_SB(1, 0), cB + kstep, voffB); PG8_STAGE(PG8_SA(1, 0), cA + kstep, voffA); PG8_STAGE(PG8_SB(1, 1), cB + hstep + kstep, voffB);
        PG8_WAIT_V(6); PG8_BAR;
    }
    for (;;) {
        const bool has_next = S.next(ui + 1, nxt);
        const char* nA = has_next ? (const char*)g.A + (size_t)nxt.pm * tstep : cA; const char* nB = has_next ? (const char*)g.Bt + (size_t)nxt.pn * tstep : cB;
        for (int t = 0; t < nt; t += 2) {
            const bool last = (t == nt - 2);
            const char* a1 = cA + (size_t)(t + 1) * kstep;
            const char* a2 = last ? nA : cA + (size_t)(t + 2) * kstep; const char* b2 = last ? nB : cB + (size_t)(t + 2) * kstep;
            const char* a3 = a2 + kstep; const char* b3 = b2 + kstep;
            if (last && has_next) S.a_ready(nxt);
            if constexpr (SP2) {
            PG8_LDB(B0, 0, 0); PG8_LDB(B1, 0, 1); PG8_SCHED; PG8_LDA(At, 0, 0); PG8_STAGE(PG8_SA(1, 1), a1 + hstep, voffA);
            PG8_WAIT_V(8); PG8_WAIT_L(0); PG8_BAR; PG8_MMA(0, 0, At, B0); PG8_MMA(0, 1, At, B1); PG8_BAR; PG8_SCHED;
            PG8_LDA(At, 0, 1); PG8_STAGE(PG8_SB(0, 0), b2, voffB); PG8_STAGE(PG8_SB(0, 1), b2 + hstep, voffB); PG8_STAGE(PG8_SA(0, 0), a2, voffA);
            PG8_WAIT_V(8); PG8_WAIT_L(0); PG8_BAR; PG8_MMA(1, 0, At, B0); PG8_MMA(1, 1, At, B1); PG8_BAR; PG8_SCHED;
            PG8_LDB(B0, 1, 0); PG8_LDB(B1, 1, 1); PG8_SCHED; PG8_LDA(At, 1, 0); PG8_STAGE(PG8_SA(0, 1), a2 + hstep, voffA);
            PG8_WAIT_V(8); PG8_WAIT_L(0); PG8_BAR; PG8_MMA(0, 0, At, B0); PG8_MMA(0, 1, At, B1); PG8_BAR; PG8_SCHED;
            PG8_LDA(At, 1, 1); PG8_STAGE(PG8_SB(1, 0), b3, voffB); PG8_STAGE(PG8_SB(1, 1), b3 + hstep, voffB); PG8_STAGE(PG8_SA(1, 0), a3, voffA);
            PG8_WAIT_V(8); PG8_WAIT_L(0); PG8_BAR; PG8_MMA(1, 0, At, B0); PG8_MMA(1, 1, At, B1); PG8_BAR; PG8_SCHED;
            } else {
            PG8_LDB(B0, 0, 0); PG8_SCHED; PG8_LDA(At, 0, 0); PG8_STAGE(PG8_SA(1, 1), a1 + hstep, voffA);
            PG8_WAIT_L(8); PG8_BAR; PG8_WAIT_L(0); PG8_MMA(0, 0, At, B0); PG8_BAR; PG8_SCHED;
            PG8_LDB(B1, 0, 1); PG8_STAGE(PG8_SB(0, 0), b2, voffB);
            PG8_BAR; PG8_WAIT_L(0); PG8_MMA(0, 1, At, B1); PG8_BAR;
            PG8_LDA(At, 0, 1); PG8_STAGE(PG8_SA(0, 0), a2, voffA);
            PG8_BAR; PG8_WAIT_L(0); PG8_MMA(1, 0, At, B0); PG8_BAR; PG8_SCHED;
            PG8_STAGE(PG8_SB(0, 1), b2 + hstep, voffB);
            PG8_WAIT_V(6); PG8_BAR; PG8_MMA(1, 1, At, B1); PG8_BAR;
            PG8_LDB(B0, 1, 0); PG8_SCHED; PG8_LDA(At, 1, 0); PG8_STAGE(PG8_SA(0, 1), a2 + hstep, voffA);
            PG8_WAIT_L(8); PG8_BAR; PG8_WAIT_L(0); PG8_MMA(0, 0, At, B0); PG8_BAR; PG8_SCHED;
            PG8_LDB(B1, 1, 1); PG8_STAGE(PG8_SB(1, 0), b3, voffB);
            PG8_BAR; PG8_WAIT_L(0); PG8_MMA(0, 1, At, B1); PG8_BAR;
            PG8_LDA(At, 1, 1); PG8_STAGE(PG8_SA(1, 0), a3, voffA);
            PG8_BAR; PG8_WAIT_L(0); PG8_MMA(1, 0, At, B0); PG8_BAR; PG8_SCHED;
            PG8_STAGE(PG8_SB(1, 1), b3 + hstep, voffB);
            PG8_WAIT_V(6); PG8_BAR; PG8_MMA(1, 1, At, B1); PG8_BAR;
            }
        }
        if constexpr (ALIGN_EPI) { if (wr == 0) PG8_BAR; }
        if constexpr (!Epi::AFTER_DRAIN) { E(acc, cur, wr, wc, fr, fq); S.done(cur); }
        if (!has_next) break;
#pragma unroll
        for (int a = 0; a < 2; ++a)
#pragma unroll
            for (int b = 0; b < 2; ++b)
#pragma unroll
                for (int m = 0; m < 4; ++m)
#pragma unroll
                    for (int n = 0; n < 2; ++n) acc[a][b][m][n] = (f32x4){0.f, 0.f, 0.f, 0.f};
        cur = nxt; cA = nA; cB = nB; ++ui;
        if constexpr (ALIGN_EPI) { if (wr == 1) PG8_BAR; }
    }
    PG8_WAIT_V(0);
    if constexpr (!ALIGN_EPI) { if (wr == 0) PG8_BAR; }
    PG8_BAR;
    if constexpr (Epi::AFTER_DRAIN) { E.fused(acc, cur, wr, wc, fr, fq, lds, wid, lane); S.done(cur); }
#undef PG8_SA
#undef PG8_SB
#undef PG8_STAGE
#undef PG8_LDA
#undef PG8_LDB
#undef PG8_MMA
#undef PG8_WAIT_V
#undef PG8_WAIT_L
#undef PG8_BAR
#undef PG8_SCHED
}
}
#define GAS __attribute__((address_space(1)))
#define LAS __attribute__((address_space(3)))
typedef unsigned short bf16;
typedef unsigned v4u __attribute__((ext_vector_type(4)));
typedef float f32x4 __attribute__((ext_vector_type(4)));
typedef short bf16x8 __attribute__((ext_vector_type(8)));
typedef GAS unsigned gu32;
typedef GAS unsigned long long gu64;
#define RLX_AGENT __ATOMIC_RELAXED, __HIP_MEMORY_SCOPE_AGENT
#define LDS_WAIT() asm volatile("s_waitcnt lgkmcnt(0)" ::: "memory")
#define VM_WAIT() asm volatile("s_waitcnt vmcnt(0)" ::: "memory")
__device__ __forceinline__ unsigned long long rt() { return __builtin_amdgcn_s_memrealtime(); }
__device__ __forceinline__ unsigned f2bf(float f) { unsigned u = __builtin_bit_cast(unsigned, f); return (u + 0x7fffu + ((u >> 16) & 1u)) >> 16; }
__device__ __forceinline__ unsigned pk2(float lo, float hi) { return f2bf(lo) | (f2bf(hi) << 16); }

#define XB_TMO      128
#define XB_XCNT(j)  (256  + 64 * (j))
#define XB_XSUB(j)  (1280 + 64 * (j))
#define XB_XGEN(j)  (2304 + 64 * (j))
#define XB_TOP      3328
#define XB_TOPGEN   3392
#define XCD_BAR_WORDS 3456
#define XB_SPIN_CAP (1u << 18)

__device__ __forceinline__ unsigned xb_ld(unsigned* p)              { return __hip_atomic_load(p, __ATOMIC_RELAXED, __HIP_MEMORY_SCOPE_AGENT); }
__device__ __forceinline__ unsigned xb_add(unsigned* p, unsigned v) { return __hip_atomic_fetch_add(p, v, __ATOMIC_RELAXED, __HIP_MEMORY_SCOPE_AGENT); }
__device__ __forceinline__ unsigned xb_xcc_id() { return (unsigned)__builtin_amdgcn_s_getreg((3 << 11) | 20) & 0xFu; }
#define XB_SPIN(cond, bar) do { unsigned _sp = 0; while (cond) { __builtin_amdgcn_s_sleep(1); \
    if ((++_sp & 255u) == 0u) { if (xb_ld(&(bar)[XB_TMO])) break; if (_sp > XB_SPIN_CAP) { atomicAdd(&(bar)[XB_TMO], 1u); break; } } } } while (0)

struct XcdBarrier {
    unsigned* bar; unsigned x;
    volatile LAS unsigned* st;
};

__device__ __forceinline__ XcdBarrier xcd_barrier_post(unsigned* bar, volatile LAS unsigned* st) {
    XcdBarrier b; b.bar = bar; b.x = xb_xcc_id(); b.st = st;
    if (threadIdx.x == 0) (void)xb_add(&bar[XB_XCNT(b.x)], 1u);
    return b;
}
__device__ __forceinline__ void xcd_barrier_complete(unsigned* bar, unsigned x, unsigned& nloc, unsigned& nx) {
    const unsigned G = gridDim.x * gridDim.y * gridDim.z;
    unsigned sum, cnt, mine, sp = 0u;
    for (;;) {
        sum = 0u; cnt = 0u; mine = 0u;
#pragma unroll
        for (unsigned j = 0; j < 16; ++j) { const unsigned c = xb_ld(&bar[XB_XCNT(j)]); sum += c; cnt += (c > 0u) ? 1u : 0u; mine = (j == x) ? c : mine; }
        if (sum == G) break;
        __builtin_amdgcn_s_sleep(1);
        if ((++sp & 255u) == 0u) { if (xb_ld(&bar[XB_TMO])) break; if (sp > XB_SPIN_CAP) { atomicAdd(&bar[XB_TMO], 1u); break; } }
    }
    nloc = mine > 0u ? mine : 1u; nx = cnt > 0u ? cnt : 1u;
}

__device__ __forceinline__ void xcd_barrier(const XcdBarrier& b) {
    asm volatile("s_waitcnt vmcnt(0)" ::: "memory");
    __syncthreads();
    if (threadIdx.x == 0) {
        unsigned* bar = b.bar;
        __builtin_amdgcn_s_waitcnt(0);
        unsigned nloc = b.st[0], nx = b.st[1];
        if (nloc == 0u) { xcd_barrier_complete(bar, b.x, nloc, nx); b.st[0] = nloc; b.st[1] = nx; }
        const unsigned old = xb_add(&bar[XB_XSUB(b.x)], 1u);
        const unsigned gen = old / nloc;
        if (old + 1u == (gen + 1u) * nloc) {
            __builtin_amdgcn_fence(__ATOMIC_RELEASE, "agent");
            asm volatile("s_waitcnt vmcnt(0)" ::: "memory");
            const unsigned og = xb_add(&bar[XB_TOP], 1u);
            const unsigned tg = og / nx;
            if (og + 1u == (tg + 1u) * nx) xb_add(&bar[XB_TOPGEN], 1u);
            else XB_SPIN(xb_ld(&bar[XB_TOPGEN]) == tg, bar);
            __builtin_amdgcn_fence(__ATOMIC_ACQUIRE, "agent");
            xb_add(&bar[XB_XGEN(b.x)], 1u);
            asm volatile("s_waitcnt vmcnt(0)" ::: "memory");
        } else {
            XB_SPIN(xb_ld(&bar[XB_XGEN(b.x)]) == gen, bar);
            __builtin_amdgcn_fence(__ATOMIC_ACQUIRE, "agent");
            asm volatile("s_waitcnt vmcnt(0)" ::: "memory");
        }
    }
    __syncthreads();
}
constexpr int NWAVES = 8;
constexpr int DM = 1024, SEQ = 16384, NB = 16, MS = NB * 64, M = SEQ + MS;
constexpr int NIN_A = 2304, NIN_B = 4096;
constexpr float EPS = 1e-6f, LOG2E = 1.4426950408889634f, C2 = 0.125f * 1.4426950408889634f;
constexpr size_t O_Y = 0, O_KAP = 17825792, O_VAP = 17842176, O_KBP = 17858560, O_VBP = 18382848, O_KAS = 18907136, O_VAS = 19169280, O_KBS = 19431424, O_VBS = 27820032, O_END = 36208640;
constexpr size_t KiB = 1024, MiB = 1u << 20;
constexpr size_t WS_CTL = 0, CTL_ZERO_BYTES = 256 * KiB;
constexpr size_t WS_WINA = 256 * KiB;
constexpr size_t WS_WOUTA = WS_WINA + (size_t)NIN_A * DM * 2;
constexpr size_t WS_WINB = WS_WOUTA + (size_t)DM * DM * 2;
constexpr size_t WS_WOUTB = WS_WINB + (size_t)NIN_B * DM * 2;
constexpr size_t WS_SLAB = WS_WOUTB + (size_t)DM * DM * 2;
constexpr size_t ACT = (size_t)M * DM * 2;
constexpr size_t WS_XN = 18 * MiB;
constexpr size_t WS_QA = WS_XN + ACT;
constexpr size_t WS_GA = WS_QA + ACT, WS_KA = WS_GA + ACT, WS_VA = WS_KA + (size_t)M * 128 * 2;
constexpr size_t WS_QB = WS_GA;
constexpr size_t WS_KB = WS_QB + ACT, WS_VB = WS_KB + ACT, WS_GB = WS_VB + ACT;
constexpr size_t WS_CKA = WS_GB + ACT, WS_CVA = WS_CKA + (size_t)NB * 128 * 128 * 2, WS_CKB = WS_CVA + (size_t)NB * 128 * 128 * 2, WS_CVB = WS_CKB + (size_t)NB * 512 * 1024 * 2;
constexpr size_t WS_END = WS_CVB + (size_t)NB * 512 * 1024 * 2;
static_assert(WS_SLAB + (size_t)M * 16 * 4 <= WS_XN && WS_VA + (size_t)M * 128 * 2 <= WS_CKA && WS_QB >= WS_QA + ACT && WS_END <= 256 * MiB, "d_ws map");
constexpr int CW_KMAX_A = 64, CW_KMAX_B = 128;
constexpr int CW_BAR = 4096;
constexpr int RING_OFF = 0, RING_BYTES = 131072;
constexpr int LDSCTL_OFF = RING_BYTES, MISC_OFF = LDSCTL_OFF + 320;
constexpr int LDS_BYTES = 147456;
constexpr int AT_SLOT = 0, AT_SLOTB = 16384  , AT_TAB = 2 * AT_SLOTB, AT_TABB = 49152, AT_WSF = AT_TAB + AT_TABB, AT_OST = AT_WSF + NWAVES * 256, AT_END = AT_OST + NWAVES * 4096;
static_assert(AT_END <= RING_BYTES, "attention LDS map");

struct Frame {
    LAS unsigned char* lds;
    volatile LAS unsigned* MISC;
    gu32* ctl;
    int tid, lane, wave;
    int vcu, G;
};
struct Args { const float* in[19]; float* out; unsigned char* ws; };

__device__ __forceinline__ float wave_sum(float v) {
#pragma unroll
    for (int o = 1; o < 64; o <<= 1) v += __shfl_xor(v, o);
    return v;
}
__device__ __forceinline__ float wave_max(float v) {
#pragma unroll
    for (int o = 1; o < 64; o <<= 1) v = fmaxf(v, __shfl_xor(v, o));
    return v;
}
__device__ __forceinline__ int phys_col(int c) { return (c & ~255) | (((c >> 5) & 1) << 7) | (((c >> 6) & 3) << 5) | (c & 31); }

__device__ __forceinline__ void p0_transpose_item(const float* W, int K, int N, bf16* WT, bool permute, const float* gain, LAS float* scr, int item, int lane) {
    const int nblk = N / 32, kb = item / nblk, nb = item % nblk, k0 = 64 * kb, n0 = 32 * nb;
#pragma unroll 8
    for (int i = 0; i < 32; ++i) { const int kk = 2 * i + (lane >> 5); float w = W[(size_t)(k0 + kk) * N + n0 + (lane & 31)]; if (gain) w *= gain[k0 + kk]; scr[kk * 33 + (lane & 31)] = w; }
    LDS_WAIT(); asm volatile("" ::: "memory");
    const int c = lane & 7;
    const int r0 = permute ? phys_col(n0) : n0;
#pragma unroll
    for (int j = 0; j < 4; ++j) { const int n = (lane >> 3) + 8 * j; const LAS float* s = scr + (8 * c) * 33 + n;
        v4u o; o.x = pk2(s[0 * 33], s[1 * 33]); o.y = pk2(s[2 * 33], s[3 * 33]); o.z = pk2(s[4 * 33], s[5 * 33]); o.w = pk2(s[6 * 33], s[7 * 33]);
        *(GAS v4u*)(WT + (size_t)(r0 + n) * K + k0 + 8 * c) = o; }
    LDS_WAIT(); asm volatile("" ::: "memory");
}
__device__ __forceinline__ void rms_row_to_bf16(const float* xrow, const float* g, bf16* orow, int lane) {
    const GAS f32x4* xr = (const GAS f32x4*)xrow + lane; const GAS f32x4* gr = (const GAS f32x4*)g + lane;
    f32x4 v[4]; float s = 0.f;
#pragma unroll
    for (int j = 0; j < 4; ++j) { v[j] = xr[64 * j]; s += (v[j].x * v[j].x + v[j].y * v[j].y) + (v[j].z * v[j].z + v[j].w * v[j].w); }
    const float r = rsqrtf(wave_sum(s) * (1.f / DM) + EPS);
    GAS unsigned long long* o8 = (GAS unsigned long long*)orow + lane;
#pragma unroll
    for (int j = 0; j < 4; ++j) { const f32x4 gg = gr[64 * j]; o8[64 * j] = (unsigned long long)pk2(v[j].x * r * gg.x, v[j].y * r * gg.y) | ((unsigned long long)pk2(v[j].z * r * gg.z, v[j].w * r * gg.w) << 32); }
}
template <int W>
__device__ __forceinline__ void cache_row(const float* src, bf16* dstb, float* dsto, int L, int row, gu32* kmax, int lane) {
    const int b = row / L, j = row % L;
    const float* s = src + (size_t)row * W;
    float* o = j >= 64 ? dsto + ((size_t)b * L + (j - 64)) * W : nullptr;
    if constexpr (W == 128) {
        const float v0 = s[2 * lane], v1 = s[2 * lane + 1];
        ((GAS unsigned*)(dstb + (size_t)row * W))[lane] = pk2(v0, v1);
        if (o) { o[2 * lane] = v0; o[2 * lane + 1] = v1; }
        if (kmax) { float q = v0 * v0 + v1 * v1;
#pragma unroll
            for (int d = 1; d < 32; d <<= 1) q += __shfl_xor(q, d);
            q = fmaxf(q, __shfl_xor(q, 32));
            if (lane == 0) __hip_atomic_fetch_max(kmax, __float_as_uint(q), __ATOMIC_RELAXED, __HIP_MEMORY_SCOPE_AGENT); }
    } else {
        float qm = 0.f;
#pragma unroll
        for (int t = 0; t < W / 256; ++t) { const f32x4 v = ((const GAS f32x4*)s)[lane + 64 * t];
            ((GAS unsigned long long*)(dstb + (size_t)row * W))[lane + 64 * t] = (unsigned long long)pk2(v.x, v.y) | ((unsigned long long)pk2(v.z, v.w) << 32);
            if (o) ((GAS f32x4*)o)[lane + 64 * t] = v;
            if (kmax) { float q = (v.x * v.x + v.y * v.y) + (v.z * v.z + v.w * v.w);
#pragma unroll
                for (int d = 1; d < 16; d <<= 1) q += __shfl_xor(q, d);
                qm = fmaxf(qm, q); } }
        if (kmax) { qm = wave_max(qm); if (lane == 0) __hip_atomic_fetch_max(kmax, __float_as_uint(qm), __ATOMIC_RELAXED, __HIP_MEMORY_SCOPE_AGENT); }
    }
}
__device__ __forceinline__ void p0_prologue(Frame& F, const Args& a) {
    LAS float* scr = (LAS float*)(F.lds + RING_OFF + F.wave * 16384);
    const int gw = F.vcu * NWAVES + F.wave, NGW = F.G * NWAVES;
    unsigned char* ws = a.ws;
    constexpr int I_INA = (DM / 64) * (NIN_A / 32), I_O = (DM / 64) * (DM / 32), I_INB = (DM / 64) * (NIN_B / 32);
    constexpr int NITEMS = I_INA + I_O + I_INB + I_O;
    for (int it = gw; it < NITEMS; it += NGW) {
        int r = it;
        if (r < I_INA) { p0_transpose_item(a.in[8], DM, NIN_A, (bf16*)(ws + WS_WINA), true, nullptr, scr, r, F.lane); continue; } r -= I_INA;
        if (r < I_O) { p0_transpose_item(a.in[12], DM, DM, (bf16*)(ws + WS_WOUTA), false, nullptr, scr, r, F.lane); continue; } r -= I_O;
        if (r < I_INB) { p0_transpose_item(a.in[14], DM, NIN_B, (bf16*)(ws + WS_WINB), true, a.in[13], scr, r, F.lane); continue; } r -= I_INB;
        p0_transpose_item(a.in[18], DM, DM, (bf16*)(ws + WS_WOUTB), false, nullptr, scr, r, F.lane);
    }
    bf16* XN = (bf16*)(ws + WS_XN);
    for (int m = gw; m < M; m += NGW) rms_row_to_bf16(m < SEQ ? a.in[0] + (size_t)m * DM : a.in[1] + (size_t)(m - SEQ) * DM, a.in[7], XN + (size_t)m * DM, F.lane);
    for (int r = gw; r < NB * 128; r += NGW) {
        cache_row<128>(a.in[2], (bf16*)(ws + WS_CKA), a.out + O_KAS, 128, r, F.ctl + CW_KMAX_A, F.lane);
        cache_row<128>(a.in[3], (bf16*)(ws + WS_CVA), a.out + O_VAS, 128, r, nullptr, F.lane);
    }
    for (int r = gw; r < NB * 512; r += NGW) {
        cache_row<1024>(a.in[4], (bf16*)(ws + WS_CKB), a.out + O_KBS, 512, r, F.ctl + CW_KMAX_B, F.lane);
        cache_row<1024>(a.in[5], (bf16*)(ws + WS_CVB), a.out + O_VBS, 512, r, nullptr, F.lane);
    }
}

namespace attn {
using bf16x8 = __attribute__((ext_vector_type(8))) short;
using s16x4 = __attribute__((ext_vector_type(4))) short;
using f32x16 = __attribute__((ext_vector_type(16))) float;
using u32x4 = pg8::u32x4;
typedef short v4i16_t __attribute__((ext_vector_type(4)));
typedef __attribute__((address_space(3))) const char* lds_cptr;
__device__ __forceinline__ int crow(int r, int hi) { return (r & 3) + 8 * (r >> 2) + 4 * hi; }
__device__ __forceinline__ s16x4 vtr(lds_cptr p) { return __builtin_bit_cast(s16x4, __builtin_amdgcn_ds_read_tr16_b64_v4i16((__attribute__((address_space(3))) v4i16_t*)p)); }
__device__ __forceinline__ unsigned cvtpk(float lo, float hi) { unsigned r; asm volatile("v_cvt_pk_bf16_f32 %0, %1, %2" : "=v"(r) : "v"(lo), "v"(hi)); return r; }
__device__ __forceinline__ int t5_bucket(int rel) {
    const int n = rel < 0 ? -rel : rel;
    int b = n;
    if (n >= 8) b = 8 + (n >= 12) + (n >= 16) + (n >= 23) + (n >= 32) + (n >= 46) + (n >= 64) + (n >= 91);
    return b + (rel > 0 ? 16 : 0);
}
__device__ __forceinline__ float bf2f(unsigned short h) { return __uint_as_float((unsigned)h << 16); }

template <int LAYER>
__device__ __forceinline__ void attn_phase(Frame& F, const Args& a) {
    constexpr int P = LAYER == 0 ? 2 : 8;
    constexpr int KVW = LAYER == 0 ? 128 : 1024;
    constexpr int L = P * 64;
    constexpr int RT0 = LAYER == 0 ? 0 : 6;
    unsigned char* ws = a.ws;
    const bf16* Q = (const bf16*)(ws + (LAYER == 0 ? WS_QA : WS_QB));
    const bf16* Kg = (const bf16*)(ws + (LAYER == 0 ? WS_KA : WS_KB));
    const bf16* Vg = (const bf16*)(ws + (LAYER == 0 ? WS_VA : WS_VB));
    const bf16* Gt = (const bf16*)(ws + (LAYER == 0 ? WS_GA : WS_GB));
    const bf16* CK = (const bf16*)(ws + (LAYER == 0 ? WS_CKA : WS_CKB));
    const bf16* CV = (const bf16*)(ws + (LAYER == 0 ? WS_CVA : WS_CVB));
    bf16* O = (bf16*)(ws + (LAYER == 0 ? WS_QA : WS_QB));
    const float* qg = a.in[LAYER == 0 ? 9 : 15]; const float* kg = a.in[LAYER == 0 ? 10 : 16];
    const float* table = a.in[LAYER == 0 ? 6 : 17];
    int tid_ = threadIdx.x; asm volatile("" : "+v"(tid_));
    const int tid = tid_, lane = tid & 63, wid = __builtin_amdgcn_readfirstlane(tid >> 6), r32 = lane & 31, hi = lane >> 5;
    const int h = F.vcu >> 4, sub = F.vcu & 15;
    const int kvh = LAYER == 0 ? (h >> 3) : h;
    LAS unsigned char* lds = F.lds + RING_OFF;
    float gqm = wave_max(fabsf(qg[lane])), gkm = wave_max(fabsf(kg[lane]));
    float bm = -1e30f;
    if (LAYER == 0) { if (lane < 32) bm = table[lane * 16 + h]; }
    else { for (int i = lane; i < 257; i += 64) bm = fmaxf(bm, table[h * 257 + i]); }
    bm = wave_max(bm);
    const float kc = sqrtf(__uint_as_float(__hip_atomic_load(F.ctl + (LAYER == 0 ? CW_KMAX_A : CW_KMAX_B), __ATOMIC_RELAXED, __HIP_MEMORY_SCOPE_AGENT)));
    const float bound = gqm * fmaxf(8.f * gkm, kc) * 1.01f + bm;
    const float cconst = LAYER == 0 ? 0.f : (table[h * 257 + 256] - bound) * LOG2E;
    const float sinkp = LAYER == 0 ? __builtin_amdgcn_exp2f((a.in[11][h] - bound) * LOG2E) : 0.f;
    {
        LAS float* tab = (LAS float*)(lds + AT_TAB);
        for (int i = tid; i < 3 * 2 * 8 * 64 * 4; i += NWAVES * 64) {
            const int e = i & 3, ln = (i >> 2) & 63, q4 = (i >> 8) & 7, half = (i >> 11) & 1, rtv = i >> 12;
            const int R = 4 * q4 + e, key = 32 * (R >> 4) + crow(R & 15, ln >> 5), qi = 32 * half + (ln & 31), j = 64 * (RT0 + rtv) + key;
            float bv;
            if (LAYER == 0) bv = table[t5_bucket(j - (P * 64 + qi)) * 16 + h];
            else { int idx = P * 64 + qi - j; idx = idx < -128 ? -128 : (idx > 128 ? 128 : idx); bv = table[h * 257 + idx + 128]; }
            tab[i] = (bv - bound) * LOG2E;
        }
    }
    __syncthreads();
    const int cw = wid >> 1, half = wid & 1;
    const lds_cptr lds3 = (lds_cptr)lds;
    const lds_cptr kp0 = lds3 + AT_SLOT + hi * 1024 + r32 * 16;
    const lds_cptr vp0 = lds3 + AT_SLOT + 8192 + ((lane >> 4) & 1) * 32 + (lane & 3) * 8 + (4 * hi + ((lane & 15) >> 2)) * 64;
    const LAS f32x4* tabl = (const LAS f32x4*)(lds + AT_TAB) + lane;
    LAS float* wsf = (LAS float*)(lds + AT_WSF) + wid * 64;
    for (int ui = 0; ui < 5; ++ui) {
        const bool sample = ui == 4;
        const int u0 = 4 * (4 * sub + ui);
        const int nt = sample ? P + 1 : P + 4;
        const int t_begin = sample ? 0 : (u0 >= P ? 0 : P - u0);
        const bool wave_on = !sample || cw == 0;
        const size_t qtok = sample ? (size_t)SEQ + 64 * sub + 32 * half : (size_t)64 * (u0 + cw) + 32 * half;
        const size_t koff = (size_t)lane * KVW + kvh * 64 + wid * 8, voff = (size_t)(16 * (wid & 3) + (lane >> 2)) * KVW + kvh * 64 + (wid >> 2) * 32 + (lane & 3) * 8;
#define TILE_DMA(t) do { const bf16 *kb_, *vb_; \
            if (!sample) { const size_t r0_ = (size_t)64 * (u0 - P + (t)) * KVW; kb_ = Kg + r0_; vb_ = Vg + r0_; } \
            else if ((t) < P) { const size_t r0_ = ((size_t)sub * L + 64 * (t)) * KVW; kb_ = CK + r0_; vb_ = CV + r0_; } \
            else { const size_t r0_ = ((size_t)SEQ + 64 * sub) * KVW; kb_ = Kg + r0_; vb_ = Vg + r0_; } \
            LAS unsigned char* s_ = lds + AT_SLOT + ((t) & 1) * AT_SLOTB + wid * 1024; \
            __builtin_amdgcn_global_load_lds((const unsigned*)(kb_ + koff), (LAS unsigned*)s_, 16, 0, 0); \
            __builtin_amdgcn_global_load_lds((const unsigned*)(vb_ + voff), (LAS unsigned*)(s_ + 8192), 16, 0, 0); } while (0)
        TILE_DMA(t_begin);
        bf16x8 qr[4];
#pragma unroll
        for (int d0 = 0; d0 < 4; ++d0) qr[d0] = wave_on ? *(const bf16x8*)(Q + (qtok + r32) * DM + h * 64 + d0 * 16 + hi * 8) : (bf16x8){0, 0, 0, 0, 0, 0, 0, 0};
        f32x16 o[2]; o[0] = f32x16{}; o[1] = f32x16{};
        float l_reg = 0.f;
        asm volatile("s_waitcnt vmcnt(0)" ::: "memory");
        __syncthreads();
        for (int t = t_begin; t < nt; ++t) {
            if (t + 1 < nt) TILE_DMA(t + 1);
            const int rt = t - cw;
            if (wave_on && rt >= 0 && rt <= P) {
                const int so = (t & 1) * AT_SLOTB;
                f32x16 p0, p1;
                if (rt >= RT0) { const LAS f32x4* tp = tabl + ((rt - RT0) * 2 + half) * 8 * 64;
#pragma unroll
                    for (int q4 = 0; q4 < 4; ++q4) { const f32x4 c0 = tp[q4 * 64], c1 = tp[(q4 + 4) * 64];
#pragma unroll
                        for (int e = 0; e < 4; ++e) { p0[4 * q4 + e] = c0[e]; p1[4 * q4 + e] = c1[e]; } } }
                else {
#pragma unroll
                    for (int r = 0; r < 16; ++r) { p0[r] = cconst; p1[r] = cconst; } }
                const lds_cptr kp = kp0 + so;
#pragma unroll
                for (int d0 = 0; d0 < 4; ++d0) {
                    const bf16x8 b0 = *(const __attribute__((address_space(3))) bf16x8*)(kp + d0 * 2048);
                    const bf16x8 b1 = *(const __attribute__((address_space(3))) bf16x8*)(kp + d0 * 2048 + 512);
                    p0 = __builtin_amdgcn_mfma_f32_32x32x16_bf16(b0, qr[d0], p0, 0, 0, 0);
                    p1 = __builtin_amdgcn_mfma_f32_32x32x16_bf16(b1, qr[d0], p1, 0, 0, 0);
                }
                float sacc = 0.f;
#pragma unroll
                for (int r = 0; r < 16; ++r) { p0[r] = __builtin_amdgcn_exp2f(p0[r]); p1[r] = __builtin_amdgcn_exp2f(p1[r]); sacc += p0[r] + p1[r]; }
                l_reg += sacc;
                u32x4 pw[4];
#pragma unroll
                for (int s = 0; s < 2; ++s)
#pragma unroll
                    for (int i = 0; i < 4; ++i) { pw[s][i] = cvtpk(p0[8 * s + 2 * i], p0[8 * s + 2 * i + 1]); pw[2 + s][i] = cvtpk(p1[8 * s + 2 * i], p1[8 * s + 2 * i + 1]); }
                const lds_cptr vp = vp0 + so;
#pragma unroll
                for (int d0 = 0; d0 < 2; ++d0)
#pragma unroll
                    for (int ks = 0; ks < 4; ++ks) {
                        const s16x4 lo = vtr(vp + d0 * 4096 + ks * 1024), hh = vtr(vp + d0 * 4096 + ks * 1024 + 512);
                        const bf16x8 vf = (bf16x8){lo[0], lo[1], lo[2], lo[3], hh[0], hh[1], hh[2], hh[3]};
                        o[d0] = __builtin_amdgcn_mfma_f32_32x32x16_bf16(__builtin_bit_cast(bf16x8, pw[ks]), vf, o[d0], 0, 0, 0);
                    }
            }
            asm volatile("s_waitcnt vmcnt(0)" ::: "memory");
            __syncthreads();
        }
#undef TILE_DMA
        if (wave_on) {
            l_reg += __shfl_xor(l_reg, 32);
            l_reg += sinkp;
            if (hi == 0) wsf[r32] = l_reg;
            LDS_WAIT(); asm volatile("" ::: "memory");
            LAS unsigned short* stg = (LAS unsigned short*)(lds + AT_OST) + wid * 2048;
#pragma unroll
            for (int r = 0; r < 16; ++r) { const int orow = crow(r, hi); const float rl = __builtin_amdgcn_rcpf(wsf[orow]);
#pragma unroll
                for (int d0 = 0; d0 < 2; ++d0) stg[orow * 64 + d0 * 32 + r32] = (unsigned short)(f2bf(o[d0][r] * rl)); }
            LDS_WAIT(); asm volatile("" ::: "memory");
#pragma unroll
            for (int i = 0; i < 4; ++i) { const int row = i * 8 + (lane >> 3), ch = lane & 7;
                const v4u ov = *(const LAS v4u*)(stg + row * 64 + ch * 8);
                const size_t go = (qtok + row) * DM + h * 64 + ch * 8;
                const v4u gvv = *(const GAS v4u*)(Gt + go);
                v4u res;
#pragma unroll
                for (int e = 0; e < 4; ++e) { const float a0 = __uint_as_float(ov[e] << 16) * __uint_as_float(gvv[e] << 16), a1 = __uint_as_float(ov[e] & 0xffff0000u) * __uint_as_float(gvv[e] & 0xffff0000u); res[e] = cvtpk(a0, a1); }
                *(GAS v4u*)(O + go) = res; }
        }
        __syncthreads();
    }
}
}

__global__ void __launch_bounds__(NWAVES * 64, 2) mk_fwd(Args args) {
    extern __shared__ __attribute__((aligned(16))) unsigned char lds[];
    Frame F;
    F.lds = (LAS unsigned char*)lds;
    F.MISC = (volatile LAS unsigned*)(F.lds + MISC_OFF);
    F.tid = threadIdx.x; F.lane = F.tid & 63; F.wave = __builtin_amdgcn_readfirstlane(F.tid >> 6);
    F.G = gridDim.x; { const int bx = blockIdx.x; F.vcu = (F.G % 8 == 0) ? (bx % 8) * (F.G / 8) + bx / 8 : bx; }
    unsigned char* ws = args.ws;
    F.ctl = (gu32*)(ws + WS_CTL);
    for (int u = F.tid; u < (LDS_BYTES - LDSCTL_OFF) / 4; u += NWAVES * 64) ((LAS unsigned*)(F.lds + LDSCTL_OFF))[u] = 0u;
    __syncthreads();
    XcdBarrier bar = xcd_barrier_post((unsigned*)(F.ctl + CW_BAR), F.MISC + 8);
    bf16* XN = (bf16*)(ws + WS_XN);
    float* slab = (float*)(ws + WS_SLAB);
    float* out = args.out;

    p0_prologue(F, args);
    xcd_barrier(bar);
    {
        pg8::Gemm g{XN, (const bf16*)(ws + WS_WINA), M, NIN_A, DM}; pg8::StaticOrder S; S.init(M, NIN_A, F.G, (int)blockIdx.x);
        pg8::EpiIn E{0, (bf16*)(ws + WS_QA), (bf16*)(ws + WS_KA), (bf16*)(ws + WS_VA), (bf16*)(ws + WS_GA), 128, args.in[9], args.in[10], nullptr,
                     out + O_KAP, out + O_VAP, out + O_KAS, out + O_VAS, 128, 2, C2};
        pg8::gemm_phase<pg8::EpiIn, pg8::StaticOrder, true, true>(F.lds + RING_OFF, g, S, E);
    }
    xcd_barrier(bar);
    attn::attn_phase<0>(F, args);
    xcd_barrier(bar);
    {
        pg8::Gemm g{(const bf16*)(ws + WS_QA), (const bf16*)(ws + WS_WOUTA), M, DM, DM}; pg8::StaticOrder S; S.init(M, DM, F.G, (int)blockIdx.x);
        pg8::EpiOut E{args.in[0], args.in[1], out + O_Y, XN, slab};
        pg8::gemm_phase<pg8::EpiOut, pg8::StaticOrder, true, true>(F.lds + RING_OFF, g, S, E);
    }
    xcd_barrier(bar);
    {
        pg8::Gemm g{XN, (const bf16*)(ws + WS_WINB), M, NIN_B, DM}; pg8::StaticOrder S; S.init(M, NIN_B, F.G, (int)blockIdx.x);
        pg8::EpiIn E{1, (bf16*)(ws + WS_QB), (bf16*)(ws + WS_KB), (bf16*)(ws + WS_VB), (bf16*)(ws + WS_GB), 1024, args.in[15], args.in[16], slab,
                     out + O_KBP, out + O_VBP, out + O_KBS, out + O_VBS, 512, 16, C2};
        pg8::gemm_phase<pg8::EpiIn, pg8::StaticOrder, true, true>(F.lds + RING_OFF, g, S, E);
    }
    xcd_barrier(bar);
    attn::attn_phase<1>(F, args);
    xcd_barrier(bar);
    {
        pg8::Gemm g{(const bf16*)(ws + WS_QB), (const bf16*)(ws + WS_WOUTB), M, DM, DM}; pg8::StaticOrder S; S.init(M, DM, F.G, (int)blockIdx.x);
        pg8::EpiOut E{out + O_Y, out + O_Y + (size_t)SEQ * DM, out + O_Y, nullptr, nullptr};
        pg8::gemm_phase<pg8::EpiOut, pg8::StaticOrder, true, true>(F.lds + RING_OFF, g, S, E);
    }
}

extern "C" void kernel_launch(void* const* d_in, const int* in_sizes, int n_in, void* d_out, int out_size, void* d_ws, size_t ws_size, hipStream_t stream) {
    static int grid = 0;
    if (grid == 0) {
        if (n_in != 19 || out_size != (int)O_END || ws_size < WS_END) { fprintf(stderr, "kernel_launch: unexpected shapes (n_in %d, out %d, ws %zu)\n", n_in, out_size, ws_size); grid = -1; return; }
        int dev = 0, cus = 0, per_cu = 0;
        if (hipGetDevice(&dev) != hipSuccess || hipDeviceGetAttribute(&cus, hipDeviceAttributeMultiprocessorCount, dev) != hipSuccess) { grid = -1; return; }
        if (hipFuncSetAttribute((const void*)mk_fwd, hipFuncAttributeMaxDynamicSharedMemorySize, LDS_BYTES) != hipSuccess) { fprintf(stderr, "kernel_launch: hipFuncSetAttribute failed\n"); grid = -1; return; }
        if (hipOccupancyMaxActiveBlocksPerMultiprocessor(&per_cu, (const void*)mk_fwd, NWAVES * 64, LDS_BYTES) != hipSuccess || per_cu < 1) { fprintf(stderr, "kernel_launch: occupancy query says %d blocks per CU\n", per_cu); }
        (void)hipGetLastError();
        grid = cus;
        if (grid != 256) { fprintf(stderr, "kernel_launch: built for 256 CUs, found %d\n", cus); grid = -1; return; }
    }
    if (grid < 0) return;
    (void)hipMemsetAsync((char*)d_ws + WS_CTL, 0, CTL_ZERO_BYTES, stream);
    Args a{};
    for (int i = 0; i < 19; ++i) a.in[i] = (const float*)d_in[i];
    a.out = (float*)d_out; a.ws = (unsigned char*)d_ws;
    hipLaunchKernelGGL(mk_fwd, dim3(grid), dim3(NWAVES * 64), LDS_BYTES, stream, a);
}
```

```cpp
#include <hip/hip_runtime.h>
#include <cstdio>
#include <cstdint>
#include <cmath>
namespace pg8 {
#define PG8_LAS __attribute__((address_space(3)))
typedef unsigned short bf16_t;
typedef short bf16x8 __attribute__((ext_vector_type(8)));
typedef float f32x4 __attribute__((ext_vector_type(4)));
typedef unsigned u32x4 __attribute__((ext_vector_type(4)));
constexpr int BM = 256, BK = 64, HALF = 128, HTB = HALF * BK * 2  , STAGE_BYTES = 8 * HTB, NXCD = 8, WGM = 8;

__host__ __device__ __forceinline__ int lds_byte(int r, int c) { const int st = (r >> 4) * 2 + (c >> 5), rr = r & 15, cc = c & 31, ob = rr * 64 + cc * 2; return st * 1024 + (ob ^ (((ob >> 9) & 1) << 5)); }
__host__ __device__ __forceinline__ void stage_rc(int b, int& R, int& C) { const int st = b / 1024, sb = b % 1024, swz = sb ^ (((sb >> 9) & 1) << 5); R = (st >> 1) * 16 + swz / 64; C = (st & 1) * 32 + (swz % 64) / 2; }
__host__ __device__ __forceinline__ int perm32(int rho) { const int n = rho >> 4, i = rho & 15; return 8 * (i >> 2) + 4 * n + (i & 3); }

struct Unit { int pm, pn; };
struct Gemm { const bf16_t* A; const bf16_t* Bt; int M, N, K; };

struct StaticOrder {
    int nM, nN, nwg, G, c;
    __host__ __device__ void init(int M, int N, int G_, int c_) { nM = M / BM; nN = N / BM; nwg = nM * nN; G = G_; c = c_; }
    __host__ __device__ bool next(int i, Unit& u) const {
        const long L = (long)i * G + c; if (L >= nwg) return false;
        int wgid = (int)L; { const int q = nwg / NXCD, r = nwg % NXCD, xcd = wgid % NXCD, off = wgid / NXCD; wgid = (xcd < r ? xcd * (q + 1) : r * (q + 1) + (xcd - r) * q) + off; }
        const int nig = WGM * nN, gid = wgid / nig, fm = gid * WGM, gsz = (nM - fm) < WGM ? (nM - fm) : WGM;
        u.pm = fm + ((wgid % nig) % gsz); u.pn = (wgid % nig) / gsz; return true;
    }
    __device__ __forceinline__ void a_ready(const Unit&) const {}
    __device__ __forceinline__ void done(const Unit&) const {}
};
__device__ __forceinline__ unsigned cvt_pk_bf16(float lo, float hi) { unsigned r; asm volatile("v_cvt_pk_bf16_f32 %0, %1, %2" : "=v"(r) : "v"(lo), "v"(hi)); return r; }
__device__ __forceinline__ void st16_wt(void* p, u32x4 v) { asm volatile("global_store_dwordx4 %0, %1, off sc1\n\ts_nop 1" :: "v"(p), "v"(v) : "memory"); }
constexpr int SEQ_ = 16384;
constexpr float NORM_EPS = 1e-6f;
struct EpiIn {
    static constexpr bool PERM = true, AFTER_DRAIN = false;
    int layer;
    bf16_t *Q, *Kb, *Vb, *G; int kvw;
    const float *qg, *kg;
    const float* slab;
    float *okp, *ovp, *oks, *ovs; int keep, nkv;
    float c2;
    PG8_LAS float* rstd_lds;
    template <int TYPE>
    __device__ __forceinline__ void tile(const f32x4 (&acc)[2][2][4][2], int row0, int rl0, int dcol, int fq, bf16_t* dst, int ld, const float* gp, float sc, float* o_p, float* o_s, int head) const {
        f32x4 gv[2][2];
        if (TYPE < 2) {
#pragma unroll
            for (int bj = 0; bj < 2; ++bj)
#pragma unroll
                for (int n = 0; n < 2; ++n) gv[bj][n] = *(const f32x4*)(gp + 32 * bj + dcol + 4 * n) * sc; }
#pragma unroll
        for (int ai = 0; ai < 2; ++ai)
#pragma unroll
            for (int m = 0; m < 4; ++m) {
                const int row = row0 + ai * HALF + m * 16;
                const float rs = slab ? rstd_lds[ai * HALF + rl0 + m * 16] : 1.f;
                f32x4 v[2][2];
#pragma unroll
                for (int bj = 0; bj < 2; ++bj)
#pragma unroll
                    for (int n = 0; n < 2; ++n) v[bj][n] = acc[ai][bj][m][n] * rs;
                if (TYPE < 2) {
                    float ss = 0.f;
#pragma unroll
                    for (int bj = 0; bj < 2; ++bj)
#pragma unroll
                        for (int n = 0; n < 2; ++n) { const f32x4 x = v[bj][n]; ss += (x[0] * x[0] + x[1] * x[1]) + (x[2] * x[2] + x[3] * x[3]); }
                    ss += __shfl_xor(ss, 16); ss += __shfl_xor(ss, 32);
                    const float r = rsqrtf(ss * (1.f / 64.f) + NORM_EPS);
#pragma unroll
                    for (int bj = 0; bj < 2; ++bj)
#pragma unroll
                        for (int n = 0; n < 2; ++n) v[bj][n] = v[bj][n] * r * gv[bj][n];
                } else if (TYPE == 3) {
#pragma unroll
                    for (int bj = 0; bj < 2; ++bj)
#pragma unroll
                        for (int n = 0; n < 2; ++n)
#pragma unroll
                            for (int e = 0; e < 4; ++e) { const float x = v[bj][n][e]; v[bj][n][e] = x * __builtin_amdgcn_rcpf(1.f + __builtin_amdgcn_exp2f(-1.4426950408889634f * x)); }
                }
                if ((TYPE == 1 || TYPE == 2) && row >= SEQ_ - keep) {
                    float* op;
                    if (row < SEQ_) op = o_p + ((size_t)(row - (SEQ_ - keep)) * nkv + head) * 64 + dcol;
                    else { const int r_ = row - SEQ_; op = o_s + (((size_t)(r_ >> 6) * keep + (keep - 64) + (r_ & 63)) * nkv + head) * 64 + dcol; }
#pragma unroll
                    for (int bj = 0; bj < 2; ++bj) { *(f32x4*)(op + 32 * bj) = v[bj][0]; *(f32x4*)(op + 32 * bj + 4) = v[bj][1]; }
                }
#pragma unroll
                for (int bj = 0; bj < 2; ++bj) { u32x4 w; w.x = cvt_pk_bf16(v[bj][0][0], v[bj][0][1]); w.y = cvt_pk_bf16(v[bj][0][2], v[bj][0][3]); w.z = cvt_pk_bf16(v[bj][1][0], v[bj][1][1]); w.w = cvt_pk_bf16(v[bj][1][2], v[bj][1][3]);
                    st16_wt(dst + (size_t)row * ld + 32 * bj, w); }
            }
    }
    __device__ __forceinline__ void operator()(const f32x4 (&acc)[2][2][4][2], const Unit& u, int wr, int wc, int fr, int fq) const {
        int type, head;
        if (layer == 0) { if (u.pn < 4) { type = 0; head = 4 * u.pn + wc; } else if (u.pn == 4) { type = wc < 2 ? 1 : 2; head = wc & 1; } else { type = 3; head = 4 * (u.pn - 5) + wc; } }
        else { type = u.pn >> 2; head = 4 * (u.pn & 3) + wc; }
        const int row0 = u.pm * BM + wr * 64 + fr, rl0 = wr * 64 + fr, dcol = 8 * fq, co = head * 64 + dcol;
        if (slab) {
            const int t = threadIdx.x;
            if (t < BM) { const f32x4* sp = (const f32x4*)(slab + (size_t)(u.pm * BM + t) * 16); const f32x4 a = sp[0], b = sp[1], c = sp[2], d = sp[3];
                const f32x4 s = (a + b) + (c + d); rstd_lds[t] = rsqrtf(((s[0] + s[1]) + (s[2] + s[3])) * (1.f / 1024.f) + NORM_EPS); }
            asm volatile("s_waitcnt lgkmcnt(0)\n\ts_barrier" ::: "memory");
        }
        if (type == 0) tile<0>(acc, row0, rl0, dcol, fq, Q + co, 1024, qg, c2, nullptr, nullptr, head);
        else if (type == 1) tile<1>(acc, row0, rl0, dcol, fq, Kb + co, kvw, kg, 1.f, okp, oks, head);
        else if (type == 2) tile<2>(acc, row0, rl0, dcol, fq, Vb + co, kvw, nullptr, 1.f, ovp, ovs, head);
        else tile<3>(acc, row0, rl0, dcol, fq, G + co, 1024, nullptr, 1.f, nullptr, nullptr, head);
    }
};
struct EpiOut {
    static constexpr bool PERM = true, AFTER_DRAIN = false;
    int layer;
    const float *base_p, *base_s;
    bf16_t* yb;
    float* out;
    float* slab;
    __device__ __forceinline__ void operator()(const f32x4 (&acc)[2][2][4][2], const Unit& u, int wr, int wc, int fr, int fq) const {
        const int row0 = u.pm * BM + wr * 64 + fr, col0 = u.pn * BM + wc * 32 + 8 * fq;
        if (layer == 0) {
#pragma unroll
            for (int ai = 0; ai < 2; ++ai) {
                f32x4 b[4][2][2];
#pragma unroll
                for (int m = 0; m < 4; ++m) { const int row = row0 + ai * HALF + m * 16;
                    const float* bp = (row < SEQ_ ? base_p + (size_t)row * 1024 : base_s + (size_t)(row - SEQ_) * 1024) + col0;
#pragma unroll
                    for (int bj = 0; bj < 2; ++bj) { b[m][bj][0] = *(const f32x4*)(bp + bj * HALF); b[m][bj][1] = *(const f32x4*)(bp + bj * HALF + 4); } }
#pragma unroll
                for (int m = 0; m < 4; ++m) { const int row = row0 + ai * HALF + m * 16; float ss = 0.f;
#pragma unroll
                    for (int bj = 0; bj < 2; ++bj) { const f32x4 y0 = acc[ai][bj][m][0] + b[m][bj][0], y1 = acc[ai][bj][m][1] + b[m][bj][1];
                        ss += ((y0[0] * y0[0] + y0[1] * y0[1]) + (y0[2] * y0[2] + y0[3] * y0[3])) + ((y1[0] * y1[0] + y1[1] * y1[1]) + (y1[2] * y1[2] + y1[3] * y1[3]));
                        u32x4 w; w.x = cvt_pk_bf16(y0[0], y0[1]); w.y = cvt_pk_bf16(y0[2], y0[3]); w.z = cvt_pk_bf16(y1[0], y1[1]); w.w = cvt_pk_bf16(y1[2], y1[3]);
                        *(u32x4*)(yb + (size_t)row * 1024 + col0 + bj * HALF) = w; }
                    ss += __shfl_xor(ss, 16); ss += __shfl_xor(ss, 32); if (fq == 0) slab[(size_t)row * 16 + 4 * u.pn + wc] = ss; }
            }
        } else {
#pragma unroll
            for (int ai = 0; ai < 2; ++ai) {
                u32x4 b[4][2];
#pragma unroll
                for (int m = 0; m < 4; ++m) { const int row = row0 + ai * HALF + m * 16;
#pragma unroll
                    for (int bj = 0; bj < 2; ++bj) b[m][bj] = *(const u32x4*)(yb + (size_t)row * 1024 + col0 + bj * HALF); }
#pragma unroll
                for (int m = 0; m < 4; ++m) { const int row = row0 + ai * HALF + m * 16; float* op = out + (size_t)row * 1024 + col0;
#pragma unroll
                    for (int bj = 0; bj < 2; ++bj) { const u32x4 w = b[m][bj];
                        const f32x4 r0 = {__uint_as_float(w.x << 16), __uint_as_float(w.x & 0xffff0000u), __uint_as_float(w.y << 16), __uint_as_float(w.y & 0xffff0000u)};
                        const f32x4 r1 = {__uint_as_float(w.z << 16), __uint_as_float(w.z & 0xffff0000u), __uint_as_float(w.w << 16), __uint_as_float(w.w & 0xffff0000u)};
                        *(f32x4*)(op + bj * HALF) = acc[ai][bj][m][0] + r0; *(f32x4*)(op + bj * HALF + 4) = acc[ai][bj][m][1] + r1; } }
            }
        }
    }
};
template <class Epi, class Sched, bool ALIGN_EPI = false, bool SP2 = false>
__device__ __forceinline__ void gemm_phase(PG8_LAS unsigned char* lds, const Gemm g, const Sched& S, const Epi& E, unsigned long long* tepi = nullptr) {
    int tid_ = threadIdx.x; asm volatile("" : "+v"(tid_));
    const int tid = tid_, wid = __builtin_amdgcn_readfirstlane(tid >> 6), lane = tid & 63, wr = wid >> 2, wc = wid & 3, fr = lane & 15, fq = lane >> 4;
    const int K = g.K, nt = K / BK;
    unsigned voffA[2], voffB[2];
#pragma unroll
    for (int i = 0; i < 2; ++i) { int R, C; stage_rc(tid * 16 + i * 8192, R, C); const int Rb = Epi::PERM ? ((R & ~31) + perm32(R & 31)) : R;
        voffA[i] = (unsigned)(R * K + C) * 2u; voffB[i] = (unsigned)(Rb * K + C) * 2u; }
    const size_t kstep = (size_t)(BK * 2);
    const size_t hstep = (size_t)HALF * K * 2;
    const size_t tstep = 2 * hstep;
    const unsigned ldsw = (unsigned)wid * 1024u;
    const int aoff = lds_byte(wr * 64 + fr, fq * 8), boff = lds_byte(wc * 32 + fr, fq * 8);
#define PG8_SA(b, h) (((b) * 2 + (h)) * HTB)
#define PG8_SB(b, h) ((4 + (b) * 2 + (h)) * HTB)
#define PG8_STAGE(bufoff, gbase, voff) do { _Pragma("unroll") for (int _i = 0; _i < 2; ++_i) \
        __builtin_amdgcn_global_load_lds((const unsigned*)((const char*)(gbase) + (voff)[_i]), (PG8_LAS unsigned*)(lds + (bufoff) + ldsw + _i * 8192), 16, 0, 0); } while (0)
#define PG8_LDA(dst, b, h) do { _Pragma("unroll") for (int m = 0; m < 4; ++m) _Pragma("unroll") for (int k = 0; k < 2; ++k) dst[m][k] = *(const PG8_LAS bf16x8*)(lds + PG8_SA(b, h) + aoff + m * 2048 + k * 1024); } while (0)
#define PG8_LDB(dst, b, h) do { _Pragma("unroll") for (int n = 0; n < 2; ++n) _Pragma("unroll") for (int k = 0; k < 2; ++k) dst[n][k] = *(const PG8_LAS bf16x8*)(lds + PG8_SB(b, h) + boff + n * 2048 + k * 1024); } while (0)
#define PG8_MMA(ai, bj, At, Bt) do { __builtin_amdgcn_s_setprio(1); _Pragma("unroll") for (int m = 0; m < 4; ++m) _Pragma("unroll") for (int n = 0; n < 2; ++n) _Pragma("unroll") for (int k = 0; k < 2; ++k) \
        acc[ai][bj][m][n] = __builtin_amdgcn_mfma_f32_16x16x32_bf16(Bt[n][k], At[m][k], acc[ai][bj][m][n], 0, 0, 0); __builtin_amdgcn_s_setprio(0); } while (0)
#define PG8_WAIT_V(n) asm volatile("s_waitcnt vmcnt(" #n ")" ::: "memory")
#define PG8_WAIT_L(n) asm volatile("s_waitcnt lgkmcnt(" #n ")" ::: "memory")
#define PG8_BAR __builtin_amdgcn_s_barrier()
#define PG8_SCHED __builtin_amdgcn_sched_barrier(0)
    Unit cur, nxt; int ui = 0;
    if (!S.next(0, cur)) return;
    f32x4 acc[2][2][4][2];
#pragma unroll
    for (int a = 0; a < 2; ++a)
#pragma unroll
        for (int b = 0; b < 2; ++b)
#pragma unroll
            for (int m = 0; m < 4; ++m)
#pragma unroll
                for (int n = 0; n < 2; ++n) acc[a][b][m][n] = (f32x4){0.f, 0.f, 0.f, 0.f};
    bf16x8 At[4][2], B0[2][2], B1[2][2];
    const char* cA = (const char*)g.A + (size_t)cur.pm * tstep; const char* cB = (const char*)g.Bt + (size_t)cur.pn * tstep;
    S.a_ready(cur);
    if constexpr (SP2) {
        PG8_STAGE(PG8_SB(0, 0), cB, voffB); PG8_STAGE(PG8_SB(0, 1), cB + hstep, voffB); PG8_STAGE(PG8_SA(0, 0), cA, voffA); PG8_STAGE(PG8_SA(0, 1), cA + hstep, voffA);
        if (wr == 1) PG8_BAR;
        PG8_WAIT_V(2); PG8_BAR;
        PG8_STAGE(PG8_SB(1, 0), cB + kstep, voffB); PG8_STAGE(PG8_SA(1, 0), cA + kstep, voffA); PG8_STAGE(PG8_SB(1, 1), cB + hstep + kstep, voffB);
        PG8_WAIT_V(6); PG8_BAR;
    } else {
        PG8_STAGE(PG8_SB(0, 0), cB, voffB); PG8_STAGE(PG8_SA(0, 0), cA, voffA); PG8_STAGE(PG8_SB(0, 1), cB + hstep, voffB); PG8_STAGE(PG8_SA(0, 1), cA + hstep, voffA);
        if (wr == 1) PG8_BAR;
        PG8_WAIT_V(4); PG8_BAR;
        PG8_STAGE(PG8_SB(1, 0), cB + kstep, voffB); PG8_STAGE(PG8_SA(1, 0), cA + kstep, voffA); PG8_STAGE(PG8_SB(1, 1), cB + hstep + kstep, voffB);
        PG8_WAIT_V(6); PG8_BAR;
    }
    for (;;) {
        const bool has_next = S.next(ui + 1, nxt);
        const char* nA = has_next ? (const char*)g.A + (size_t)nxt.pm * tstep : cA; const char* nB = has_next ? (const char*)g.Bt + (size_t)nxt.pn * tstep : cB;
        for (int t = 0; t < nt; t += 2) {
            const bool last = (t == nt - 2);
            const char* a1 = cA + (size_t)(t + 1) * kstep;
            const char* a2 = last ? nA : cA + (size_t)(t + 2) * kstep; const char* b2 = last ? nB : cB + (size_t)(t + 2) * kstep;
            const char* a3 = a2 + kstep; const char* b3 = b2 + kstep;
            if (last && has_next) S.a_ready(nxt);
            if constexpr (SP2) {
            PG8_LDB(B0, 0, 0); PG8_LDB(B1, 0, 1); PG8_SCHED; PG8_LDA(At, 0, 0); PG8_STAGE(PG8_SA(1, 1), a1 + hstep, voffA);
            PG8_WAIT_V(8); PG8_WAIT_L(0); PG8_BAR; PG8_MMA(0, 0, At, B0); PG8_MMA(0, 1, At, B1); PG8_BAR; PG8_SCHED;
            PG8_LDA(At, 0, 1); PG8_STAGE(PG8_SB(0, 0), b2, voffB); PG8_STAGE(PG8_SB(0, 1), b2 + hstep, voffB); PG8_STAGE(PG8_SA(0, 0), a2, voffA);
            PG8_WAIT_V(8); PG8_WAIT_L(0); PG8_BAR; PG8_MMA(1, 0, At, B0); PG8_MMA(1, 1, At, B1); PG8_BAR; PG8_SCHED;
            PG8_LDB(B0, 1, 0); PG8_LDB(B1, 1, 1); PG8_SCHED; PG8_LDA(At, 1, 0); PG8_STAGE(PG8_SA(0, 1), a2 + hstep, voffA);
            PG8_WAIT_V(8); PG8_WAIT_L(0); PG8_BAR; PG8_MMA(0, 0, At, B0); PG8_MMA(0, 1, At, B1); PG8_BAR; PG8_SCHED;
            PG8_LDA(At, 1, 1); PG8_STAGE(PG8_SB(1, 0), b3, voffB); PG8_STAGE(PG8_SB(1, 1), b3 + hstep, voffB); PG8_STAGE(PG8_SA(1, 0), a3, voffA);
            PG8_WAIT_V(8); PG8_WAIT_L(0); PG8_BAR; PG8_MMA(1, 0, At, B0); PG8_MMA(1, 1, At, B1); PG8_BAR; PG8_SCHED;
            } else {
            PG8_LDB(B0, 0, 0); PG8_SCHED; PG8_LDA(At, 0, 0); PG8_STAGE(PG8_SA(1, 1), a1 + hstep, voffA);
            PG8_WAIT_L(8); PG8_BAR; PG8_WAIT_L(0); PG8_MMA(0, 0, At, B0); PG8_BAR; PG8_SCHED;
            PG8_LDB(B1, 0, 1); PG8_STAGE(PG8_SB(0, 0), b2, voffB);
            PG8_BAR; PG8_WAIT_L(0); PG8_MMA(0, 1, At, B1); PG8_BAR;
            PG8_LDA(At, 0, 1); PG8_STAGE(PG8_SA(0, 0), a2, voffA);
            PG8_BAR; PG8_WAIT_L(0); PG8_MMA(1, 0, At, B0); PG8_BAR; PG8_SCHED;
            PG8_STAGE(PG8_SB(0, 1), b2 + hstep, voffB);
            PG8_WAIT_V(6); PG8_BAR; PG8_MMA(1, 1, At, B1); PG8_BAR;
            PG8_LDB(B0, 1, 0); PG8_SCHED; PG8_LDA(At, 1, 0); PG8_STAGE(PG8_SA(0, 1), a2 + hstep, voffA);
            PG8_WAIT_L(8); PG8_BAR; PG8_WAIT_L(0); PG8_MMA(0, 0, At, B0); PG8_BAR; PG8_SCHED;
            PG8_LDB(B1, 1, 1); PG8_STAGE(PG8_SB(1, 0), b3, voffB);
            PG8_BAR; PG8_WAIT_L(0); PG8_MMA(0, 1, At, B1); PG8_BAR;
            PG8_LDA(At, 1, 1); PG8_STAGE(PG8_SA(1, 0), a3, voffA);
            PG8_BAR; PG8_WAIT_L(0); PG8_MMA(1, 0, At, B0); PG8_BAR; PG8_SCHED;
            PG8_STAGE(PG8_SB(1, 1), b3 + hstep, voffB);
            PG8_WAIT_V(6); PG8_BAR; PG8_MMA(1, 1, At, B1); PG8_BAR;
            }
        }
        if constexpr (ALIGN_EPI) { if (wr == 0) PG8_BAR; }
        if constexpr (!Epi::AFTER_DRAIN) { unsigned long long te0_ = 0; if (tepi) te0_ = __builtin_amdgcn_s_memrealtime(); E(acc, cur, wr, wc, fr, fq); S.done(cur); if (tepi) *tepi += __builtin_amdgcn_s_memrealtime() - te0_; }
        if (!has_next) break;
#pragma unroll
        for (int a = 0; a < 2; ++a)
#pragma unroll
            for (int b = 0; b < 2; ++b)
#pragma unroll
                for (int m = 0; m < 4; ++m)
#pragma unroll
                    for (int n = 0; n < 2; ++n) acc[a][b][m][n] = (f32x4){0.f, 0.f, 0.f, 0.f};
        cur = nxt; cA = nA; cB = nB; ++ui;
        if constexpr (ALIGN_EPI) { if (wr == 1) PG8_BAR; }
    }
    PG8_WAIT_V(0);
    if constexpr (!ALIGN_EPI) { if (wr == 0) PG8_BAR; }
    PG8_BAR;
    if constexpr (Epi::AFTER_DRAIN) { E.fused(acc, cur, wr, wc, fr, fq, lds, wid, lane); S.done(cur); }
#undef PG8_SA
#undef PG8_SB
#undef PG8_STAGE
#undef PG8_LDA
#undef PG8_LDB
#undef PG8_MMA
#undef PG8_WAIT_V
#undef PG8_WAIT_L
#undef PG8_BAR
#undef PG8_SCHED
}
}
#define GAS __attribute__((address_space(1)))
#define LAS __attribute__((address_space(3)))
typedef unsigned short bf16;
typedef unsigned v4u __attribute__((ext_vector_type(4)));
typedef float f32x4 __attribute__((ext_vector_type(4)));
typedef short bf16x8 __attribute__((ext_vector_type(8)));
typedef GAS unsigned gu32;
typedef GAS unsigned long long gu64;
#define RLX_AGENT __ATOMIC_RELAXED, __HIP_MEMORY_SCOPE_AGENT
#define LDS_WAIT() asm volatile("s_waitcnt lgkmcnt(0)" ::: "memory")
#define VM_WAIT() asm volatile("s_waitcnt vmcnt(0)" ::: "memory")
__device__ __forceinline__ unsigned long long rt() { return __builtin_amdgcn_s_memrealtime(); }
__device__ __forceinline__ unsigned f2bf(float f) { unsigned u = __builtin_bit_cast(unsigned, f); return (u + 0x7fffu + ((u >> 16) & 1u)) >> 16; }
__device__ __forceinline__ unsigned pk2(float lo, float hi) { return f2bf(lo) | (f2bf(hi) << 16); }

#define XB_TMO      128
#define XB_XCNT(j)  (256  + 64 * (j))
#define XB_XSUB(j)  (1280 + 64 * (j))
#define XB_XGEN(j)  (2304 + 64 * (j))
#define XB_TOP      3328
#define XB_TOPGEN   3392
#define XCD_BAR_WORDS 3456
#define XB_SPIN_CAP (1u << 18)

__device__ __forceinline__ unsigned xb_ld(unsigned* p)              { return __hip_atomic_load(p, __ATOMIC_RELAXED, __HIP_MEMORY_SCOPE_AGENT); }
__device__ __forceinline__ unsigned xb_add(unsigned* p, unsigned v) { return __hip_atomic_fetch_add(p, v, __ATOMIC_RELAXED, __HIP_MEMORY_SCOPE_AGENT); }
__device__ __forceinline__ unsigned xb_xcc_id() { return (unsigned)__builtin_amdgcn_s_getreg((3 << 11) | 20) & 0xFu; }
#define XB_SPIN(cond, bar) do { unsigned _sp = 0; while (cond) { __builtin_amdgcn_s_sleep(1); \
    if ((++_sp & 255u) == 0u) { if (xb_ld(&(bar)[XB_TMO])) break; if (_sp > XB_SPIN_CAP) { atomicAdd(&(bar)[XB_TMO], 1u); break; } } } } while (0)

struct XcdBarrier {
    unsigned* bar; unsigned x;
    volatile LAS unsigned* st;
};

__device__ __forceinline__ XcdBarrier xcd_barrier_post(unsigned* bar, volatile LAS unsigned* st) {
    XcdBarrier b; b.bar = bar; b.x = xb_xcc_id(); b.st = st;
    if (threadIdx.x == 0) (void)xb_add(&bar[XB_XCNT(b.x)], 1u);
    return b;
}
__device__ __forceinline__ void xcd_barrier_complete(unsigned* bar, unsigned x, unsigned& nloc, unsigned& nx) {
    const unsigned G = gridDim.x * gridDim.y * gridDim.z;
    unsigned sum, cnt, mine, sp = 0u;
    for (;;) {
        sum = 0u; cnt = 0u; mine = 0u;
#pragma unroll
        for (unsigned j = 0; j < 16; ++j) { const unsigned c = xb_ld(&bar[XB_XCNT(j)]); sum += c; cnt += (c > 0u) ? 1u : 0u; mine = (j == x) ? c : mine; }
        if (sum == G) break;
        __builtin_amdgcn_s_sleep(1);
        if ((++sp & 255u) == 0u) { if (xb_ld(&bar[XB_TMO])) break; if (sp > XB_SPIN_CAP) { atomicAdd(&bar[XB_TMO], 1u); break; } }
    }
    nloc = mine > 0u ? mine : 1u; nx = cnt > 0u ? cnt : 1u;
}

__device__ __forceinline__ void xcd_barrier(const XcdBarrier& b) {
    asm volatile("s_waitcnt vmcnt(0)" ::: "memory");
    __syncthreads();
    if (threadIdx.x == 0) {
        unsigned* bar = b.bar;
        __builtin_amdgcn_s_waitcnt(0);
        unsigned nloc = b.st[0], nx = b.st[1];
        if (nloc == 0u) { xcd_barrier_complete(bar, b.x, nloc, nx); b.st[0] = nloc; b.st[1] = nx; }
        const unsigned old = xb_add(&bar[XB_XSUB(b.x)], 1u);
        const unsigned gen = old / nloc;
        if (old + 1u == (gen + 1u) * nloc) {
            __builtin_amdgcn_fence(__ATOMIC_RELEASE, "agent");
            asm volatile("s_waitcnt vmcnt(0)" ::: "memory");
            const unsigned og = xb_add(&bar[XB_TOP], 1u);
            const unsigned tg = og / nx;
            if (og + 1u == (tg + 1u) * nx) xb_add(&bar[XB_TOPGEN], 1u);
            else XB_SPIN(xb_ld(&bar[XB_TOPGEN]) == tg, bar);
            __builtin_amdgcn_fence(__ATOMIC_ACQUIRE, "agent");
            xb_add(&bar[XB_XGEN(b.x)], 1u);
            asm volatile("s_waitcnt vmcnt(0)" ::: "memory");
        } else {
            XB_SPIN(xb_ld(&bar[XB_XGEN(b.x)]) == gen, bar);
            __builtin_amdgcn_fence(__ATOMIC_ACQUIRE, "agent");
            asm volatile("s_waitcnt vmcnt(0)" ::: "memory");
        }
    }
    __syncthreads();
}
constexpr int NWAVES = 8;
constexpr int DM = 1024, SEQ = 16384, NB = 16, MS = NB * 64, M = SEQ + MS;
constexpr int NIN_A = 2304, NIN_B = 4096;
constexpr float EPS = 1e-6f, LOG2E = 1.4426950408889634f, C2 = 0.125f * 1.4426950408889634f;
constexpr size_t O_Y = 0, O_KAP = 17825792, O_VAP = 17842176, O_KBP = 17858560, O_VBP = 18382848, O_KAS = 18907136, O_VAS = 19169280, O_KBS = 19431424, O_VBS = 27820032, O_END = 36208640;
constexpr size_t KiB = 1024, MiB = 1u << 20;
constexpr size_t WS_CTL = 0, CTL_ZERO_BYTES = 256 * KiB;
constexpr size_t WS_WINA = 256 * KiB;
constexpr size_t WS_WOUTA = WS_WINA + (size_t)NIN_A * DM * 2;
constexpr size_t WS_WINB = WS_WOUTA + (size_t)DM * DM * 2;
constexpr size_t WS_WOUTB = WS_WINB + (size_t)NIN_B * DM * 2;
constexpr size_t WS_SLAB = WS_WOUTB + (size_t)DM * DM * 2;
constexpr size_t ACT = (size_t)M * DM * 2;
constexpr size_t WS_XN = 18 * MiB;
constexpr size_t WS_QA = WS_XN + ACT;
constexpr size_t WS_GA = WS_QA + ACT, WS_KA = WS_GA + ACT, WS_VA = WS_KA + (size_t)M * 128 * 2;
constexpr size_t WS_QB = WS_GA;
constexpr size_t WS_KB = WS_QB + ACT, WS_VB = WS_KB + ACT, WS_GB = WS_VB + ACT;
constexpr size_t WS_CKA = WS_GB + ACT, WS_CVA = WS_CKA + (size_t)NB * 128 * 128 * 2, WS_CKB = WS_CVA + (size_t)NB * 128 * 128 * 2, WS_CVB = WS_CKB + (size_t)NB * 512 * 1024 * 2;
constexpr size_t WS_END = WS_CVB + (size_t)NB * 512 * 1024 * 2;
static_assert(WS_SLAB + (size_t)M * 16 * 4 <= WS_XN && WS_VA + (size_t)M * 128 * 2 <= WS_CKA && WS_QB >= WS_QA + ACT && WS_END <= 256 * MiB, "d_ws map");
constexpr int CW_KMAX_A = 64, CW_KMAX_B = 128;
constexpr int CW_BAR = 4096;
constexpr int RING_OFF = 0, RING_BYTES = 131072;
constexpr int PHASE_BYTES = 159744;
constexpr int LDSCTL_OFF = PHASE_BYTES, MISC_OFF = LDSCTL_OFF + 320;
constexpr int LDS_BYTES = 163840;
constexpr int AT_NS = 4;
constexpr int AT_SLOT = 0, AT_SLOTB = 16384  , AT_TAB = AT_NS * AT_SLOTB, AT_TABB = 49152, AT_WSF = AT_TAB + AT_TABB, AT_OST = AT_WSF + NWAVES * 256, AT_END = AT_OST + NWAVES * 4096;
static_assert(AT_END <= PHASE_BYTES && MISC_OFF + 128 <= LDS_BYTES, "attention LDS map");

#ifndef PROBE_SEG
#define PROBE_SEG 0
#endif
#ifndef PROBE_LAYER
#define PROBE_LAYER 1
#endif
#if PROBE_SEG
#define KSEG_BEGIN(s) unsigned long long ks_t0_##s = 0; if (PROBE_SEG == (s)) ks_t0_##s = __builtin_amdgcn_s_memrealtime();
#define KSEG_END(s) if (PROBE_SEG == (s)) F.tacc += __builtin_amdgcn_s_memrealtime() - ks_t0_##s;
#define PSEG_BEGIN(s) unsigned long long ps_t0_##s = 0; if (PROBE_SEG == (s) && LAYER == PROBE_LAYER) ps_t0_##s = __builtin_amdgcn_s_memrealtime();
#define PSEG_END(s) if (PROBE_SEG == (s) && LAYER == PROBE_LAYER) F.tacc += __builtin_amdgcn_s_memrealtime() - ps_t0_##s;
#else
#define PSEG_BEGIN(s)
#define PSEG_END(s)
#define KSEG_BEGIN(s)
#define KSEG_END(s)
#endif
struct Frame {
    unsigned long long tacc;
    LAS unsigned char* lds;
    volatile LAS unsigned* MISC;
    gu32* ctl;
    int tid, lane, wave;
    int vcu, G;
};
struct Args { const float* in[19]; float* out; unsigned char* ws; };

__device__ __forceinline__ float wave_sum(float v) {
#pragma unroll
    for (int o = 1; o < 64; o <<= 1) v += __shfl_xor(v, o);
    return v;
}
__device__ __forceinline__ float wave_max(float v) {
#pragma unroll
    for (int o = 1; o < 64; o <<= 1) v = fmaxf(v, __shfl_xor(v, o));
    return v;
}
__device__ __forceinline__ int phys_col(int c) { return (c & ~255) | (((c >> 5) & 1) << 7) | (((c >> 6) & 3) << 5) | (c & 31); }

__device__ __forceinline__ void p0_transpose_item(const float* W, int K, int N, bf16* WT, bool permute, const float* gain, LAS float* scr, int item, int lane) {
    const int nblk = N / 32, kb = item / nblk, nb = item % nblk, k0 = 64 * kb, n0 = 32 * nb;
    const float* src = W + (size_t)(k0 + (lane >> 5)) * N + n0 + (lane & 31);
    float w[32];
#pragma unroll
    for (int i = 0; i < 32; ++i) w[i] = __builtin_nontemporal_load(src + (size_t)(2 * i) * N);
    if (gain) {
#pragma unroll
        for (int i = 0; i < 32; ++i) w[i] *= gain[k0 + 2 * i + (lane >> 5)]; }
#pragma unroll
    for (int i = 0; i < 32; ++i) scr[(2 * i + (lane >> 5)) * 33 + (lane & 31)] = w[i];
    LDS_WAIT(); asm volatile("" ::: "memory");
    const int c = lane & 7;
    const int r0 = permute ? phys_col(n0) : n0;
#pragma unroll
    for (int j = 0; j < 4; ++j) { const int n = (lane >> 3) + 8 * j; const LAS float* s = scr + (8 * c) * 33 + n;
        v4u o; o.x = pk2(s[0 * 33], s[1 * 33]); o.y = pk2(s[2 * 33], s[3 * 33]); o.z = pk2(s[4 * 33], s[5 * 33]); o.w = pk2(s[6 * 33], s[7 * 33]);
        *(GAS v4u*)(WT + (size_t)(r0 + n) * K + k0 + 8 * c) = o; }
    LDS_WAIT(); asm volatile("" ::: "memory");
}
struct Row4 { f32x4 v[4]; };
__device__ __forceinline__ void row_load(Row4& r, const float* p, int lane) {
#pragma unroll
    for (int j = 0; j < 4; ++j) r.v[j] = __builtin_nontemporal_load((const GAS f32x4*)p + lane + 64 * j); }
__device__ __forceinline__ void row_store_bf16(const Row4& r, bf16* o, int lane) {
#pragma unroll
    for (int j = 0; j < 4; ++j) ((GAS unsigned long long*)o)[lane + 64 * j] = (unsigned long long)pk2(r.v[j].x, r.v[j].y) | ((unsigned long long)pk2(r.v[j].z, r.v[j].w) << 32); }
__device__ __forceinline__ void row_store_f32(const Row4& r, float* o, int lane) {
#pragma unroll
    for (int j = 0; j < 4; ++j) __builtin_nontemporal_store(r.v[j], (GAS f32x4*)o + lane + 64 * j); }
__device__ __forceinline__ const float* x_row(const Args& a, int m) { return m < SEQ ? a.in[0] + (size_t)m * DM : a.in[1] + (size_t)(m - SEQ) * DM; }
__device__ __forceinline__ void rms_finish(Row4& r, const Row4& g, bf16* o, int lane) {
    float s = 0.f;
#pragma unroll
    for (int j = 0; j < 4; ++j) s += (r.v[j].x * r.v[j].x + r.v[j].y * r.v[j].y) + (r.v[j].z * r.v[j].z + r.v[j].w * r.v[j].w);
    const float rs = rsqrtf(wave_sum(s) * (1.f / DM) + EPS);
#pragma unroll
    for (int j = 0; j < 4; ++j) r.v[j] = r.v[j] * rs * g.v[j];
    row_store_bf16(r, o, lane);
}
__device__ __forceinline__ float row_maxnorm2(const Row4& r) {
    float qm = 0.f;
#pragma unroll
    for (int j = 0; j < 4; ++j) { float q = (r.v[j].x * r.v[j].x + r.v[j].y * r.v[j].y) + (r.v[j].z * r.v[j].z + r.v[j].w * r.v[j].w);
#pragma unroll
        for (int d = 1; d < 16; d <<= 1) q += __shfl_xor(q, d);
        qm = fmaxf(qm, q); }
    return qm;
}
__device__ __forceinline__ void cache_rows_a(const float* srck, const float* srcv, bf16* dbk, bf16* dbv, float* dok, float* dov, int row, gu32* kmax, int lane) {
    constexpr int L = 128, W = 128;
    const int b = row / L, j = row % L;
    const size_t so = (size_t)row * W, oo = ((size_t)b * L + (j - 64)) * W;
    const float k0 = srck[so + 2 * lane], k1 = srck[so + 2 * lane + 1], v0 = srcv[so + 2 * lane], v1 = srcv[so + 2 * lane + 1];
    ((GAS unsigned*)(dbk + so))[lane] = pk2(k0, k1); ((GAS unsigned*)(dbv + so))[lane] = pk2(v0, v1);
    if (j >= 64) { dok[oo + 2 * lane] = k0; dok[oo + 2 * lane + 1] = k1; dov[oo + 2 * lane] = v0; dov[oo + 2 * lane + 1] = v1; }
    float q = k0 * k0 + k1 * k1;
#pragma unroll
    for (int d = 1; d < 32; d <<= 1) q += __shfl_xor(q, d);
    q = fmaxf(q, __shfl_xor(q, 32));
    if (lane == 0) __hip_atomic_fetch_max(kmax, __float_as_uint(q), __ATOMIC_RELAXED, __HIP_MEMORY_SCOPE_AGENT);
}
__device__ __forceinline__ void p0_prologue(Frame& F, const Args& a) {
    LAS float* scr = (LAS float*)(F.lds + RING_OFF + F.wave * 16384);
    const int gw = F.vcu * NWAVES + F.wave, NGW = F.G * NWAVES, lane = F.lane;
    unsigned char* ws = a.ws;
    bf16* XN = (bf16*)(ws + WS_XN);
    {
        Row4 g, a0, a1, b0, b1; row_load(g, a.in[7], lane);
        const int S = NGW;
        int m = gw;
#define XLOAD(R0, R1, mm) do { if ((mm) < M) row_load(R0, x_row(a, (mm)), lane); if ((mm) + S < M) row_load(R1, x_row(a, (mm) + S), lane); } while (0)
#define XFIN(R0, R1, mm) do { if ((mm) < M) rms_finish(R0, g, XN + (size_t)(mm) * DM, lane); if ((mm) + S < M) rms_finish(R1, g, XN + (size_t)((mm) + S) * DM, lane); } while (0)
        XLOAD(a0, a1, m);
        for (; m < M; m += 4 * S) {
            XLOAD(b0, b1, m + 2 * S);
            XFIN(a0, a1, m);
            XLOAD(a0, a1, m + 4 * S);
            XFIN(b0, b1, m + 2 * S);
        }
#undef XLOAD
#undef XFIN
    }
    constexpr int I_INA = (DM / 64) * (NIN_A / 32);
    for (int it = gw; it < I_INA; it += NGW) p0_transpose_item(a.in[8], DM, NIN_A, (bf16*)(ws + WS_WINA), true, nullptr, scr, it, lane);
    for (int r = gw; r < NB * 128; r += NGW)
        cache_rows_a(a.in[2], a.in[3], (bf16*)(ws + WS_CKA), (bf16*)(ws + WS_CVA), a.out + O_KAS, a.out + O_VAS, r, F.ctl + CW_KMAX_A, lane);
}
__device__ __forceinline__ void side_weights(Frame& F, const Args& a, int w, int nw) {
    LAS float* scr = (LAS float*)(F.lds + RING_OFF + F.wave * 16384);
    unsigned char* ws = a.ws;
    constexpr int I_O = (DM / 64) * (DM / 32), I_INB = (DM / 64) * (NIN_B / 32);
    for (int it = w; it < I_O + I_INB + I_O; it += nw) {
        int r = it;
        if (r < I_O) { p0_transpose_item(a.in[12], DM, DM, (bf16*)(ws + WS_WOUTA), false, nullptr, scr, r, F.lane); continue; } r -= I_O;
        if (r < I_INB) { p0_transpose_item(a.in[14], DM, NIN_B, (bf16*)(ws + WS_WINB), true, a.in[13], scr, r, F.lane); continue; } r -= I_INB;
        p0_transpose_item(a.in[18], DM, DM, (bf16*)(ws + WS_WOUTB), false, nullptr, scr, r, F.lane);
    }
}
__device__ __forceinline__ void side_cache_b_conv(Frame& F, const Args& a, int w, int nw) {
    unsigned char* ws = a.ws; const int lane = F.lane;
    const float* srck = a.in[4]; const float* srcv = a.in[5];
    bf16* dbk = (bf16*)(ws + WS_CKB); bf16* dbv = (bf16*)(ws + WS_CVB);
    constexpr int NR = NB * 512;
    Row4 ka, va, kb, vb; float qm = 0.f;
#define CB_LOAD(K_, V_, r) do { row_load(K_, srck + (size_t)(r) * DM, lane); row_load(V_, srcv + (size_t)(r) * DM, lane); } while (0)
#define CB_FIN(K_, V_, r) do { const size_t so_ = (size_t)(r) * DM; row_store_bf16(K_, dbk + so_, lane); row_store_bf16(V_, dbv + so_, lane); qm = fmaxf(qm, row_maxnorm2(K_)); } while (0)
    int r = w;
    if (r < NR) CB_LOAD(ka, va, r);
    for (; r < NR; r += 2 * nw) {
        const int r1 = r + nw, r2 = r + 2 * nw;
        if (r1 < NR) CB_LOAD(kb, vb, r1);
        CB_FIN(ka, va, r);
        if (r2 < NR) CB_LOAD(ka, va, r2);
        if (r1 < NR) CB_FIN(kb, vb, r1);
    }
#undef CB_LOAD
#undef CB_FIN
    qm = wave_max(qm);
    if (lane == 0) __hip_atomic_fetch_max(F.ctl + CW_KMAX_B, __float_as_uint(qm), __ATOMIC_RELAXED, __HIP_MEMORY_SCOPE_AGENT);
}
__device__ __forceinline__ void side_cache_b_copy(Frame& F, const Args& a, int w, int nw) {
    const int lane = F.lane;
    const float* srck = a.in[4]; const float* srcv = a.in[5]; float* dok = a.out + O_KBS; float* dov = a.out + O_VBS;
    constexpr int NR = NB * 448;
    Row4 ka, va, kb, vb;
#define CP_SRC(r) ((size_t)((r) / 448) * 512 + 64 + (r) % 448)
#define CP_DST(r) ((size_t)((r) / 448) * 512 + (r) % 448)
#define CP_LOAD(K_, V_, r) do { const size_t so_ = CP_SRC(r) * DM; row_load(K_, srck + so_, lane); row_load(V_, srcv + so_, lane); } while (0)
#define CP_FIN(K_, V_, r) do { const size_t oo_ = CP_DST(r) * DM; row_store_f32(K_, dok + oo_, lane); row_store_f32(V_, dov + oo_, lane); } while (0)
    int r = w;
    if (r < NR) CP_LOAD(ka, va, r);
    for (; r < NR; r += 2 * nw) {
        const int r1 = r + nw, r2 = r + 2 * nw;
        if (r1 < NR) CP_LOAD(kb, vb, r1);
        CP_FIN(ka, va, r);
        if (r2 < NR) CP_LOAD(ka, va, r2);
        if (r1 < NR) CP_FIN(kb, vb, r1);
    }
#undef CP_SRC
#undef CP_DST
#undef CP_LOAD
#undef CP_FIN
}
__device__ __forceinline__ void tail_outproj_a(LAS unsigned char* lds, const bf16* A, const bf16* Bt, int c, const float* xs, bf16* yb, float* slab) {
    int tid_ = threadIdx.x; asm volatile("" : "+v"(tid_));
    const int tid = tid_, lane = tid & 63, wid = __builtin_amdgcn_readfirstlane(tid >> 6), fr = lane & 15, fq = lane >> 4;
    const int rb = c >> 4, cb = c & 15, row0 = SEQ + 64 * rb, col0 = 64 * cb;
    const bf16* ap = A + (size_t)(row0 + fr) * DM + 128 * wid + 8 * fq;
    const bf16* bp = Bt + (size_t)(col0 + fr) * DM + 128 * wid + 8 * fq;
    bf16x8 af[4][4], bfr[4][4];
#pragma unroll
    for (int m = 0; m < 4; ++m)
#pragma unroll
        for (int ks = 0; ks < 4; ++ks) { af[m][ks] = *(const GAS bf16x8*)(ap + (size_t)(16 * m) * DM + 32 * ks); bfr[m][ks] = *(const GAS bf16x8*)(bp + (size_t)(16 * m) * DM + 32 * ks); }
    f32x4 acc[4][4];
#pragma unroll
    for (int m = 0; m < 4; ++m)
#pragma unroll
        for (int n = 0; n < 4; ++n) { acc[m][n] = (f32x4){0.f, 0.f, 0.f, 0.f};
#pragma unroll
            for (int ks = 0; ks < 4; ++ks) acc[m][n] = __builtin_amdgcn_mfma_f32_16x16x32_bf16(bfr[n][ks], af[m][ks], acc[m][n], 0, 0, 0); }
    LAS float* part = (LAS float*)lds + wid * 4096;
#pragma unroll
    for (int m = 0; m < 4; ++m)
#pragma unroll
        for (int n = 0; n < 4; ++n) *(LAS f32x4*)(part + (16 * m + fr) * 64 + 16 * n + 4 * fq) = acc[m][n];
    __syncthreads();
    const int r = tid >> 3, c8 = (tid & 7) * 8;
    f32x4 s0 = (f32x4){0.f, 0.f, 0.f, 0.f}, s1 = s0;
#pragma unroll
    for (int w = 0; w < 8; ++w) { const LAS float* p = (const LAS float*)lds + w * 4096 + r * 64 + c8; s0 += *(const LAS f32x4*)p; s1 += *(const LAS f32x4*)(p + 4); }
    const int row = row0 + r;
    const float* xp = xs + (size_t)(row - SEQ) * DM + col0 + c8;
    const f32x4 y0 = s0 + *(const GAS f32x4*)xp, y1 = s1 + *(const GAS f32x4*)(xp + 4);
    v4u wv; wv.x = pk2(y0[0], y0[1]); wv.y = pk2(y0[2], y0[3]); wv.z = pk2(y1[0], y1[1]); wv.w = pk2(y1[2], y1[3]);
    *(GAS v4u*)(yb + (size_t)row * DM + col0 + c8) = wv;
    float ss = ((y0[0] * y0[0] + y0[1] * y0[1]) + (y0[2] * y0[2] + y0[3] * y0[3])) + ((y1[0] * y1[0] + y1[1] * y1[1]) + (y1[2] * y1[2] + y1[3] * y1[3]));
    ss += __shfl_xor(ss, 1); ss += __shfl_xor(ss, 2); ss += __shfl_xor(ss, 4);
    if ((tid & 7) == 0) slab[(size_t)row * 16 + cb] = ss;
    __syncthreads();
}

namespace attn {
using bf16x8 = __attribute__((ext_vector_type(8))) short;
using s16x4 = __attribute__((ext_vector_type(4))) short;
using f32x16 = __attribute__((ext_vector_type(16))) float;
using u32x4 = pg8::u32x4;
typedef short v4i16_t __attribute__((ext_vector_type(4)));
typedef __attribute__((address_space(3))) const char* lds_cptr;
__device__ __forceinline__ int crow(int r, int hi) { return (r & 3) + 8 * (r >> 2) + 4 * hi; }
__device__ __forceinline__ s16x4 vtr(lds_cptr p) { return __builtin_bit_cast(s16x4, __builtin_amdgcn_ds_read_tr16_b64_v4i16((__attribute__((address_space(3))) v4i16_t*)p)); }
typedef float f32x2_t __attribute__((ext_vector_type(2))); typedef __bf16 bf16x2_t __attribute__((ext_vector_type(2)));
__device__ __forceinline__ unsigned cvtpk(float lo, float hi) { f32x2_t v = {lo, hi}; bf16x2_t b = __builtin_convertvector(v, bf16x2_t); return __builtin_bit_cast(unsigned, b); }
__device__ __forceinline__ int t5_bucket(int rel) {
    const int n = rel < 0 ? -rel : rel;
    int b = n;
    if (n >= 8) b = 8 + (n >= 12) + (n >= 16) + (n >= 23) + (n >= 32) + (n >= 46) + (n >= 64) + (n >= 91);
    return b + (rel > 0 ? 16 : 0);
}
__device__ __forceinline__ void glds16(const void* gsrc, unsigned lds_dst) { unsigned keep;
    asm volatile("s_mov_b32 %0, m0\n\ts_mov_b32 m0, %2\n\ts_nop 0\n\tglobal_load_lds_dwordx4 %1, off\n\ts_mov_b32 m0, %0" : "=&s"(keep) : "v"(gsrc), "s"(lds_dst) : "memory"); }
__device__ __forceinline__ float bf2f(unsigned short h) { return __uint_as_float((unsigned)h << 16); }

template <int LAYER>
__device__ __forceinline__ void attn_phase(Frame& F, const Args& a) {
    constexpr int P = LAYER == 0 ? 2 : 8;
    constexpr int KVW = LAYER == 0 ? 128 : 1024;
    constexpr int L = P * 64;
    constexpr int RT0 = LAYER == 0 ? 0 : 6;
    unsigned char* ws = a.ws;
    const bf16* Q = (const bf16*)(ws + (LAYER == 0 ? WS_QA : WS_QB));
    const bf16* Kg = (const bf16*)(ws + (LAYER == 0 ? WS_KA : WS_KB));
    const bf16* Vg = (const bf16*)(ws + (LAYER == 0 ? WS_VA : WS_VB));
    const bf16* Gt = (const bf16*)(ws + (LAYER == 0 ? WS_GA : WS_GB));
    const bf16* CK = (const bf16*)(ws + (LAYER == 0 ? WS_CKA : WS_CKB));
    const bf16* CV = (const bf16*)(ws + (LAYER == 0 ? WS_CVA : WS_CVB));
    bf16* O = (bf16*)(ws + WS_XN);
    const float* qg = a.in[LAYER == 0 ? 9 : 15]; const float* kg = a.in[LAYER == 0 ? 10 : 16];
    const float* table = a.in[LAYER == 0 ? 6 : 17];
    int tid_ = threadIdx.x; asm volatile("" : "+v"(tid_));
    const int tid = tid_, lane = tid & 63, wid = __builtin_amdgcn_readfirstlane(tid >> 6), r32 = lane & 31, hi = lane >> 5;
    const int h = F.vcu >> 4, sub = F.vcu & 15;
    const int kvh = LAYER == 0 ? (h >> 3) : h;
    LAS unsigned char* lds = F.lds + RING_OFF;
    const int cw = wid >> 1, half = wid & 1;
    const unsigned lds0 = (unsigned)(size_t)lds;
#define UNIT_PARAMS(ui_, X) const bool X##sample = (ui_) == 4; const int X##u0 = 4 * (4 * sub + (ui_)); const int X##nt = X##sample ? P + 1 : P + 4; \
        const int X##tb = X##sample ? 0 : (X##u0 >= P ? 0 : P - X##u0); const bool X##won = !X##sample || cw == 0; \
        const size_t X##qtok = X##sample ? (size_t)SEQ + 64 * sub + 32 * half : (size_t)64 * (X##u0 + cw) + 32 * half;
#define TILE_DMA_U(X, t, slot_) do { const bf16 *kb_, *vb_; \
            if (!X##sample) { const size_t r0_ = (size_t)64 * (X##u0 - P + (t)) * KVW; kb_ = Kg + r0_; vb_ = Vg + r0_; } \
            else if ((t) < P) { const size_t r0_ = ((size_t)sub * L + 64 * (t)) * KVW; kb_ = CK + r0_; vb_ = CV + r0_; } \
            else { const size_t r0_ = ((size_t)SEQ + 64 * sub) * KVW; kb_ = Kg + r0_; vb_ = Vg + r0_; } \
            const unsigned s_ = (unsigned)__builtin_amdgcn_readfirstlane(lds0 + AT_SLOT + ((slot_) & 3) * AT_SLOTB + wid * 1024); \
            glds16(kb_ + koff, s_); glds16(vb_ + voff, s_ + 8192); } while (0)
#define Q_DMA_U(X) do { if (X##won) { _Pragma("unroll") for (int i_ = 0; i_ < 4; ++i_) glds16(Q + (X##qtok + 8 * i_ + (lane >> 3)) * DM + h * 64 + (lane & 7) * 8, (unsigned)__builtin_amdgcn_readfirstlane(lds0 + AT_OST + wid * 4096 + i_ * 1024)); } } while (0)
#define WAIT_BAR(N) asm volatile("s_waitcnt vmcnt(" #N ") lgkmcnt(0)\n\ts_barrier" ::: "memory")
    const size_t koff = (size_t)lane * KVW + kvh * 64 + wid * 8, voff = (size_t)(16 * (wid & 3) + (lane >> 2)) * KVW + kvh * 64 + (wid >> 2) * 32 + (lane & 3) * 8;
    int sb = 0;
    {
        UNIT_PARAMS(0, f_)
        Q_DMA_U(f_); TILE_DMA_U(f_, f_tb, 0); TILE_DMA_U(f_, f_tb + 1, 1);
    }
    PSEG_BEGIN(1) PSEG_BEGIN(5)
    constexpr int NBR = LAYER == 0 ? 32 : 257;
    LAS float* brow = (LAS float*)(lds + AT_WSF);
    for (int i = tid; i < NBR; i += NWAVES * 64) brow[i] = LAYER == 0 ? table[i * 16 + h] : table[h * 257 + i];
    const float gqa = fabsf(qg[lane]), gka = fabsf(kg[lane]);
    const unsigned kcb = __hip_atomic_load(F.ctl + (LAYER == 0 ? CW_KMAX_A : CW_KMAX_B), __ATOMIC_RELAXED, __HIP_MEMORY_SCOPE_AGENT);
    const float sinkv = LAYER == 0 ? a.in[11][h] : 0.f;
    __syncthreads();
    float bm = -1e30f;
    for (int i = lane; i < NBR; i += 64) bm = fmaxf(bm, brow[i]);
    bm = wave_max(bm);
    const float gqm = wave_max(gqa), gkm = wave_max(gka), kc = sqrtf(__uint_as_float(kcb));
    const float bound = gqm * fmaxf(8.f * gkm, kc) * 1.01f + bm;
    const float cconst = LAYER == 0 ? 0.f : (brow[256 % NBR] - bound) * LOG2E;
    const float sinkp = LAYER == 0 ? __builtin_amdgcn_exp2f((sinkv - bound) * LOG2E) : 0.f;
    {
        LAS float* tab = (LAS float*)(lds + AT_TAB);
        for (int i = tid; i < 3 * 2 * 8 * 64 * 4; i += NWAVES * 64) {
            const int e = i & 3, ln = (i >> 2) & 63, q4 = (i >> 8) & 7, half = (i >> 11) & 1, rtv = i >> 12;
            const int R = 4 * q4 + e, key = 32 * (R >> 4) + crow(R & 15, ln >> 5), qi = 32 * half + (ln & 31), j = 64 * (RT0 + rtv) + key;
            float bv;
            if (LAYER == 0) bv = brow[t5_bucket(j - (P * 64 + qi))];
            else { int idx = P * 64 + qi - j; idx = idx < -128 ? -128 : (idx > 128 ? 128 : idx); bv = brow[(idx + 128) % NBR]; }
            tab[i] = (bv - bound) * LOG2E;
        }
    }
    __syncthreads();
    f32x16 cc16;
#pragma unroll
    for (int r = 0; r < 16; ++r) cc16[r] = cconst;
    asm volatile("" : "+v"(cc16));
    PSEG_END(5)
    const lds_cptr lds3 = (lds_cptr)lds;
    const lds_cptr kp0 = lds3 + AT_SLOT + hi * 1024 + r32 * 16;
    const lds_cptr vp0 = lds3 + AT_SLOT + 8192 + ((lane >> 4) & 1) * 32 + (lane & 3) * 8 + (4 * hi + ((lane & 15) >> 2)) * 64;
    const LAS f32x4* tabl = (const LAS f32x4*)(lds + AT_TAB) + lane;
    LAS float* wsf = (LAS float*)(lds + AT_WSF) + wid * 64;
    for (int ui = 0; ui < 5; ++ui) {
        PSEG_BEGIN(2)
        UNIT_PARAMS(ui, c_)
        const bool sample = c_sample, wave_on = c_won, has_next = ui < 4; const int nt = c_nt, t_begin = c_tb; const size_t qtok = c_qtok;
        UNIT_PARAMS(ui + 1, n_)
        f32x16 o[2]; o[0] = f32x16{}; o[1] = f32x16{};
        float l_reg = 0.f;
        if (ui == 0) WAIT_BAR(2); else WAIT_BAR(4);
        PSEG_END(2) PSEG_BEGIN(3)
        bf16x8 qr[4];
#pragma unroll
        for (int d0 = 0; d0 < 4; ++d0) qr[d0] = *(const __attribute__((address_space(3))) bf16x8*)(lds3 + AT_OST + wid * 4096 + r32 * 128 + (2 * d0 + hi) * 16);
        u32x4 pw[4];
#pragma unroll
        for (int s = 0; s < 4; ++s) pw[s] = (u32x4){0u, 0u, 0u, 0u};
        v4u gpre[4];
#pragma unroll
        for (int i = 0; i < 4; ++i) gpre[i] = (v4u){0u, 0u, 0u, 0u};
#define STEP_HEAD(t) const int sl = (t) - t_begin + sb;                    \
            if ((t) + 2 < nt) TILE_DMA_U(c_, (t) + 2, sl + 2);             \
            if ((t) == nt - 1) { \
                if (wave_on) { _Pragma("unroll") for (int i = 0; i < 4; ++i) gpre[i] = *(const GAS v4u*)(Gt + (qtok + i * 8 + (lane >> 3)) * DM + h * 64 + (lane & 7) * 8); } \
                asm volatile("" ::: "memory"); \
                if (has_next) { Q_DMA_U(n_); TILE_DMA_U(n_, n_tb, sl + 1); } }     \
            if ((t) == nt && has_next) TILE_DMA_U(n_, n_tb + 1, sl + 1);
#define STEP_TAIL(t) if ((t) + 2 < nt) WAIT_BAR(2); else if ((t) + 2 == nt || !has_next) WAIT_BAR(0); else WAIT_BAR(63);
        const int a_lo = wave_on ? (cw > t_begin ? cw : t_begin) : nt + 1, a_hi = wave_on ? (cw + P + 1 < nt ? cw + P + 1 : nt) : nt;
        int t = t_begin;
        for (; t < a_lo && t <= nt; ++t) { STEP_HEAD(t) STEP_TAIL(t) }
        for (; t <= a_hi; ++t) {
            STEP_HEAD(t)
            const int rt = t - cw;
            {
                const bool last = rt == P + 1 || t == nt, first = rt == 0 || t == t_begin;
                const int rtb = last ? rt - 1 : rt;
                const int ko = ((last ? sl - 1 : sl) & 3) * AT_SLOTB, vo = ((first ? sl : sl - 1) & 3) * AT_SLOTB;
                const lds_cptr kp = kp0 + ko, vp = vp0 + vo;
                bf16x8 kf[8];
#pragma unroll
                for (int d0 = 0; d0 < 4; ++d0) { kf[2 * d0] = *(const __attribute__((address_space(3))) bf16x8*)(kp + d0 * 2048); kf[2 * d0 + 1] = *(const __attribute__((address_space(3))) bf16x8*)(kp + d0 * 2048 + 512); }
                f32x16 p0, p1;
                __builtin_amdgcn_s_setprio(1);
                if (rtb >= RT0) { const LAS f32x4* tp = tabl + ((rtb - RT0) * 2 + half) * 8 * 64;
                    const f32x16 t0 = __builtin_shufflevector(__builtin_shufflevector(tp[0], tp[64], 0, 1, 2, 3, 4, 5, 6, 7), __builtin_shufflevector(tp[128], tp[192], 0, 1, 2, 3, 4, 5, 6, 7), 0, 1, 2, 3, 4, 5, 6, 7, 8, 9, 10, 11, 12, 13, 14, 15);
                    const f32x16 t1 = __builtin_shufflevector(__builtin_shufflevector(tp[256], tp[320], 0, 1, 2, 3, 4, 5, 6, 7), __builtin_shufflevector(tp[384], tp[448], 0, 1, 2, 3, 4, 5, 6, 7), 0, 1, 2, 3, 4, 5, 6, 7, 8, 9, 10, 11, 12, 13, 14, 15);
                    p0 = __builtin_amdgcn_mfma_f32_32x32x16_bf16(kf[0], qr[0], t0, 0, 0, 0); p1 = __builtin_amdgcn_mfma_f32_32x32x16_bf16(kf[1], qr[0], t1, 0, 0, 0); }
                else { p0 = __builtin_amdgcn_mfma_f32_32x32x16_bf16(kf[0], qr[0], cc16, 0, 0, 0); p1 = __builtin_amdgcn_mfma_f32_32x32x16_bf16(kf[1], qr[0], cc16, 0, 0, 0); }
#pragma unroll
                for (int d0 = 1; d0 < 4; ++d0) { p0 = __builtin_amdgcn_mfma_f32_32x32x16_bf16(kf[2 * d0], qr[d0], p0, 0, 0, 0); p1 = __builtin_amdgcn_mfma_f32_32x32x16_bf16(kf[2 * d0 + 1], qr[d0], p1, 0, 0, 0); }
                bf16x8 vf[8];
#pragma unroll
                for (int i = 0; i < 8; ++i) { const s16x4 lo = vtr(vp + (i >> 2) * 4096 + (i & 3) * 1024), hh = vtr(vp + (i >> 2) * 4096 + (i & 3) * 1024 + 512); vf[i] = (bf16x8){lo[0], lo[1], lo[2], lo[3], hh[0], hh[1], hh[2], hh[3]}; }
#pragma unroll
                for (int ks = 0; ks < 4; ++ks) { o[0] = __builtin_amdgcn_mfma_f32_32x32x16_bf16(__builtin_bit_cast(bf16x8, pw[ks]), vf[ks], o[0], 0, 0, 0); o[1] = __builtin_amdgcn_mfma_f32_32x32x16_bf16(__builtin_bit_cast(bf16x8, pw[ks]), vf[4 + ks], o[1], 0, 0, 0); }
                __builtin_amdgcn_s_setprio(0);
                float sacc = 0.f;
#pragma unroll
                for (int r = 0; r < 16; ++r) { p0[r] = __builtin_amdgcn_exp2f(p0[r]); p1[r] = __builtin_amdgcn_exp2f(p1[r]); sacc += p0[r] + p1[r]; }
                l_reg += last ? 0.f : sacc;
#pragma unroll
                for (int s = 0; s < 2; ++s)
#pragma unroll
                    for (int i = 0; i < 4; ++i) { pw[s][i] = cvtpk(p0[8 * s + 2 * i], p0[8 * s + 2 * i + 1]); pw[2 + s][i] = cvtpk(p1[8 * s + 2 * i], p1[8 * s + 2 * i + 1]); }
            }
            STEP_TAIL(t)
        }
        for (; t <= nt; ++t) { STEP_HEAD(t) STEP_TAIL(t) }
#undef STEP_HEAD
#undef STEP_TAIL
        PSEG_END(3) PSEG_BEGIN(4)
#undef TILE_DMA
#undef WAIT_BAR
        if (wave_on) {
            l_reg += __shfl_xor(l_reg, 32);
            l_reg += sinkp;
            if (hi == 0) wsf[r32] = l_reg;
            LDS_WAIT(); asm volatile("" ::: "memory");
            LAS unsigned short* stg = (LAS unsigned short*)(lds + AT_SLOT + (((nt - 2 - t_begin + sb) + (wid >> 2)) & 3) * AT_SLOTB + (wid & 3) * 4096);
#pragma unroll
            for (int r = 0; r < 16; ++r) { const int orow = crow(r, hi); const float rl = __builtin_amdgcn_rcpf(wsf[orow]);
#pragma unroll
                for (int d0 = 0; d0 < 2; ++d0) stg[orow * 64 + d0 * 32 + r32] = (unsigned short)(f2bf(o[d0][r] * rl)); }
            LDS_WAIT(); asm volatile("" ::: "memory");
#pragma unroll
            for (int i = 0; i < 4; ++i) { const int row = i * 8 + (lane >> 3), ch = lane & 7;
                const v4u ov = *(const LAS v4u*)(stg + row * 64 + ch * 8);
                const size_t go = (qtok + row) * DM + h * 64 + ch * 8;
                const v4u gvv = gpre[i];
                v4u res;
#pragma unroll
                for (int e = 0; e < 4; ++e) { const float a0 = __uint_as_float(ov[e] << 16) * __uint_as_float(gvv[e] << 16), a1 = __uint_as_float(ov[e] & 0xffff0000u) * __uint_as_float(gvv[e] & 0xffff0000u); res[e] = cvtpk(a0, a1); }
                *(GAS v4u*)(O + go) = res; }
        }
        sb += nt - t_begin;
        PSEG_END(4)
    }
    __syncthreads();
    PSEG_END(1)
}
template <int NV> __device__ __forceinline__ void wait_bar_n(int n) {
#define WB_(N) case N: asm volatile("s_waitcnt vmcnt(" #N ") lgkmcnt(0)\n\ts_barrier" ::: "memory"); break;
    switch (n) { WB_(0) WB_(2) WB_(4) WB_(6) WB_(8) WB_(10) WB_(12) WB_(14) WB_(16) WB_(18) WB_(20) WB_(22) WB_(24) WB_(26) WB_(28) default: asm volatile("s_waitcnt vmcnt(0) lgkmcnt(0)\n\ts_barrier" ::: "memory"); break; }
#undef WB_
}
__device__ __forceinline__ void attn_phase_a(Frame& F, const Args& a) {
    constexpr int P = 2, KVW = 128, NCH = 272, NSL = 5, SLOTB = 16384;
    constexpr int A2_RING = 0, A2_TT = NSL * SLOTB, A2_WSF = A2_TT + 8192, A2_Q = A2_WSF + 3072, A2_OST = A2_Q + NWAVES * 4096, A2_END = A2_OST + NWAVES * 4096;
    static_assert(A2_Q % 1024 == 0 && A2_END <= PHASE_BYTES, "layer A attention LDS map");
    unsigned char* ws = a.ws;
    const bf16* Q = (const bf16*)(ws + WS_QA); const bf16* Kg = (const bf16*)(ws + WS_KA); const bf16* Vg = (const bf16*)(ws + WS_VA); const bf16* Gt = (const bf16*)(ws + WS_GA);
    const bf16* CK = (const bf16*)(ws + WS_CKA); const bf16* CV = (const bf16*)(ws + WS_CVA);
    bf16* O = (bf16*)(ws + WS_XN);
    const float* qg = a.in[9]; const float* kg = a.in[10]; const float* table = a.in[6];
    int tid_ = threadIdx.x; asm volatile("" : "+v"(tid_));
    const int tid = tid_, lane = tid & 63, wid = __builtin_amdgcn_readfirstlane(tid >> 6), r32 = lane & 31, hi = lane >> 5;
    const int combo = F.vcu >> 6, g = combo >> 1, half = combo & 1, cidx = F.vcu & 63;
    const int c_lo = (cidx * NCH) >> 6, c_hi = ((cidx + 1) * NCH) >> 6;
    const int h = 8 * g + wid;
    LAS unsigned char* lds = F.lds + RING_OFF;
    const unsigned lds0 = (unsigned)(size_t)lds;
    const lds_cptr lds3 = (lds_cptr)lds;
    const int cp_hi = c_hi < 256 ? c_hi : 256;
    const int a0 = c_lo >= 2 ? c_lo - 2 : 0;
    const int npt = c_lo < 256 ? (cp_hi - 1) - a0 + 1 : 0;
    const int cs_lo = c_lo > 256 ? c_lo : 256;
#define T0_OF(c) (((c) < 2) ? 2 - (c) : 0)
#define POS_OF(c, ti) ((c) < 256 ? ((c) - 2 + (ti)) - a0 : npt + 3 * ((c) - cs_lo) + (ti))
#define NEW_OF(c, ti) ((c) >= 256 || (c) == c_lo || (ti) == 2)
#define QTOK_OF(c) ((c) < 256 ? (size_t)64 * (c) + 32 * half : (size_t)SEQ + 64 * ((c) - 256) + 32 * half)
    const size_t koff = (size_t)lane * KVW + g * 64 + wid * 8, voff = (size_t)(16 * (wid & 3) + (lane >> 2)) * KVW + g * 64 + (wid >> 2) * 32 + (lane & 3) * 8;
#define TILE_DMA_A(c, ti) do { const bf16 *kb_, *vb_; \
        if ((c) < 256) { const size_t r0_ = (size_t)64 * ((c) - 2 + (ti)) * KVW; kb_ = Kg + r0_; vb_ = Vg + r0_; } \
        else if ((ti) < 2) { const size_t r0_ = ((size_t)((c) - 256) * 128 + 64 * (ti)) * KVW; kb_ = CK + r0_; vb_ = CV + r0_; } \
        else { const size_t r0_ = ((size_t)SEQ + 64 * ((c) - 256)) * KVW; kb_ = Kg + r0_; vb_ = Vg + r0_; } \
        const unsigned s_ = (unsigned)__builtin_amdgcn_readfirstlane(lds0 + A2_RING + (POS_OF(c, ti) % NSL) * SLOTB + wid * 1024); \
        glds16(kb_ + koff, s_); glds16(vb_ + voff, s_ + 8192); } while (0)
#define Q_DMA_A(c) do { const size_t qt_ = QTOK_OF(c); _Pragma("unroll") for (int i_ = 0; i_ < 4; ++i_) glds16(Q + (qt_ + 8 * i_ + (lane >> 3)) * DM + h * 64 + (lane & 7) * 8, (unsigned)__builtin_amdgcn_readfirstlane(lds0 + A2_Q + wid * 4096 + i_ * 1024)); } while (0)
#define STEP_NEXT(c, ti) do { if ((ti) < 2) ++(ti); else { ++(c); (ti) = T0_OF(c); } } while (0)
    int c3 = c_lo, t3 = T0_OF(c_lo);
    Q_DMA_A(c_lo);
#pragma unroll 1
    for (int k = 0; k < 3; ++k) { if (c3 < c_hi) { if (NEW_OF(c3, t3)) TILE_DMA_A(c3, t3); STEP_NEXT(c3, t3); } }
    const float gqm = wave_max(fabsf(qg[lane])), gkm = wave_max(fabsf(kg[lane]));
    const float kc = sqrtf(__uint_as_float(__hip_atomic_load(F.ctl + CW_KMAX_A, __ATOMIC_RELAXED, __HIP_MEMORY_SCOPE_AGENT)));
    const float bm = wave_max(lane < 32 ? table[lane * 16 + h] : -1e30f);
    const float bound = gqm * fmaxf(8.f * gkm, kc) * 1.01f + bm;
    const float sinkp = __builtin_amdgcn_exp2f((a.in[11][h] - bound) * LOG2E);
    LAS float* TTw = (LAS float*)(lds + A2_TT) + wid * 256;
    for (int i = lane; i < 255; i += 64) TTw[i] = (table[t5_bucket(i - 191) * 16 + h] - bound) * LOG2E;
    const LAS float* tql = TTw + (63 - 32 * half - r32 + 4 * hi);
    const lds_cptr kp0 = lds3 + A2_RING + hi * 1024 + r32 * 16;
    const lds_cptr vp0 = lds3 + A2_RING + 8192 + ((lane >> 4) & 1) * 32 + (lane & 3) * 8 + (4 * hi + ((lane & 15) >> 2)) * 64;
    LAS float* wsf = (LAS float*)(lds + A2_WSF) + wid * 64;
    asm volatile("s_waitcnt vmcnt(0) lgkmcnt(0)\n\ts_barrier" ::: "memory");
    f32x16 o[2]; o[0] = f32x16{}; o[1] = f32x16{};
    float l_reg = 0.f;
    u32x4 pw[4];
#pragma unroll
    for (int s = 0; s < 4; ++s) pw[s] = (u32x4){0u, 0u, 0u, 0u};
    bf16x8 qr[4];
    v4u gpre[4];
#pragma unroll
    for (int i = 0; i < 4; ++i) gpre[i] = (v4u){0u, 0u, 0u, 0u};
    int c = c_lo, ti = T0_OF(c_lo);
    int pc = -1, pv_pos = 0;
    bool p_last = false;
    int ops_prev = 0;
    for (;;) {
        const bool qk_on = c < c_hi;
        int ops = 0;
        if (qk_on && ti == T0_OF(c)) {
#pragma unroll
            for (int d0 = 0; d0 < 4; ++d0) qr[d0] = *(const __attribute__((address_space(3))) bf16x8*)(lds3 + A2_Q + wid * 4096 + r32 * 128 + (2 * d0 + hi) * 16);
        }
        f32x16 p0, p1;
        {
            const int pos = qk_on ? POS_OF(c, ti) : pv_pos;
            const int tq = qk_on ? ti : 2;
            const lds_cptr kp = kp0 + (pos % NSL) * SLOTB, vp = vp0 + ((pc >= 0 ? pv_pos : pos) % NSL) * SLOTB;
            bf16x8 kf[8];
#pragma unroll
            for (int d0 = 0; d0 < 4; ++d0) { kf[2 * d0] = *(const __attribute__((address_space(3))) bf16x8*)(kp + d0 * 2048); kf[2 * d0 + 1] = *(const __attribute__((address_space(3))) bf16x8*)(kp + d0 * 2048 + 512); }
            const LAS float* tq_ = tql + 64 * tq;
#pragma unroll
            for (int r = 0; r < 16; ++r) { p0[r] = tq_[(r & 3) + 8 * (r >> 2)]; p1[r] = tq_[32 + (r & 3) + 8 * (r >> 2)]; }
            __builtin_amdgcn_s_setprio(1);
#pragma unroll
            for (int d0 = 0; d0 < 4; ++d0) { p0 = __builtin_amdgcn_mfma_f32_32x32x16_bf16(kf[2 * d0], qr[d0], p0, 0, 0, 0); p1 = __builtin_amdgcn_mfma_f32_32x32x16_bf16(kf[2 * d0 + 1], qr[d0], p1, 0, 0, 0); }
            bf16x8 vf[8];
#pragma unroll
            for (int i = 0; i < 8; ++i) { const s16x4 lo = vtr(vp + (i >> 2) * 4096 + (i & 3) * 1024), hh = vtr(vp + (i >> 2) * 4096 + (i & 3) * 1024 + 512); vf[i] = (bf16x8){lo[0], lo[1], lo[2], lo[3], hh[0], hh[1], hh[2], hh[3]}; }
#pragma unroll
            for (int ks = 0; ks < 4; ++ks) { o[0] = __builtin_amdgcn_mfma_f32_32x32x16_bf16(__builtin_bit_cast(bf16x8, pw[ks]), vf[ks], o[0], 0, 0, 0); o[1] = __builtin_amdgcn_mfma_f32_32x32x16_bf16(__builtin_bit_cast(bf16x8, pw[ks]), vf[4 + ks], o[1], 0, 0, 0); }
            __builtin_amdgcn_s_setprio(0);
        }
        if (p_last) {
            l_reg += __shfl_xor(l_reg, 32);
            l_reg += sinkp;
            if (hi == 0) wsf[r32] = l_reg;
            LDS_WAIT(); asm volatile("" ::: "memory");
            LAS unsigned short* stg = (LAS unsigned short*)(lds + A2_OST) + wid * 2048;
#pragma unroll
            for (int r = 0; r < 16; ++r) { const int orow = crow(r, hi); const float rl = __builtin_amdgcn_rcpf(wsf[orow]);
#pragma unroll
                for (int d0 = 0; d0 < 2; ++d0) stg[orow * 64 + d0 * 32 + r32] = (unsigned short)(f2bf(o[d0][r] * rl)); }
            LDS_WAIT(); asm volatile("" ::: "memory");
            const size_t qtok = QTOK_OF(pc);
#pragma unroll
            for (int i = 0; i < 4; ++i) { const int row = i * 8 + (lane >> 3), ch = lane & 7;
                const v4u ov = *(const LAS v4u*)(stg + row * 64 + ch * 8);
                const v4u gvv = gpre[i];
                v4u res;
#pragma unroll
                for (int e = 0; e < 4; ++e) { const float a0_ = __uint_as_float(ov[e] << 16) * __uint_as_float(gvv[e] << 16), a1_ = __uint_as_float(ov[e] & 0xffff0000u) * __uint_as_float(gvv[e] & 0xffff0000u); res[e] = cvtpk(a0_, a1_); }
                *(GAS v4u*)(O + (qtok + row) * DM + h * 64 + ch * 8) = res; }
            ops += 4;
            o[0] = f32x16{}; o[1] = f32x16{}; l_reg = 0.f;
        }
        if (!qk_on) break;
        if (c3 < c_hi) { if (NEW_OF(c3, t3)) { TILE_DMA_A(c3, t3); ops += 2; } STEP_NEXT(c3, t3); }
        if (ti == T0_OF(c) && c + 1 < c_hi) { asm volatile("s_waitcnt lgkmcnt(0)" ::: "memory"); Q_DMA_A(c + 1); ops += 4; }
        if (ti == T0_OF(c)) { const size_t qtok = QTOK_OF(c);
#pragma unroll
            for (int i = 0; i < 4; ++i) gpre[i] = *(const GAS v4u*)(Gt + (qtok + i * 8 + (lane >> 3)) * DM + h * 64 + (lane & 7) * 8);
            ops += 4; }
        {
            float sacc = 0.f;
#pragma unroll
            for (int r = 0; r < 16; ++r) { p0[r] = __builtin_amdgcn_exp2f(p0[r]); p1[r] = __builtin_amdgcn_exp2f(p1[r]); sacc += p0[r] + p1[r]; }
            l_reg += sacc;
#pragma unroll
            for (int s = 0; s < 2; ++s)
#pragma unroll
                for (int i = 0; i < 4; ++i) { pw[s][i] = cvtpk(p0[8 * s + 2 * i], p0[8 * s + 2 * i + 1]); pw[2 + s][i] = cvtpk(p1[8 * s + 2 * i], p1[8 * s + 2 * i + 1]); }
        }
        const bool short_chunk = T0_OF(c) != 0;
        wait_bar_n<0>(short_chunk ? 0 : ops + ops_prev);
        ops_prev = ops;
        pc = c; pv_pos = POS_OF(c, ti); p_last = ti == 2;
        STEP_NEXT(c, ti);
    }
    asm volatile("s_waitcnt vmcnt(0) lgkmcnt(0)\n\ts_barrier" ::: "memory");
#undef T0_OF
#undef POS_OF
#undef NEW_OF
#undef QTOK_OF
#undef TILE_DMA_A
#undef Q_DMA_A
#undef STEP_NEXT
}
}

__global__ void __launch_bounds__(NWAVES * 64, 2) mk_fwd(Args args) {
    extern __shared__ __attribute__((aligned(16))) unsigned char lds[];
    Frame F; F.tacc = 0;
    F.lds = (LAS unsigned char*)lds;
    F.MISC = (volatile LAS unsigned*)(F.lds + MISC_OFF);
    F.tid = threadIdx.x; F.lane = F.tid & 63; F.wave = __builtin_amdgcn_readfirstlane(F.tid >> 6);
    F.G = gridDim.x; { const int bx = blockIdx.x; F.vcu = (F.G % 8 == 0) ? (bx % 8) * (F.G / 8) + bx / 8 : bx; }
    unsigned char* ws = args.ws;
    F.ctl = (gu32*)(ws + WS_CTL);
    for (int u = F.tid; u < (LDS_BYTES - LDSCTL_OFF) / 4; u += NWAVES * 64) ((LAS unsigned*)(F.lds + LDSCTL_OFF))[u] = 0u;
    __syncthreads();
    XcdBarrier bar = xcd_barrier_post((unsigned*)(F.ctl + CW_BAR), F.MISC + 8);
    bf16* XN = (bf16*)(ws + WS_XN);
    float* slab = (float*)(ws + WS_SLAB);
    float* out = args.out;

#ifndef DUP_PHASE
#define DUP_PHASE -1
#endif
#define REPS_ON(k) int nrep_##k = 2; asm volatile("" : "+s"(nrep_##k)); for (int rep_ = 0; rep_ < nrep_##k; ++rep_)
#define REPS_OFF(k)
#define REPS_SEL(k) REPS_SEL2(k, DUP_PHASE)
#define REPS(k) REPS_##k
#if DUP_PHASE == 0
#define REPS_0 REPS_ON(0)
#else
#define REPS_0
#endif
#if DUP_PHASE == 1
#define REPS_1 REPS_ON(1)
#else
#define REPS_1
#endif
#if DUP_PHASE == 2
#define REPS_2 REPS_ON(2)
#else
#define REPS_2
#endif
#if DUP_PHASE == 3
#define REPS_3 REPS_ON(3)
#else
#define REPS_3
#endif
#if DUP_PHASE == 4
#define REPS_4 REPS_ON(4)
#else
#define REPS_4
#endif
#if DUP_PHASE == 5
#define REPS_5 REPS_ON(5)
#else
#define REPS_5
#endif
#if DUP_PHASE == 6
#define REPS_6 REPS_ON(6)
#else
#define REPS_6
#endif
    KSEG_BEGIN(10) REPS(0) { p0_prologue(F, args);
    xcd_barrier(bar); } KSEG_END(10)
    KSEG_BEGIN(11) REPS(1) {
        pg8::Gemm g{XN, (const bf16*)(ws + WS_WINA), M, NIN_A, DM}; pg8::StaticOrder S; S.init(M, NIN_A, F.G, (int)blockIdx.x);
        pg8::EpiIn E{0, (bf16*)(ws + WS_QA), (bf16*)(ws + WS_KA), (bf16*)(ws + WS_VA), (bf16*)(ws + WS_GA), 128, args.in[9], args.in[10], nullptr,
                     out + O_KAP, out + O_VAP, out + O_KAS, out + O_VAS, 128, 2, C2, nullptr};
        pg8::gemm_phase<pg8::EpiIn, pg8::StaticOrder, true, true>(F.lds + RING_OFF, g, S, E, PROBE_SEG == 31 ? &F.tacc : nullptr);
        { const int busy = (M / 256) * (NIN_A / 256) - 2 * F.G;
          if ((int)blockIdx.x >= busy && F.wave < 4) side_weights(F, args, ((int)blockIdx.x - busy) * 4 + F.wave, (F.G - busy) * 4); }
    xcd_barrier(bar); } KSEG_END(11)
    KSEG_BEGIN(12) REPS(2) { attn::attn_phase_a(F, args);
    xcd_barrier(bar); } KSEG_END(12)
    KSEG_BEGIN(13) REPS(3) {
        pg8::Gemm g{XN, (const bf16*)(ws + WS_WOUTA), SEQ, DM, DM}; pg8::StaticOrder S; S.init(SEQ, DM, F.G, (int)blockIdx.x);
        pg8::EpiOut E{0, args.in[0], args.in[1], (bf16*)(ws + WS_QA), nullptr, slab};
        KSEG_BEGIN(20) pg8::gemm_phase<pg8::EpiOut, pg8::StaticOrder, true, true>(F.lds + RING_OFF, g, S, E); KSEG_END(20)
        KSEG_BEGIN(21)
        tail_outproj_a(F.lds + RING_OFF, XN, (const bf16*)(ws + WS_WOUTA), (int)blockIdx.x, args.in[1], (bf16*)(ws + WS_QA), slab);
        KSEG_END(21)
    xcd_barrier(bar); } KSEG_END(13)
    KSEG_BEGIN(14) REPS(4) {
        pg8::Gemm g{(const bf16*)(ws + WS_QA), (const bf16*)(ws + WS_WINB), M, NIN_B, DM}; pg8::StaticOrder S; S.init(M, NIN_B, F.G, (int)blockIdx.x);
        pg8::EpiIn E{1, (bf16*)(ws + WS_QB), (bf16*)(ws + WS_KB), (bf16*)(ws + WS_VB), (bf16*)(ws + WS_GB), 1024, args.in[15], args.in[16], slab,
                     out + O_KBP, out + O_VBP, out + O_KBS, out + O_VBS, 512, 16, C2, (LAS float*)(F.lds + RING_BYTES + 1024)};
        pg8::gemm_phase<pg8::EpiIn, pg8::StaticOrder, true, true>(F.lds + RING_OFF, g, S, E, PROBE_SEG == 30 ? &F.tacc : nullptr);
        { const int busy = (M / 256) * (NIN_B / 256) - 4 * F.G;
          if ((int)blockIdx.x >= busy && F.wave < 2) side_cache_b_conv(F, args, ((int)blockIdx.x - busy) * 2 + F.wave, (F.G - busy) * 2); }
    xcd_barrier(bar); } KSEG_END(14)
    KSEG_BEGIN(15) REPS(5) { attn::attn_phase<1>(F, args);
    xcd_barrier(bar); } KSEG_END(15)
    KSEG_BEGIN(16) REPS(6) {
        pg8::Gemm g{XN, (const bf16*)(ws + WS_WOUTB), M, DM, DM}; pg8::StaticOrder S; S.init(M, DM, F.G, (int)blockIdx.x);
        pg8::EpiOut E{1, nullptr, nullptr, (bf16*)(ws + WS_QA), out + O_Y, nullptr};
        pg8::gemm_phase<pg8::EpiOut, pg8::StaticOrder, true, true>(F.lds + RING_OFF, g, S, E);
        { const int busy = (M / 256) * (DM / 256) - F.G;
          if ((int)blockIdx.x >= busy && F.wave < 4) side_cache_b_copy(F, args, ((int)blockIdx.x - busy) * 4 + F.wave, (F.G - busy) * 4); }
    }
    KSEG_END(16)
#if PROBE_SEG
    if (blockIdx.x == 0) {
        const unsigned long long t0 = __builtin_amdgcn_s_memrealtime(), dt = 8ull * (unsigned long long)__builtin_amdgcn_readfirstlane((unsigned)F.tacc);
        while (__builtin_amdgcn_s_memrealtime() - t0 < dt) __builtin_amdgcn_s_sleep(32);
    }
#endif
}
extern "C" void kernel_launch(void* const* d_in, const int* in_sizes, int n_in, void* d_out, int out_size, void* d_ws, size_t ws_size, hipStream_t stream) {
    static int grid = 0;
    if (grid == 0) {
        if (n_in != 19 || out_size != (int)O_END || ws_size < WS_END) { fprintf(stderr, "kernel_launch: unexpected shapes (n_in %d, out %d, ws %zu)\n", n_in, out_size, ws_size); grid = -1; return; }
        int dev = 0, cus = 0, per_cu = 0;
        if (hipGetDevice(&dev) != hipSuccess || hipDeviceGetAttribute(&cus, hipDeviceAttributeMultiprocessorCount, dev) != hipSuccess) { grid = -1; return; }
        if (hipFuncSetAttribute((const void*)mk_fwd, hipFuncAttributeMaxDynamicSharedMemorySize, LDS_BYTES) != hipSuccess) { fprintf(stderr, "kernel_launch: hipFuncSetAttribute failed\n"); grid = -1; return; }
        if (hipOccupancyMaxActiveBlocksPerMultiprocessor(&per_cu, (const void*)mk_fwd, NWAVES * 64, LDS_BYTES) != hipSuccess || per_cu < 1) { fprintf(stderr, "kernel_launch: occupancy query says %d blocks per CU\n", per_cu); }
        (void)hipGetLastError();
        grid = cus;
        if (grid != 256) { fprintf(stderr, "kernel_launch: built for 256 CUs, found %d\n", cus); grid = -1; return; }
    }
    if (grid < 0) return;
    (void)hipMemsetAsync((char*)d_ws + WS_CTL, 0, CTL_ZERO_BYTES, stream);
    Args a{};
    for (int i = 0; i < 19; ++i) a.in[i] = (const float*)d_in[i];
    a.out = (float*)d_out; a.ws = (unsigned char*)d_ws;
    hipLaunchKernelGGL(mk_fwd, dim3(grid), dim3(NWAVES * 64), LDS_BYTES, stream, a);
}
```

```cpp
#include <hip/hip_runtime.h>
#include <cstdio>
#include <cstdint>
#include <cmath>
namespace pg8 {
#define PG8_LAS __attribute__((address_space(3)))
typedef unsigned short bf16_t;
typedef short bf16x8 __attribute__((ext_vector_type(8)));
typedef float f32x4 __attribute__((ext_vector_type(4)));
typedef unsigned u32x4 __attribute__((ext_vector_type(4)));
constexpr int BM = 256, BK = 64, HALF = 128, HTB = HALF * BK * 2  , STAGE_BYTES = 8 * HTB, NXCD = 8, WGM = 8;

__host__ __device__ __forceinline__ int lds_byte(int r, int c) { const int st = (r >> 4) * 2 + (c >> 5), rr = r & 15, cc = c & 31, ob = rr * 64 + cc * 2; return st * 1024 + (ob ^ (((ob >> 9) & 1) << 5)); }
__host__ __device__ __forceinline__ void stage_rc(int b, int& R, int& C) { const int st = b / 1024, sb = b % 1024, swz = sb ^ (((sb >> 9) & 1) << 5); R = (st >> 1) * 16 + swz / 64; C = (st & 1) * 32 + (swz % 64) / 2; }
__host__ __device__ __forceinline__ int perm32(int rho) { const int n = rho >> 4, i = rho & 15; return 8 * (i >> 2) + 4 * n + (i & 3); }

struct Unit { int pm, pn; };
struct Gemm { const bf16_t* A; const bf16_t* Bt; int M, N, K; };

struct StaticOrder {
    int nM, nN, nwg, G, c;
    __host__ __device__ void init(int M, int N, int G_, int c_) { nM = M / BM; nN = N / BM; nwg = nM * nN; G = G_; c = c_; }
    __host__ __device__ bool next(int i, Unit& u) const {
        const long L = (long)i * G + c; if (L >= nwg) return false;
        int wgid = (int)L; { const int q = nwg / NXCD, r = nwg % NXCD, xcd = wgid % NXCD, off = wgid / NXCD; wgid = (xcd < r ? xcd * (q + 1) : r * (q + 1) + (xcd - r) * q) + off; }
        const int nig = WGM * nN, gid = wgid / nig, fm = gid * WGM, gsz = (nM - fm) < WGM ? (nM - fm) : WGM;
        u.pm = fm + ((wgid % nig) % gsz); u.pn = (wgid % nig) / gsz; return true;
    }
    __device__ __forceinline__ void a_ready(const Unit&) const {}
    __device__ __forceinline__ void done(const Unit&) const {}
};
__device__ __forceinline__ unsigned cvt_pk_bf16(float lo, float hi) { unsigned r; asm volatile("v_cvt_pk_bf16_f32 %0, %1, %2" : "=v"(r) : "v"(lo), "v"(hi)); return r; }
__device__ __forceinline__ void st16_wt(void* p, u32x4 v) { asm volatile("global_store_dwordx4 %0, %1, off sc1\n\ts_nop 1" :: "v"(p), "v"(v) : "memory"); }
constexpr int SEQ_ = 16384;
constexpr float NORM_EPS = 1e-6f;
struct EpiIn {
    static constexpr bool PERM = true, AFTER_DRAIN = false;
    int layer;
    bf16_t *Q, *Kb, *Vb, *G; int kvw;
    const float *qg, *kg;
    const float* slab;
    float *okp, *ovp, *oks, *ovs; int keep, nkv;
    float c2;
    PG8_LAS float* rstd_lds;
    template <int TYPE>
    __device__ __forceinline__ void tile(const f32x4 (&acc)[2][2][4][2], int row0, int rl0, int dcol, int fq, bf16_t* dst, int ld, const float* gp, float sc, float* o_p, float* o_s, int head) const {
        f32x4 gv[2][2];
        if (TYPE < 2) {
#pragma unroll
            for (int bj = 0; bj < 2; ++bj)
#pragma unroll
                for (int n = 0; n < 2; ++n) gv[bj][n] = *(const f32x4*)(gp + 32 * bj + dcol + 4 * n) * sc; }
#pragma unroll
        for (int ai = 0; ai < 2; ++ai)
#pragma unroll
            for (int m = 0; m < 4; ++m) {
                const int row = row0 + ai * HALF + m * 16;
                const float rs = slab ? rstd_lds[ai * HALF + rl0 + m * 16] : 1.f;
                f32x4 v[2][2];
#pragma unroll
                for (int bj = 0; bj < 2; ++bj)
#pragma unroll
                    for (int n = 0; n < 2; ++n) v[bj][n] = acc[ai][bj][m][n] * rs;
                if (TYPE < 2) {
                    float ss = 0.f;
#pragma unroll
                    for (int bj = 0; bj < 2; ++bj)
#pragma unroll
                        for (int n = 0; n < 2; ++n) { const f32x4 x = v[bj][n]; ss += (x[0] * x[0] + x[1] * x[1]) + (x[2] * x[2] + x[3] * x[3]); }
                    ss += __shfl_xor(ss, 16); ss += __shfl_xor(ss, 32);
                    const float r = rsqrtf(ss * (1.f / 64.f) + NORM_EPS);
#pragma unroll
                    for (int bj = 0; bj < 2; ++bj)
#pragma unroll
                        for (int n = 0; n < 2; ++n) v[bj][n] = v[bj][n] * r * gv[bj][n];
                } else if (TYPE == 3) {
#pragma unroll
                    for (int bj = 0; bj < 2; ++bj)
#pragma unroll
                        for (int n = 0; n < 2; ++n)
#pragma unroll
                            for (int e = 0; e < 4; ++e) { const float x = v[bj][n][e]; v[bj][n][e] = x * __builtin_amdgcn_rcpf(1.f + __builtin_amdgcn_exp2f(-1.4426950408889634f * x)); }
                }
                if ((TYPE == 1 || TYPE == 2) && row >= SEQ_ - keep) {
                    float* op;
                    if (row < SEQ_) op = o_p + ((size_t)(row - (SEQ_ - keep)) * nkv + head) * 64 + dcol;
                    else { const int r_ = row - SEQ_; op = o_s + (((size_t)(r_ >> 6) * keep + (keep - 64) + (r_ & 63)) * nkv + head) * 64 + dcol; }
#pragma unroll
                    for (int bj = 0; bj < 2; ++bj) { *(f32x4*)(op + 32 * bj) = v[bj][0]; *(f32x4*)(op + 32 * bj + 4) = v[bj][1]; }
                }
#pragma unroll
                for (int bj = 0; bj < 2; ++bj) { u32x4 w; w.x = cvt_pk_bf16(v[bj][0][0], v[bj][0][1]); w.y = cvt_pk_bf16(v[bj][0][2], v[bj][0][3]); w.z = cvt_pk_bf16(v[bj][1][0], v[bj][1][1]); w.w = cvt_pk_bf16(v[bj][1][2], v[bj][1][3]);
                    st16_wt(dst + (size_t)row * ld + 32 * bj, w); }
            }
    }
    __device__ __forceinline__ void operator()(const f32x4 (&acc)[2][2][4][2], const Unit& u, int wr, int wc, int fr, int fq) const {
        int type, head;
        if (layer == 0) { if (u.pn < 4) { type = 0; head = 4 * u.pn + wc; } else if (u.pn == 4) { type = wc < 2 ? 1 : 2; head = wc & 1; } else { type = 3; head = 4 * (u.pn - 5) + wc; } }
        else { type = u.pn >> 2; head = 4 * (u.pn & 3) + wc; }
        const int row0 = u.pm * BM + wr * 64 + fr, rl0 = wr * 64 + fr, dcol = 8 * fq, co = head * 64 + dcol;
        if (slab) {
            const int t = threadIdx.x;
            if (t < BM) { const f32x4* sp = (const f32x4*)(slab + (size_t)(u.pm * BM + t) * 16); const f32x4 a = sp[0], b = sp[1], c = sp[2], d = sp[3];
                const f32x4 s = (a + b) + (c + d); rstd_lds[t] = rsqrtf(((s[0] + s[1]) + (s[2] + s[3])) * (1.f / 1024.f) + NORM_EPS); }
            asm volatile("s_waitcnt lgkmcnt(0)\n\ts_barrier" ::: "memory");
        }
        if (type == 0) tile<0>(acc, row0, rl0, dcol, fq, Q + co, 1024, qg, c2, nullptr, nullptr, head);
        else if (type == 1) tile<1>(acc, row0, rl0, dcol, fq, Kb + co, kvw, kg, 1.f, okp, oks, head);
        else if (type == 2) tile<2>(acc, row0, rl0, dcol, fq, Vb + co, kvw, nullptr, 1.f, ovp, ovs, head);
        else tile<3>(acc, row0, rl0, dcol, fq, G + co, 1024, nullptr, 1.f, nullptr, nullptr, head);
    }
};
struct EpiOut {
    static constexpr bool PERM = true, AFTER_DRAIN = false;
    int layer;
    const float *base_p, *base_s;
    bf16_t* yb;
    float* out;
    float* slab;
    __device__ __forceinline__ void operator()(const f32x4 (&acc)[2][2][4][2], const Unit& u, int wr, int wc, int fr, int fq) const {
        const int row0 = u.pm * BM + wr * 64 + fr, col0 = u.pn * BM + wc * 32 + 8 * fq;
        if (layer == 0) {
#pragma unroll
            for (int ai = 0; ai < 2; ++ai) {
                f32x4 b[4][2][2];
#pragma unroll
                for (int m = 0; m < 4; ++m) { const int row = row0 + ai * HALF + m * 16;
                    const float* bp = (row < SEQ_ ? base_p + (size_t)row * 1024 : base_s + (size_t)(row - SEQ_) * 1024) + col0;
#pragma unroll
                    for (int bj = 0; bj < 2; ++bj) { b[m][bj][0] = *(const f32x4*)(bp + bj * HALF); b[m][bj][1] = *(const f32x4*)(bp + bj * HALF + 4); } }
#pragma unroll
                for (int m = 0; m < 4; ++m) { const int row = row0 + ai * HALF + m * 16; float ss = 0.f;
#pragma unroll
                    for (int bj = 0; bj < 2; ++bj) { const f32x4 y0 = acc[ai][bj][m][0] + b[m][bj][0], y1 = acc[ai][bj][m][1] + b[m][bj][1];
                        ss += ((y0[0] * y0[0] + y0[1] * y0[1]) + (y0[2] * y0[2] + y0[3] * y0[3])) + ((y1[0] * y1[0] + y1[1] * y1[1]) + (y1[2] * y1[2] + y1[3] * y1[3]));
                        u32x4 w; w.x = cvt_pk_bf16(y0[0], y0[1]); w.y = cvt_pk_bf16(y0[2], y0[3]); w.z = cvt_pk_bf16(y1[0], y1[1]); w.w = cvt_pk_bf16(y1[2], y1[3]);
                        *(u32x4*)(yb + (size_t)row * 1024 + col0 + bj * HALF) = w; }
                    ss += __shfl_xor(ss, 16); ss += __shfl_xor(ss, 32); if (fq == 0) slab[(size_t)row * 16 + 4 * u.pn + wc] = ss; }
            }
        } else {
#pragma unroll
            for (int ai = 0; ai < 2; ++ai) {
                u32x4 b[4][2];
#pragma unroll
                for (int m = 0; m < 4; ++m) { const int row = row0 + ai * HALF + m * 16;
#pragma unroll
                    for (int bj = 0; bj < 2; ++bj) b[m][bj] = *(const u32x4*)(yb + (size_t)row * 1024 + col0 + bj * HALF); }
#pragma unroll
                for (int m = 0; m < 4; ++m) { const int row = row0 + ai * HALF + m * 16; float* op = out + (size_t)row * 1024 + col0;
#pragma unroll
                    for (int bj = 0; bj < 2; ++bj) { const u32x4 w = b[m][bj];
                        const f32x4 r0 = {__uint_as_float(w.x << 16), __uint_as_float(w.x & 0xffff0000u), __uint_as_float(w.y << 16), __uint_as_float(w.y & 0xffff0000u)};
                        const f32x4 r1 = {__uint_as_float(w.z << 16), __uint_as_float(w.z & 0xffff0000u), __uint_as_float(w.w << 16), __uint_as_float(w.w & 0xffff0000u)};
                        *(f32x4*)(op + bj * HALF) = acc[ai][bj][m][0] + r0; *(f32x4*)(op + bj * HALF + 4) = acc[ai][bj][m][1] + r1; } }
            }
        }
    }
};
template <class Epi, class Sched, bool ALIGN_EPI = false, bool SP2 = false>
__device__ __forceinline__ void gemm_phase(PG8_LAS unsigned char* lds, const Gemm g, const Sched& S, const Epi& E, unsigned long long* tepi = nullptr) {
    int tid_ = threadIdx.x; asm volatile("" : "+v"(tid_));
    const int tid = tid_, wid = __builtin_amdgcn_readfirstlane(tid >> 6), lane = tid & 63, wr = wid >> 2, wc = wid & 3, fr = lane & 15, fq = lane >> 4;
    const int K = g.K, nt = K / BK;
    unsigned voffA[2], voffB[2];
#pragma unroll
    for (int i = 0; i < 2; ++i) { int R, C; stage_rc(tid * 16 + i * 8192, R, C); const int Rb = Epi::PERM ? ((R & ~31) + perm32(R & 31)) : R;
        voffA[i] = (unsigned)(R * K + C) * 2u; voffB[i] = (unsigned)(Rb * K + C) * 2u; }
    const size_t kstep = (size_t)(BK * 2);
    const size_t hstep = (size_t)HALF * K * 2;
    const size_t tstep = 2 * hstep;
    const unsigned ldsw = (unsigned)wid * 1024u;
    const int aoff = lds_byte(wr * 64 + fr, fq * 8), boff = lds_byte(wc * 32 + fr, fq * 8);
#define PG8_SA(b, h) (((b) * 2 + (h)) * HTB)
#define PG8_SB(b, h) ((4 + (b) * 2 + (h)) * HTB)
#define PG8_STAGE(bufoff, gbase, voff) do { _Pragma("unroll") for (int _i = 0; _i < 2; ++_i) \
        __builtin_amdgcn_global_load_lds((const unsigned*)((const char*)(gbase) + (voff)[_i]), (PG8_LAS unsigned*)(lds + (bufoff) + ldsw + _i * 8192), 16, 0, 0); } while (0)
#define PG8_LDA(dst, b, h) do { _Pragma("unroll") for (int m = 0; m < 4; ++m) _Pragma("unroll") for (int k = 0; k < 2; ++k) dst[m][k] = *(const PG8_LAS bf16x8*)(lds + PG8_SA(b, h) + aoff + m * 2048 + k * 1024); } while (0)
#define PG8_LDB(dst, b, h) do { _Pragma("unroll") for (int n = 0; n < 2; ++n) _Pragma("unroll") for (int k = 0; k < 2; ++k) dst[n][k] = *(const PG8_LAS bf16x8*)(lds + PG8_SB(b, h) + boff + n * 2048 + k * 1024); } while (0)
#define PG8_MMA(ai, bj, At, Bt) do { __builtin_amdgcn_s_setprio(1); _Pragma("unroll") for (int m = 0; m < 4; ++m) _Pragma("unroll") for (int n = 0; n < 2; ++n) _Pragma("unroll") for (int k = 0; k < 2; ++k) \
        acc[ai][bj][m][n] = __builtin_amdgcn_mfma_f32_16x16x32_bf16(Bt[n][k], At[m][k], acc[ai][bj][m][n], 0, 0, 0); __builtin_amdgcn_s_setprio(0); } while (0)
#define PG8_WAIT_V(n) asm volatile("s_waitcnt vmcnt(" #n ")" ::: "memory")
#define PG8_WAIT_L(n) asm volatile("s_waitcnt lgkmcnt(" #n ")" ::: "memory")
#define PG8_BAR __builtin_amdgcn_s_barrier()
#define PG8_SCHED __builtin_amdgcn_sched_barrier(0)
    Unit cur, nxt; int ui = 0;
    if (!S.next(0, cur)) return;
    f32x4 acc[2][2][4][2];
#pragma unroll
    for (int a = 0; a < 2; ++a)
#pragma unroll
        for (int b = 0; b < 2; ++b)
#pragma unroll
            for (int m = 0; m < 4; ++m)
#pragma unroll
                for (int n = 0; n < 2; ++n) acc[a][b][m][n] = (f32x4){0.f, 0.f, 0.f, 0.f};
    bf16x8 At[4][2], B0[2][2], B1[2][2];
    const char* cA = (const char*)g.A + (size_t)cur.pm * tstep; const char* cB = (const char*)g.Bt + (size_t)cur.pn * tstep;
    S.a_ready(cur);
    if constexpr (SP2) {
        PG8_STAGE(PG8_SB(0, 0), cB, voffB); PG8_STAGE(PG8_SB(0, 1), cB + hstep, voffB); PG8_STAGE(PG8_SA(0, 0), cA, voffA); PG8_STAGE(PG8_SA(0, 1), cA + hstep, voffA);
        if (wr == 1) PG8_BAR;
        PG8_WAIT_V(2); PG8_BAR;
        PG8_STAGE(PG8_SB(1, 0), cB + kstep, voffB); PG8_STAGE(PG8_SA(1, 0), cA + kstep, voffA); PG8_STAGE(PG8_SB(1, 1), cB + hstep + kstep, voffB);
        PG8_WAIT_V(6); PG8_BAR;
    } else {
        PG8_STAGE(PG8_SB(0, 0), cB, voffB); PG8_STAGE(PG8_SA(0, 0), cA, voffA); PG8_STAGE(PG8_SB(0, 1), cB + hstep, voffB); PG8_STAGE(PG8_SA(0, 1), cA + hstep, voffA);
        if (wr == 1) PG8_BAR;
        PG8_WAIT_V(4); PG8_BAR;
        PG8_STAGE(PG8_SB(1, 0), cB + kstep, voffB); PG8_STAGE(PG8_SA(1, 0), cA + kstep, voffA); PG8_STAGE(PG8_SB(1, 1), cB + hstep + kstep, voffB);
        PG8_WAIT_V(6); PG8_BAR;
    }
    for (;;) {
        const bool has_next = S.next(ui + 1, nxt);
        const char* nA = has_next ? (const char*)g.A + (size_t)nxt.pm * tstep : cA; const char* nB = has_next ? (const char*)g.Bt + (size_t)nxt.pn * tstep : cB;
        for (int t = 0; t < nt; t += 2) {
            const bool last = (t == nt - 2);
            const char* a1 = cA + (size_t)(t + 1) * kstep;
            const char* a2 = last ? nA : cA + (size_t)(t + 2) * kstep; const char* b2 = last ? nB : cB + (size_t)(t + 2) * kstep;
            const char* a3 = a2 + kstep; const char* b3 = b2 + kstep;
            if (last && has_next) S.a_ready(nxt);
            if constexpr (SP2) {
            PG8_LDB(B0, 0, 0); PG8_LDB(B1, 0, 1); PG8_SCHED; PG8_LDA(At, 0, 0); PG8_STAGE(PG8_SA(1, 1), a1 + hstep, voffA);
            PG8_WAIT_V(8); PG8_WAIT_L(0); PG8_BAR; PG8_MMA(0, 0, At, B0); PG8_MMA(0, 1, At, B1); PG8_BAR; PG8_SCHED;
            PG8_LDA(At, 0, 1); PG8_STAGE(PG8_SB(0, 0), b2, voffB); PG8_STAGE(PG8_SB(0, 1), b2 + hstep, voffB); PG8_STAGE(PG8_SA(0, 0), a2, voffA);
            PG8_WAIT_V(8); PG8_WAIT_L(0); PG8_BAR; PG8_MMA(1, 0, At, B0); PG8_MMA(1, 1, At, B1); PG8_BAR; PG8_SCHED;
            PG8_LDB(B0, 1, 0); PG8_LDB(B1, 1, 1); PG8_SCHED; PG8_LDA(At, 1, 0); PG8_STAGE(PG8_SA(0, 1), a2 + hstep, voffA);
            PG8_WAIT_V(8); PG8_WAIT_L(0); PG8_BAR; PG8_MMA(0, 0, At, B0); PG8_MMA(0, 1, At, B1); PG8_BAR; PG8_SCHED;
            PG8_LDA(At, 1, 1); PG8_STAGE(PG8_SB(1, 0), b3, voffB); PG8_STAGE(PG8_SB(1, 1), b3 + hstep, voffB); PG8_STAGE(PG8_SA(1, 0), a3, voffA);
            PG8_WAIT_V(8); PG8_WAIT_L(0); PG8_BAR; PG8_MMA(1, 0, At, B0); PG8_MMA(1, 1, At, B1); PG8_BAR; PG8_SCHED;
            } else {
            PG8_LDB(B0, 0, 0); PG8_SCHED; PG8_LDA(At, 0, 0); PG8_STAGE(PG8_SA(1, 1), a1 + hstep, voffA);
            PG8_WAIT_L(8); PG8_BAR; PG8_WAIT_L(0); PG8_MMA(0, 0, At, B0); PG8_BAR; PG8_SCHED;
            PG8_LDB(B1, 0, 1); PG8_STAGE(PG8_SB(0, 0), b2, voffB);
            PG8_BAR; PG8_WAIT_L(0); PG8_MMA(0, 1, At, B1); PG8_BAR;
            PG8_LDA(At, 0, 1); PG8_STAGE(PG8_SA(0, 0), a2, voffA);
            PG8_BAR; PG8_WAIT_L(0); PG8_MMA(1, 0, At, B0); PG8_BAR; PG8_SCHED;
            PG8_STAGE(PG8_SB(0, 1), b2 + hstep, voffB);
            PG8_WAIT_V(6); PG8_BAR; PG8_MMA(1, 1, At, B1); PG8_BAR;
            PG8_LDB(B0, 1, 0); PG8_SCHED; PG8_LDA(At, 1, 0); PG8_STAGE(PG8_SA(0, 1), a2 + hstep, voffA);
            PG8_WAIT_L(8); PG8_BAR; PG8_WAIT_L(0); PG8_MMA(0, 0, At, B0); PG8_BAR; PG8_SCHED;
            PG8_LDB(B1, 1, 1); PG8_STAGE(PG8_SB(1, 0), b3, voffB);
            PG8_BAR; PG8_WAIT_L(0); PG8_MMA(0, 1, At, B1); PG8_BAR;
            PG8_LDA(At, 1, 1); PG8_STAGE(PG8_SA(1, 0), a3, voffA);
            PG8_BAR; PG8_WAIT_L(0); PG8_MMA(1, 0, At, B0); PG8_BAR; PG8_SCHED;
            PG8_STAGE(PG8_SB(1, 1), b3 + hstep, voffB);
            PG8_WAIT_V(6); PG8_BAR; PG8_MMA(1, 1, At, B1); PG8_BAR;
            }
        }
        if constexpr (ALIGN_EPI) { if (wr == 0) PG8_BAR; }
        if constexpr (!Epi::AFTER_DRAIN) { unsigned long long te0_ = 0; if (tepi) te0_ = __builtin_amdgcn_s_memrealtime(); E(acc, cur, wr, wc, fr, fq); S.done(cur); if (tepi) *tepi += __builtin_amdgcn_s_memrealtime() - te0_; }
        if (!has_next) break;
#pragma unroll
        for (int a = 0; a < 2; ++a)
#pragma unroll
            for (int b = 0; b < 2; ++b)
#pragma unroll
                for (int m = 0; m < 4; ++m)
#pragma unroll
                    for (int n = 0; n < 2; ++n) acc[a][b][m][n] = (f32x4){0.f, 0.f, 0.f, 0.f};
        cur = nxt; cA = nA; cB = nB; ++ui;
        if constexpr (ALIGN_EPI) { if (wr == 1) PG8_BAR; }
    }
    PG8_WAIT_V(0);
    if constexpr (!ALIGN_EPI) { if (wr == 0) PG8_BAR; }
    PG8_BAR;
    if constexpr (Epi::AFTER_DRAIN) { E.fused(acc, cur, wr, wc, fr, fq, lds, wid, lane); S.done(cur); }
#undef PG8_SA
#undef PG8_SB
#undef PG8_STAGE
#undef PG8_LDA
#undef PG8_LDB
#undef PG8_MMA
#undef PG8_WAIT_V
#undef PG8_WAIT_L
#undef PG8_BAR
#undef PG8_SCHED
}
}
#define GAS __attribute__((address_space(1)))
#define LAS __attribute__((address_space(3)))
typedef unsigned short bf16;
typedef unsigned v4u __attribute__((ext_vector_type(4)));
typedef float f32x4 __attribute__((ext_vector_type(4)));
typedef short bf16x8 __attribute__((ext_vector_type(8)));
typedef GAS unsigned gu32;
typedef GAS unsigned long long gu64;
#define RLX_AGENT __ATOMIC_RELAXED, __HIP_MEMORY_SCOPE_AGENT
#define LDS_WAIT() asm volatile("s_waitcnt lgkmcnt(0)" ::: "memory")
#define VM_WAIT() asm volatile("s_waitcnt vmcnt(0)" ::: "memory")
__device__ __forceinline__ unsigned long long rt() { return __builtin_amdgcn_s_memrealtime(); }
__device__ __forceinline__ unsigned f2bf(float f) { unsigned u = __builtin_bit_cast(unsigned, f); return (u + 0x7fffu + ((u >> 16) & 1u)) >> 16; }
__device__ __forceinline__ unsigned pk2(float lo, float hi) { return f2bf(lo) | (f2bf(hi) << 16); }

#define XB_TMO      128
#define XB_XCNT(j)  (256  + 64 * (j))
#define XB_XSUB(j)  (1280 + 64 * (j))
#define XB_XGEN(j)  (2304 + 64 * (j))
#define XB_TOP      3328
#define XB_TOPGEN   3392
#define XCD_BAR_WORDS 3456
#define XB_SPIN_CAP (1u << 18)

__device__ __forceinline__ unsigned xb_ld(unsigned* p)              { return __hip_atomic_load(p, __ATOMIC_RELAXED, __HIP_MEMORY_SCOPE_AGENT); }
__device__ __forceinline__ unsigned xb_add(unsigned* p, unsigned v) { return __hip_atomic_fetch_add(p, v, __ATOMIC_RELAXED, __HIP_MEMORY_SCOPE_AGENT); }
__device__ __forceinline__ unsigned xb_xcc_id() { return (unsigned)__builtin_amdgcn_s_getreg((3 << 11) | 20) & 0xFu; }
#define XB_SPIN(cond, bar) do { unsigned _sp = 0; while (cond) { __builtin_amdgcn_s_sleep(1); \
    if ((++_sp & 255u) == 0u) { if (xb_ld(&(bar)[XB_TMO])) break; if (_sp > XB_SPIN_CAP) { atomicAdd(&(bar)[XB_TMO], 1u); break; } } } } while (0)

struct XcdBarrier {
    unsigned* bar; unsigned x;
    volatile LAS unsigned* st;
};

__device__ __forceinline__ XcdBarrier xcd_barrier_post(unsigned* bar, volatile LAS unsigned* st) {
    XcdBarrier b; b.bar = bar; b.x = xb_xcc_id(); b.st = st;
    if (threadIdx.x == 0) (void)xb_add(&bar[XB_XCNT(b.x)], 1u);
    return b;
}
__device__ __forceinline__ void xcd_barrier_complete(unsigned* bar, unsigned x, unsigned& nloc, unsigned& nx) {
    const unsigned G = gridDim.x * gridDim.y * gridDim.z;
    unsigned sum, cnt, mine, sp = 0u;
    for (;;) {
        sum = 0u; cnt = 0u; mine = 0u;
#pragma unroll
        for (unsigned j = 0; j < 16; ++j) { const unsigned c = xb_ld(&bar[XB_XCNT(j)]); sum += c; cnt += (c > 0u) ? 1u : 0u; mine = (j == x) ? c : mine; }
        if (sum == G) break;
        __builtin_amdgcn_s_sleep(1);
        if ((++sp & 255u) == 0u) { if (xb_ld(&bar[XB_TMO])) break; if (sp > XB_SPIN_CAP) { atomicAdd(&bar[XB_TMO], 1u); break; } }
    }
    nloc = mine > 0u ? mine : 1u; nx = cnt > 0u ? cnt : 1u;
}

__device__ __forceinline__ void xcd_barrier(const XcdBarrier& b) {
    asm volatile("s_waitcnt vmcnt(0)" ::: "memory");
    __syncthreads();
    if (threadIdx.x == 0) {
        unsigned* bar = b.bar;
        __builtin_amdgcn_s_waitcnt(0);
        unsigned nloc = b.st[0], nx = b.st[1];
        if (nloc == 0u) { xcd_barrier_complete(bar, b.x, nloc, nx); b.st[0] = nloc; b.st[1] = nx; }
        const unsigned old = xb_add(&bar[XB_XSUB(b.x)], 1u);
        const unsigned gen = old / nloc;
        if (old + 1u == (gen + 1u) * nloc) {
            __builtin_amdgcn_fence(__ATOMIC_RELEASE, "agent");
            asm volatile("s_waitcnt vmcnt(0)" ::: "memory");
            const unsigned og = xb_add(&bar[XB_TOP], 1u);
            const unsigned tg = og / nx;
            if (og + 1u == (tg + 1u) * nx) xb_add(&bar[XB_TOPGEN], 1u);
            else XB_SPIN(xb_ld(&bar[XB_TOPGEN]) == tg, bar);
            __builtin_amdgcn_fence(__ATOMIC_ACQUIRE, "agent");
            xb_add(&bar[XB_XGEN(b.x)], 1u);
            asm volatile("s_waitcnt vmcnt(0)" ::: "memory");
        } else {
            XB_SPIN(xb_ld(&bar[XB_XGEN(b.x)]) == gen, bar);
            __builtin_amdgcn_fence(__ATOMIC_ACQUIRE, "agent");
            asm volatile("s_waitcnt vmcnt(0)" ::: "memory");
        }
    }
    __syncthreads();
}
constexpr int NWAVES = 8;
constexpr int DM = 1024, SEQ = 16384, NB = 16, MS = NB * 64, M = SEQ + MS;
constexpr int NIN_A = 2304, NIN_B = 4096;
constexpr float EPS = 1e-6f, LOG2E = 1.4426950408889634f, C2 = 0.125f * 1.4426950408889634f;
constexpr size_t O_Y = 0, O_KAP = 17825792, O_VAP = 17842176, O_KBP = 17858560, O_VBP = 18382848, O_KAS = 18907136, O_VAS = 19169280, O_KBS = 19431424, O_VBS = 27820032, O_END = 36208640;
constexpr size_t KiB = 1024, MiB = 1u << 20;
constexpr size_t WS_CTL = 0, CTL_ZERO_BYTES = 256 * KiB;
constexpr size_t WS_WINA = 256 * KiB;
constexpr size_t WS_WOUTA = WS_WINA + (size_t)NIN_A * DM * 2;
constexpr size_t WS_WINB = WS_WOUTA + (size_t)DM * DM * 2;
constexpr size_t WS_WOUTB = WS_WINB + (size_t)NIN_B * DM * 2;
constexpr size_t WS_SLAB = WS_WOUTB + (size_t)DM * DM * 2;
constexpr size_t ACT = (size_t)M * DM * 2;
constexpr size_t WS_XN = 18 * MiB;
constexpr size_t WS_QA = WS_XN + ACT;
constexpr size_t WS_GA = WS_QA + ACT, WS_KA = WS_GA + ACT, WS_VA = WS_KA + (size_t)M * 128 * 2;
constexpr size_t WS_QB = WS_GA;
constexpr size_t WS_KB = WS_QB + ACT, WS_VB = WS_KB + ACT, WS_GB = WS_VB + ACT;
constexpr size_t WS_CKA = WS_GB + ACT, WS_CVA = WS_CKA + (size_t)NB * 128 * 128 * 2, WS_CKB = WS_CVA + (size_t)NB * 128 * 128 * 2, WS_CVB = WS_CKB + (size_t)NB * 512 * 1024 * 2;
constexpr size_t WS_END = WS_CVB + (size_t)NB * 512 * 1024 * 2;
static_assert(WS_SLAB + (size_t)M * 16 * 4 <= WS_XN && WS_VA + (size_t)M * 128 * 2 <= WS_CKA && WS_QB >= WS_QA + ACT && WS_END <= 256 * MiB, "d_ws map");
constexpr int CW_KMAX_A = 64, CW_KMAX_B = 128;
constexpr int CW_BAR = 4096;
constexpr int RING_OFF = 0, RING_BYTES = 131072;
constexpr int PHASE_BYTES = 159744;
constexpr int LDSCTL_OFF = PHASE_BYTES, MISC_OFF = LDSCTL_OFF + 320;
constexpr int LDS_BYTES = 163840;
constexpr int AT_NS = 4;
constexpr int AT_SLOT = 0, AT_SLOTB = 16384  , AT_TAB = AT_NS * AT_SLOTB, AT_TABB = 49152, AT_WSF = AT_TAB + AT_TABB, AT_OST = AT_WSF + NWAVES * 256, AT_END = AT_OST + NWAVES * 4096;
static_assert(AT_END <= PHASE_BYTES && MISC_OFF + 128 <= LDS_BYTES, "attention LDS map");

#ifndef PROBE_SEG
#define PROBE_SEG 0
#endif
#ifndef PROBE_LAYER
#define PROBE_LAYER 1
#endif
#if PROBE_SEG
#define KSEG_BEGIN(s) unsigned long long ks_t0_##s = 0; if (PROBE_SEG == (s)) ks_t0_##s = __builtin_amdgcn_s_memrealtime();
#define KSEG_END(s) if (PROBE_SEG == (s)) F.tacc += __builtin_amdgcn_s_memrealtime() - ks_t0_##s;
#define PSEG_BEGIN(s) unsigned long long ps_t0_##s = 0; if (PROBE_SEG == (s) && LAYER == PROBE_LAYER) ps_t0_##s = __builtin_amdgcn_s_memrealtime();
#define PSEG_END(s) if (PROBE_SEG == (s) && LAYER == PROBE_LAYER) F.tacc += __builtin_amdgcn_s_memrealtime() - ps_t0_##s;
#else
#define PSEG_BEGIN(s)
#define PSEG_END(s)
#define KSEG_BEGIN(s)
#define KSEG_END(s)
#endif
struct Frame {
    unsigned long long tacc;
    LAS unsigned char* lds;
    volatile LAS unsigned* MISC;
    gu32* ctl;
    int tid, lane, wave;
    int vcu, G;
};
struct Args { const float* in[19]; float* out; unsigned char* ws; };

__device__ __forceinline__ float wave_sum(float v) {
#pragma unroll
    for (int o = 1; o < 64; o <<= 1) v += __shfl_xor(v, o);
    return v;
}
__device__ __forceinline__ float wave_max(float v) {
#pragma unroll
    for (int o = 1; o < 64; o <<= 1) v = fmaxf(v, __shfl_xor(v, o));
    return v;
}
__device__ __forceinline__ int phys_col(int c) { return (c & ~255) | (((c >> 5) & 1) << 7) | (((c >> 6) & 3) << 5) | (c & 31); }

__device__ __forceinline__ void p0_transpose_item(const float* W, int K, int N, bf16* WT, bool permute, const float* gain, LAS float* scr, int item, int lane) {
    const int nblk = N / 32, kb = item / nblk, nb = item % nblk, k0 = 64 * kb, n0 = 32 * nb;
    const float* src = W + (size_t)(k0 + (lane >> 5)) * N + n0 + (lane & 31);
    float w[32];
#pragma unroll
    for (int i = 0; i < 32; ++i) w[i] = __builtin_nontemporal_load(src + (size_t)(2 * i) * N);
    if (gain) {
#pragma unroll
        for (int i = 0; i < 32; ++i) w[i] *= gain[k0 + 2 * i + (lane >> 5)]; }
#pragma unroll
    for (int i = 0; i < 32; ++i) scr[(2 * i + (lane >> 5)) * 33 + (lane & 31)] = w[i];
    LDS_WAIT(); asm volatile("" ::: "memory");
    const int c = lane & 7;
    const int r0 = permute ? phys_col(n0) : n0;
#pragma unroll
    for (int j = 0; j < 4; ++j) { const int n = (lane >> 3) + 8 * j; const LAS float* s = scr + (8 * c) * 33 + n;
        v4u o; o.x = pk2(s[0 * 33], s[1 * 33]); o.y = pk2(s[2 * 33], s[3 * 33]); o.z = pk2(s[4 * 33], s[5 * 33]); o.w = pk2(s[6 * 33], s[7 * 33]);
        *(GAS v4u*)(WT + (size_t)(r0 + n) * K + k0 + 8 * c) = o; }
    LDS_WAIT(); asm volatile("" ::: "memory");
}
struct Row4 { f32x4 v[4]; };
__device__ __forceinline__ void row_load(Row4& r, const float* p, int lane) {
#pragma unroll
    for (int j = 0; j < 4; ++j) r.v[j] = __builtin_nontemporal_load((const GAS f32x4*)p + lane + 64 * j); }
__device__ __forceinline__ void row_store_bf16(const Row4& r, bf16* o, int lane) {
#pragma unroll
    for (int j = 0; j < 4; ++j) ((GAS unsigned long long*)o)[lane + 64 * j] = (unsigned long long)pk2(r.v[j].x, r.v[j].y) | ((unsigned long long)pk2(r.v[j].z, r.v[j].w) << 32); }
__device__ __forceinline__ void row_store_f32(const Row4& r, float* o, int lane) {
#pragma unroll
    for (int j = 0; j < 4; ++j) __builtin_nontemporal_store(r.v[j], (GAS f32x4*)o + lane + 64 * j); }
__device__ __forceinline__ const float* x_row(const Args& a, int m) { return m < SEQ ? a.in[0] + (size_t)m * DM : a.in[1] + (size_t)(m - SEQ) * DM; }
__device__ __forceinline__ void rms_finish(Row4& r, const Row4& g, bf16* o, int lane) {
    float s = 0.f;
#pragma unroll
    for (int j = 0; j < 4; ++j) s += (r.v[j].x * r.v[j].x + r.v[j].y * r.v[j].y) + (r.v[j].z * r.v[j].z + r.v[j].w * r.v[j].w);
    const float rs = rsqrtf(wave_sum(s) * (1.f / DM) + EPS);
#pragma unroll
    for (int j = 0; j < 4; ++j) r.v[j] = r.v[j] * rs * g.v[j];
    row_store_bf16(r, o, lane);
}
__device__ __forceinline__ float row_maxnorm2(const Row4& r) {
    float qm = 0.f;
#pragma unroll
    for (int j = 0; j < 4; ++j) { float q = (r.v[j].x * r.v[j].x + r.v[j].y * r.v[j].y) + (r.v[j].z * r.v[j].z + r.v[j].w * r.v[j].w);
#pragma unroll
        for (int d = 1; d < 16; d <<= 1) q += __shfl_xor(q, d);
        qm = fmaxf(qm, q); }
    return qm;
}
__device__ __forceinline__ void cache_rows_a(const float* srck, const float* srcv, bf16* dbk, bf16* dbv, float* dok, float* dov, int row, gu32* kmax, int lane) {
    constexpr int L = 128, W = 128;
    const int b = row / L, j = row % L;
    const size_t so = (size_t)row * W, oo = ((size_t)b * L + (j - 64)) * W;
    const float k0 = srck[so + 2 * lane], k1 = srck[so + 2 * lane + 1], v0 = srcv[so + 2 * lane], v1 = srcv[so + 2 * lane + 1];
    ((GAS unsigned*)(dbk + so))[lane] = pk2(k0, k1); ((GAS unsigned*)(dbv + so))[lane] = pk2(v0, v1);
    if (j >= 64) { dok[oo + 2 * lane] = k0; dok[oo + 2 * lane + 1] = k1; dov[oo + 2 * lane] = v0; dov[oo + 2 * lane + 1] = v1; }
    float q = k0 * k0 + k1 * k1;
#pragma unroll
    for (int d = 1; d < 32; d <<= 1) q += __shfl_xor(q, d);
    q = fmaxf(q, __shfl_xor(q, 32));
    if (lane == 0) __hip_atomic_fetch_max(kmax, __float_as_uint(q), __ATOMIC_RELAXED, __HIP_MEMORY_SCOPE_AGENT);
}
__device__ __forceinline__ void p0_prologue(Frame& F, const Args& a) {
    LAS float* scr = (LAS float*)(F.lds + RING_OFF + F.wave * 16384);
    const int gw = F.vcu * NWAVES + F.wave, NGW = F.G * NWAVES, lane = F.lane;
    unsigned char* ws = a.ws;
    bf16* XN = (bf16*)(ws + WS_XN);
    {
        Row4 g, a0, a1, b0, b1; row_load(g, a.in[7], lane);
        const int S = NGW;
        int m = gw;
#define XLOAD(R0, R1, mm) do { if ((mm) < M) row_load(R0, x_row(a, (mm)), lane); if ((mm) + S < M) row_load(R1, x_row(a, (mm) + S), lane); } while (0)
#define XFIN(R0, R1, mm) do { if ((mm) < M) rms_finish(R0, g, XN + (size_t)(mm) * DM, lane); if ((mm) + S < M) rms_finish(R1, g, XN + (size_t)((mm) + S) * DM, lane); } while (0)
        XLOAD(a0, a1, m);
        for (; m < M; m += 4 * S) {
            XLOAD(b0, b1, m + 2 * S);
            XFIN(a0, a1, m);
            XLOAD(a0, a1, m + 4 * S);
            XFIN(b0, b1, m + 2 * S);
        }
#undef XLOAD
#undef XFIN
    }
    constexpr int I_INA = (DM / 64) * (NIN_A / 32);
    for (int it = gw; it < I_INA; it += NGW) p0_transpose_item(a.in[8], DM, NIN_A, (bf16*)(ws + WS_WINA), true, nullptr, scr, it, lane);
    for (int r = gw; r < NB * 128; r += NGW)
        cache_rows_a(a.in[2], a.in[3], (bf16*)(ws + WS_CKA), (bf16*)(ws + WS_CVA), a.out + O_KAS, a.out + O_VAS, r, F.ctl + CW_KMAX_A, lane);
}
__device__ __forceinline__ void side_weights(Frame& F, const Args& a, int w, int nw) {
    LAS float* scr = (LAS float*)(F.lds + RING_OFF + F.wave * 16384);
    unsigned char* ws = a.ws;
    constexpr int I_O = (DM / 64) * (DM / 32), I_INB = (DM / 64) * (NIN_B / 32);
    for (int it = w; it < I_O + I_INB + I_O; it += nw) {
        int r = it;
        if (r < I_O) { p0_transpose_item(a.in[12], DM, DM, (bf16*)(ws + WS_WOUTA), false, nullptr, scr, r, F.lane); continue; } r -= I_O;
        if (r < I_INB) { p0_transpose_item(a.in[14], DM, NIN_B, (bf16*)(ws + WS_WINB), true, a.in[13], scr, r, F.lane); continue; } r -= I_INB;
        p0_transpose_item(a.in[18], DM, DM, (bf16*)(ws + WS_WOUTB), false, nullptr, scr, r, F.lane);
    }
}
__device__ __forceinline__ void side_cache_b_conv(Frame& F, const Args& a, int w, int nw, int r_lo, int r_hi) {
    unsigned char* ws = a.ws; const int lane = F.lane;
    const float* srck = a.in[4]; const float* srcv = a.in[5];
    bf16* dbk = (bf16*)(ws + WS_CKB); bf16* dbv = (bf16*)(ws + WS_CVB); float* dok = a.out + O_KBS; float* dov = a.out + O_VBS;
    const int NR = r_hi;
    Row4 ka, va, kb, vb; float qm = 0.f;
#define CB_LOAD(K_, V_, r) do { row_load(K_, srck + (size_t)(r) * DM, lane); row_load(V_, srcv + (size_t)(r) * DM, lane); } while (0)
#define CB_FIN(K_, V_, r) do { const size_t so_ = (size_t)(r) * DM; row_store_bf16(K_, dbk + so_, lane); row_store_bf16(V_, dbv + so_, lane); \
        if (((r) & 511) >= 64) { const size_t oo_ = so_ - 64 * DM; row_store_f32(K_, dok + oo_, lane); row_store_f32(V_, dov + oo_, lane); }     \
        qm = fmaxf(qm, row_maxnorm2(K_)); } while (0)
    int r = r_lo + w;
    if (r < NR) CB_LOAD(ka, va, r);
    for (; r < NR; r += 2 * nw) {
        const int r1 = r + nw, r2 = r + 2 * nw;
        if (r1 < NR) CB_LOAD(kb, vb, r1);
        CB_FIN(ka, va, r);
        if (r2 < NR) CB_LOAD(ka, va, r2);
        if (r1 < NR) CB_FIN(kb, vb, r1);
    }
#undef CB_LOAD
#undef CB_FIN
    qm = wave_max(qm);
    if (lane == 0) __hip_atomic_fetch_max(F.ctl + CW_KMAX_B, __float_as_uint(qm), __ATOMIC_RELAXED, __HIP_MEMORY_SCOPE_AGENT);
}
__device__ __forceinline__ void side_cache_b_copy(Frame& F, const Args& a, int w, int nw, int r_lo, int r_hi) {
    const int lane = F.lane;
    const float* srck = a.in[4]; const float* srcv = a.in[5]; float* dok = a.out + O_KBS; float* dov = a.out + O_VBS;
    const int NR = r_hi;
    Row4 ka, va, kb, vb;
#define CP_SRC(r) ((size_t)((r) / 448) * 512 + 64 + (r) % 448)
#define CP_DST(r) ((size_t)((r) / 448) * 512 + (r) % 448)
#define CP_LOAD(K_, V_, r) do { const size_t so_ = CP_SRC(r) * DM; row_load(K_, srck + so_, lane); row_load(V_, srcv + so_, lane); } while (0)
#define CP_FIN(K_, V_, r) do { const size_t oo_ = CP_DST(r) * DM; row_store_f32(K_, dok + oo_, lane); row_store_f32(V_, dov + oo_, lane); } while (0)
    int r = r_lo + w;
    if (r < NR) CP_LOAD(ka, va, r);
    for (; r < NR; r += 2 * nw) {
        const int r1 = r + nw, r2 = r + 2 * nw;
        if (r1 < NR) CP_LOAD(kb, vb, r1);
        CP_FIN(ka, va, r);
        if (r2 < NR) CP_LOAD(ka, va, r2);
        if (r1 < NR) CP_FIN(kb, vb, r1);
    }
#undef CP_SRC
#undef CP_DST
#undef CP_LOAD
#undef CP_FIN
}
template <int LAYER> __device__ __forceinline__ void tail_outproj(LAS unsigned char* lds, const bf16* A, const bf16* Bt, int c, const float* xs, bf16* yb, float* slab, float* out) {
    int tid_ = threadIdx.x; asm volatile("" : "+v"(tid_));
    const int tid = tid_, lane = tid & 63, wid = __builtin_amdgcn_readfirstlane(tid >> 6), fr = lane & 15, fq = lane >> 4;
    const int rb = c >> 4, cb = c & 15, row0 = SEQ + 64 * rb, col0 = 64 * cb;
    const bf16* ap = A + (size_t)(row0 + fr) * DM + 128 * wid + 8 * fq;
    const bf16* bp = Bt + (size_t)(col0 + fr) * DM + 128 * wid + 8 * fq;
    bf16x8 af[4][4], bfr[4][4];
#pragma unroll
    for (int m = 0; m < 4; ++m)
#pragma unroll
        for (int ks = 0; ks < 4; ++ks) { af[m][ks] = *(const GAS bf16x8*)(ap + (size_t)(16 * m) * DM + 32 * ks); bfr[m][ks] = *(const GAS bf16x8*)(bp + (size_t)(16 * m) * DM + 32 * ks); }
    f32x4 acc[4][4];
#pragma unroll
    for (int m = 0; m < 4; ++m)
#pragma unroll
        for (int n = 0; n < 4; ++n) { acc[m][n] = (f32x4){0.f, 0.f, 0.f, 0.f};
#pragma unroll
            for (int ks = 0; ks < 4; ++ks) acc[m][n] = __builtin_amdgcn_mfma_f32_16x16x32_bf16(bfr[n][ks], af[m][ks], acc[m][n], 0, 0, 0); }
    LAS float* part = (LAS float*)lds + wid * 4096;
#pragma unroll
    for (int m = 0; m < 4; ++m)
#pragma unroll
        for (int n = 0; n < 4; ++n) *(LAS f32x4*)(part + (16 * m + fr) * 64 + 16 * n + 4 * fq) = acc[m][n];
    __syncthreads();
    const int r = tid >> 3, c8 = (tid & 7) * 8;
    f32x4 s0 = (f32x4){0.f, 0.f, 0.f, 0.f}, s1 = s0;
#pragma unroll
    for (int w = 0; w < 8; ++w) { const LAS float* p = (const LAS float*)lds + w * 4096 + r * 64 + c8; s0 += *(const LAS f32x4*)p; s1 += *(const LAS f32x4*)(p + 4); }
    const int row = row0 + r;
    if (LAYER == 1) {
        const v4u w = *(const GAS v4u*)(yb + (size_t)row * DM + col0 + c8);
        const f32x4 r0 = {__uint_as_float(w.x << 16), __uint_as_float(w.x & 0xffff0000u), __uint_as_float(w.y << 16), __uint_as_float(w.y & 0xffff0000u)};
        const f32x4 r1 = {__uint_as_float(w.z << 16), __uint_as_float(w.z & 0xffff0000u), __uint_as_float(w.w << 16), __uint_as_float(w.w & 0xffff0000u)};
        float* op = out + (size_t)row * DM + col0 + c8;
        *(GAS f32x4*)op = s0 + r0; *(GAS f32x4*)(op + 4) = s1 + r1;
        __syncthreads();
        return;
    }
    const float* xp = xs + (size_t)(row - SEQ) * DM + col0 + c8;
    const f32x4 y0 = s0 + *(const GAS f32x4*)xp, y1 = s1 + *(const GAS f32x4*)(xp + 4);
    v4u wv; wv.x = pk2(y0[0], y0[1]); wv.y = pk2(y0[2], y0[3]); wv.z = pk2(y1[0], y1[1]); wv.w = pk2(y1[2], y1[3]);
    *(GAS v4u*)(yb + (size_t)row * DM + col0 + c8) = wv;
    float ss = ((y0[0] * y0[0] + y0[1] * y0[1]) + (y0[2] * y0[2] + y0[3] * y0[3])) + ((y1[0] * y1[0] + y1[1] * y1[1]) + (y1[2] * y1[2] + y1[3] * y1[3]));
    ss += __shfl_xor(ss, 1); ss += __shfl_xor(ss, 2); ss += __shfl_xor(ss, 4);
    if ((tid & 7) == 0) slab[(size_t)row * 16 + cb] = ss;
    __syncthreads();
}

namespace attn {
using bf16x8 = __attribute__((ext_vector_type(8))) short;
using s16x4 = __attribute__((ext_vector_type(4))) short;
using f32x16 = __attribute__((ext_vector_type(16))) float;
using u32x4 = pg8::u32x4;
typedef short v4i16_t __attribute__((ext_vector_type(4)));
typedef __attribute__((address_space(3))) const char* lds_cptr;
__device__ __forceinline__ int crow(int r, int hi) { return (r & 3) + 8 * (r >> 2) + 4 * hi; }
__device__ __forceinline__ s16x4 vtr(lds_cptr p) { return __builtin_bit_cast(s16x4, __builtin_amdgcn_ds_read_tr16_b64_v4i16((__attribute__((address_space(3))) v4i16_t*)p)); }
typedef float f32x2_t __attribute__((ext_vector_type(2))); typedef __bf16 bf16x2_t __attribute__((ext_vector_type(2)));
__device__ __forceinline__ unsigned cvtpk(float lo, float hi) { f32x2_t v = {lo, hi}; bf16x2_t b = __builtin_convertvector(v, bf16x2_t); return __builtin_bit_cast(unsigned, b); }
__device__ __forceinline__ int t5_bucket(int rel) {
    const int n = rel < 0 ? -rel : rel;
    int b = n;
    if (n >= 8) b = 8 + (n >= 12) + (n >= 16) + (n >= 23) + (n >= 32) + (n >= 46) + (n >= 64) + (n >= 91);
    return b + (rel > 0 ? 16 : 0);
}
__device__ __forceinline__ void glds16(const void* gsrc, unsigned lds_dst) { unsigned keep;
    asm volatile("s_mov_b32 %0, m0\n\ts_mov_b32 m0, %2\n\ts_nop 0\n\tglobal_load_lds_dwordx4 %1, off\n\ts_mov_b32 m0, %0" : "=&s"(keep) : "v"(gsrc), "s"(lds_dst) : "memory"); }
__device__ __forceinline__ float bf2f(unsigned short h) { return __uint_as_float((unsigned)h << 16); }

template <int LAYER>
__device__ __forceinline__ void attn_phase(Frame& F, const Args& a) {
    constexpr int P = LAYER == 0 ? 2 : 8;
    constexpr int KVW = LAYER == 0 ? 128 : 1024;
    constexpr int L = P * 64;
    constexpr int RT0 = LAYER == 0 ? 0 : 6;
    unsigned char* ws = a.ws;
    const bf16* Q = (const bf16*)(ws + (LAYER == 0 ? WS_QA : WS_QB));
    const bf16* Kg = (const bf16*)(ws + (LAYER == 0 ? WS_KA : WS_KB));
    const bf16* Vg = (const bf16*)(ws + (LAYER == 0 ? WS_VA : WS_VB));
    const bf16* Gt = (const bf16*)(ws + (LAYER == 0 ? WS_GA : WS_GB));
    const bf16* CK = (const bf16*)(ws + (LAYER == 0 ? WS_CKA : WS_CKB));
    const bf16* CV = (const bf16*)(ws + (LAYER == 0 ? WS_CVA : WS_CVB));
    bf16* O = (bf16*)(ws + WS_XN);
    const float* qg = a.in[LAYER == 0 ? 9 : 15]; const float* kg = a.in[LAYER == 0 ? 10 : 16];
    const float* table = a.in[LAYER == 0 ? 6 : 17];
    int tid_ = threadIdx.x; asm volatile("" : "+v"(tid_));
    const int tid = tid_, lane = tid & 63, wid = __builtin_amdgcn_readfirstlane(tid >> 6), r32 = lane & 31, hi = lane >> 5;
    const int h = F.vcu >> 4, sub = F.vcu & 15;
    const int kvh = LAYER == 0 ? (h >> 3) : h;
    LAS unsigned char* lds = F.lds + RING_OFF;
    const int cw = wid >> 1, half = wid & 1;
    const unsigned lds0 = (unsigned)(size_t)lds;
#define UNIT_PARAMS(ui_, X) const bool X##sample = (ui_) == 4; const int X##u0 = 4 * (4 * sub + (ui_)); const int X##nt = X##sample ? P + 1 : P + 4; \
        const int X##tb = X##sample ? 0 : (X##u0 >= P ? 0 : P - X##u0); const bool X##won = !X##sample || cw == 0; \
        const size_t X##qtok = X##sample ? (size_t)SEQ + 64 * sub + 32 * half : (size_t)64 * (X##u0 + cw) + 32 * half;
#define TILE_DMA_U(X, t, slot_) do { const bf16 *kb_, *vb_; \
            if (!X##sample) { const size_t r0_ = (size_t)64 * (X##u0 - P + (t)) * KVW; kb_ = Kg + r0_; vb_ = Vg + r0_; } \
            else if ((t) < P) { const size_t r0_ = ((size_t)sub * L + 64 * (t)) * KVW; kb_ = CK + r0_; vb_ = CV + r0_; } \
            else { const size_t r0_ = ((size_t)SEQ + 64 * sub) * KVW; kb_ = Kg + r0_; vb_ = Vg + r0_; } \
            const unsigned s_ = (unsigned)__builtin_amdgcn_readfirstlane(lds0 + AT_SLOT + ((slot_) & 3) * AT_SLOTB + wid * 1024); \
            glds16(kb_ + koff, s_); glds16(vb_ + voff, s_ + 8192); } while (0)
#define Q_DMA_U(X) do { if (X##won) { _Pragma("unroll") for (int i_ = 0; i_ < 4; ++i_) glds16(Q + (X##qtok + 8 * i_ + (lane >> 3)) * DM + h * 64 + (lane & 7) * 8, (unsigned)__builtin_amdgcn_readfirstlane(lds0 + AT_OST + wid * 4096 + i_ * 1024)); } } while (0)
#define WAIT_BAR(N) asm volatile("s_waitcnt vmcnt(" #N ") lgkmcnt(0)\n\ts_barrier" ::: "memory")
    const size_t koff = (size_t)lane * KVW + kvh * 64 + wid * 8, voff = (size_t)(16 * (wid & 3) + (lane >> 2)) * KVW + kvh * 64 + (wid >> 2) * 32 + (lane & 3) * 8;
    int sb = 0;
    {
        UNIT_PARAMS(0, f_)
        Q_DMA_U(f_); TILE_DMA_U(f_, f_tb, 0); TILE_DMA_U(f_, f_tb + 1, 1);
    }
    PSEG_BEGIN(1) PSEG_BEGIN(5)
    constexpr int NBR = LAYER == 0 ? 32 : 257;
    LAS float* brow = (LAS float*)(lds + AT_WSF);
    for (int i = tid; i < NBR; i += NWAVES * 64) brow[i] = LAYER == 0 ? table[i * 16 + h] : table[h * 257 + i];
    const float gqa = fabsf(qg[lane]), gka = fabsf(kg[lane]);
    const unsigned kcb = __hip_atomic_load(F.ctl + (LAYER == 0 ? CW_KMAX_A : CW_KMAX_B), __ATOMIC_RELAXED, __HIP_MEMORY_SCOPE_AGENT);
    const float sinkv = LAYER == 0 ? a.in[11][h] : 0.f;
    __syncthreads();
    float bm = -1e30f;
    for (int i = lane; i < NBR; i += 64) bm = fmaxf(bm, brow[i]);
    bm = wave_max(bm);
    const float gqm = wave_max(gqa), gkm = wave_max(gka), kc = sqrtf(__uint_as_float(kcb));
    const float bound = gqm * fmaxf(8.f * gkm, kc) * 1.01f + bm;
    const float cconst = LAYER == 0 ? 0.f : (brow[256 % NBR] - bound) * LOG2E;
    const float sinkp = LAYER == 0 ? __builtin_amdgcn_exp2f((sinkv - bound) * LOG2E) : 0.f;
    {
        LAS float* tab = (LAS float*)(lds + AT_TAB);
        for (int i = tid; i < 3 * 2 * 8 * 64 * 4; i += NWAVES * 64) {
            const int e = i & 3, ln = (i >> 2) & 63, q4 = (i >> 8) & 7, half = (i >> 11) & 1, rtv = i >> 12;
            const int R = 4 * q4 + e, key = 32 * (R >> 4) + crow(R & 15, ln >> 5), qi = 32 * half + (ln & 31), j = 64 * (RT0 + rtv) + key;
            float bv;
            if (LAYER == 0) bv = brow[t5_bucket(j - (P * 64 + qi))];
            else { int idx = P * 64 + qi - j; idx = idx < -128 ? -128 : (idx > 128 ? 128 : idx); bv = brow[(idx + 128) % NBR]; }
            tab[i] = (bv - bound) * LOG2E;
        }
    }
    __syncthreads();
    f32x16 cc16;
#pragma unroll
    for (int r = 0; r < 16; ++r) cc16[r] = cconst;
    asm volatile("" : "+v"(cc16));
    PSEG_END(5)
    const lds_cptr lds3 = (lds_cptr)lds;
    const lds_cptr kp0 = lds3 + AT_SLOT + hi * 1024 + r32 * 16;
    const lds_cptr vp0 = lds3 + AT_SLOT + 8192 + ((lane >> 4) & 1) * 32 + (lane & 3) * 8 + (4 * hi + ((lane & 15) >> 2)) * 64;
    const LAS f32x4* tabl = (const LAS f32x4*)(lds + AT_TAB) + lane;
    LAS float* wsf = (LAS float*)(lds + AT_WSF) + wid * 64;
    for (int ui = 0; ui < 5; ++ui) {
        PSEG_BEGIN(2)
        UNIT_PARAMS(ui, c_)
        const bool sample = c_sample, wave_on = c_won, has_next = ui < 4; const int nt = c_nt, t_begin = c_tb; const size_t qtok = c_qtok;
        UNIT_PARAMS(ui + 1, n_)
        f32x16 o[2]; o[0] = f32x16{}; o[1] = f32x16{};
        float l_reg = 0.f;
        if (ui == 0) WAIT_BAR(2); else WAIT_BAR(4);
        PSEG_END(2) PSEG_BEGIN(3)
        bf16x8 qr[4];
#pragma unroll
        for (int d0 = 0; d0 < 4; ++d0) qr[d0] = *(const __attribute__((address_space(3))) bf16x8*)(lds3 + AT_OST + wid * 4096 + r32 * 128 + (2 * d0 + hi) * 16);
        u32x4 pw[4];
#pragma unroll
        for (int s = 0; s < 4; ++s) pw[s] = (u32x4){0u, 0u, 0u, 0u};
        v4u gpre[4];
#pragma unroll
        for (int i = 0; i < 4; ++i) gpre[i] = (v4u){0u, 0u, 0u, 0u};
#define STEP_HEAD(t) const int sl = (t) - t_begin + sb;                    \
            if ((t) + 2 < nt) TILE_DMA_U(c_, (t) + 2, sl + 2);             \
            if ((t) == nt - 1) { \
                if (wave_on) { _Pragma("unroll") for (int i = 0; i < 4; ++i) gpre[i] = *(const GAS v4u*)(Gt + (qtok + i * 8 + (lane >> 3)) * DM + h * 64 + (lane & 7) * 8); } \
                asm volatile("" ::: "memory"); \
                if (has_next) { Q_DMA_U(n_); TILE_DMA_U(n_, n_tb, sl + 1); } }     \
            if ((t) == nt && has_next) TILE_DMA_U(n_, n_tb + 1, sl + 1);
#define STEP_TAIL(t) if ((t) + 2 < nt) WAIT_BAR(2); else if ((t) + 2 == nt || !has_next) WAIT_BAR(0); else WAIT_BAR(63);
        const int a_lo = wave_on ? (cw > t_begin ? cw : t_begin) : nt + 1, a_hi = wave_on ? (cw + P + 1 < nt ? cw + P + 1 : nt) : nt;
        int t = t_begin;
        for (; t < a_lo && t <= nt; ++t) { STEP_HEAD(t) STEP_TAIL(t) }
        for (; t <= a_hi; ++t) {
            STEP_HEAD(t)
            const int rt = t - cw;
            {
                const bool last = rt == P + 1 || t == nt, first = rt == 0 || t == t_begin;
                const int rtb = last ? rt - 1 : rt;
                const int ko = ((last ? sl - 1 : sl) & 3) * AT_SLOTB, vo = ((first ? sl : sl - 1) & 3) * AT_SLOTB;
                const lds_cptr kp = kp0 + ko, vp = vp0 + vo;
                bf16x8 kf[8];
#pragma unroll
                for (int d0 = 0; d0 < 4; ++d0) { kf[2 * d0] = *(const __attribute__((address_space(3))) bf16x8*)(kp + d0 * 2048); kf[2 * d0 + 1] = *(const __attribute__((address_space(3))) bf16x8*)(kp + d0 * 2048 + 512); }
                f32x16 p0, p1;
                __builtin_amdgcn_s_setprio(1);
                if (rtb >= RT0) { const LAS f32x4* tp = tabl + ((rtb - RT0) * 2 + half) * 8 * 64;
                    const f32x16 t0 = __builtin_shufflevector(__builtin_shufflevector(tp[0], tp[64], 0, 1, 2, 3, 4, 5, 6, 7), __builtin_shufflevector(tp[128], tp[192], 0, 1, 2, 3, 4, 5, 6, 7), 0, 1, 2, 3, 4, 5, 6, 7, 8, 9, 10, 11, 12, 13, 14, 15);
                    const f32x16 t1 = __builtin_shufflevector(__builtin_shufflevector(tp[256], tp[320], 0, 1, 2, 3, 4, 5, 6, 7), __builtin_shufflevector(tp[384], tp[448], 0, 1, 2, 3, 4, 5, 6, 7), 0, 1, 2, 3, 4, 5, 6, 7, 8, 9, 10, 11, 12, 13, 14, 15);
                    p0 = __builtin_amdgcn_mfma_f32_32x32x16_bf16(kf[0], qr[0], t0, 0, 0, 0); p1 = __builtin_amdgcn_mfma_f32_32x32x16_bf16(kf[1], qr[0], t1, 0, 0, 0); }
                else { p0 = __builtin_amdgcn_mfma_f32_32x32x16_bf16(kf[0], qr[0], cc16, 0, 0, 0); p1 = __builtin_amdgcn_mfma_f32_32x32x16_bf16(kf[1], qr[0], cc16, 0, 0, 0); }
#pragma unroll
                for (int d0 = 1; d0 < 4; ++d0) { p0 = __builtin_amdgcn_mfma_f32_32x32x16_bf16(kf[2 * d0], qr[d0], p0, 0, 0, 0); p1 = __builtin_amdgcn_mfma_f32_32x32x16_bf16(kf[2 * d0 + 1], qr[d0], p1, 0, 0, 0); }
                bf16x8 vf[8];
#pragma unroll
                for (int i = 0; i < 8; ++i) { const s16x4 lo = vtr(vp + (i >> 2) * 4096 + (i & 3) * 1024), hh = vtr(vp + (i >> 2) * 4096 + (i & 3) * 1024 + 512); vf[i] = (bf16x8){lo[0], lo[1], lo[2], lo[3], hh[0], hh[1], hh[2], hh[3]}; }
#pragma unroll
                for (int ks = 0; ks < 4; ++ks) { o[0] = __builtin_amdgcn_mfma_f32_32x32x16_bf16(__builtin_bit_cast(bf16x8, pw[ks]), vf[ks], o[0], 0, 0, 0); o[1] = __builtin_amdgcn_mfma_f32_32x32x16_bf16(__builtin_bit_cast(bf16x8, pw[ks]), vf[4 + ks], o[1], 0, 0, 0); }
                __builtin_amdgcn_s_setprio(0);
                float sacc = 0.f;
#pragma unroll
                for (int r = 0; r < 16; ++r) { p0[r] = __builtin_amdgcn_exp2f(p0[r]); p1[r] = __builtin_amdgcn_exp2f(p1[r]); sacc += p0[r] + p1[r]; }
                l_reg += last ? 0.f : sacc;
#pragma unroll
                for (int s = 0; s < 2; ++s)
#pragma unroll
                    for (int i = 0; i < 4; ++i) { pw[s][i] = cvtpk(p0[8 * s + 2 * i], p0[8 * s + 2 * i + 1]); pw[2 + s][i] = cvtpk(p1[8 * s + 2 * i], p1[8 * s + 2 * i + 1]); }
            }
            STEP_TAIL(t)
        }
        for (; t <= nt; ++t) { STEP_HEAD(t) STEP_TAIL(t) }
#undef STEP_HEAD
#undef STEP_TAIL
        PSEG_END(3) PSEG_BEGIN(4)
#undef TILE_DMA
#undef WAIT_BAR
        if (wave_on) {
            l_reg += __shfl_xor(l_reg, 32);
            l_reg += sinkp;
            if (hi == 0) wsf[r32] = l_reg;
            LDS_WAIT(); asm volatile("" ::: "memory");
            LAS unsigned short* stg = (LAS unsigned short*)(lds + AT_SLOT + (((nt - 2 - t_begin + sb) + (wid >> 2)) & 3) * AT_SLOTB + (wid & 3) * 4096);
#pragma unroll
            for (int r = 0; r < 16; ++r) { const int orow = crow(r, hi); const float rl = __builtin_amdgcn_rcpf(wsf[orow]);
#pragma unroll
                for (int d0 = 0; d0 < 2; ++d0) stg[orow * 64 + d0 * 32 + r32] = (unsigned short)(f2bf(o[d0][r] * rl)); }
            LDS_WAIT(); asm volatile("" ::: "memory");
#pragma unroll
            for (int i = 0; i < 4; ++i) { const int row = i * 8 + (lane >> 3), ch = lane & 7;
                const v4u ov = *(const LAS v4u*)(stg + row * 64 + ch * 8);
                const size_t go = (qtok + row) * DM + h * 64 + ch * 8;
                const v4u gvv = gpre[i];
                v4u res;
#pragma unroll
                for (int e = 0; e < 4; ++e) { const float a0 = __uint_as_float(ov[e] << 16) * __uint_as_float(gvv[e] << 16), a1 = __uint_as_float(ov[e] & 0xffff0000u) * __uint_as_float(gvv[e] & 0xffff0000u); res[e] = cvtpk(a0, a1); }
                *(GAS v4u*)(O + go) = res; }
        }
        sb += nt - t_begin;
        PSEG_END(4)
    }
    __syncthreads();
    PSEG_END(1)
}
template <int NV> __device__ __forceinline__ void wait_bar_n(int n) {
#define WB_(N) case N: asm volatile("s_waitcnt vmcnt(" #N ") lgkmcnt(0)\n\ts_barrier" ::: "memory"); break;
    switch (n) { WB_(0) WB_(2) WB_(4) WB_(6) WB_(8) WB_(10) WB_(12) WB_(14) WB_(16) WB_(18) WB_(20) WB_(22) WB_(24) WB_(26) WB_(28) default: asm volatile("s_waitcnt vmcnt(0) lgkmcnt(0)\n\ts_barrier" ::: "memory"); break; }
#undef WB_
}
__device__ __forceinline__ void attn_phase_a(Frame& F, const Args& a) {
    constexpr int P = 2, KVW = 128, NCH = 272, NSL = 5, SLOTB = 16384;
    constexpr int A2_RING = 0, A2_TT = NSL * SLOTB, A2_WSF = A2_TT + 8192, A2_Q = A2_WSF + 3072, A2_OST = A2_Q + NWAVES * 4096, A2_END = A2_OST + NWAVES * 4096;
    static_assert(A2_Q % 1024 == 0 && A2_END <= PHASE_BYTES, "layer A attention LDS map");
    unsigned char* ws = a.ws;
    const bf16* Q = (const bf16*)(ws + WS_QA); const bf16* Kg = (const bf16*)(ws + WS_KA); const bf16* Vg = (const bf16*)(ws + WS_VA); const bf16* Gt = (const bf16*)(ws + WS_GA);
    const bf16* CK = (const bf16*)(ws + WS_CKA); const bf16* CV = (const bf16*)(ws + WS_CVA);
    bf16* O = (bf16*)(ws + WS_XN);
    const float* qg = a.in[9]; const float* kg = a.in[10]; const float* table = a.in[6];
    int tid_ = threadIdx.x; asm volatile("" : "+v"(tid_));
    const int tid = tid_, lane = tid & 63, wid = __builtin_amdgcn_readfirstlane(tid >> 6), r32 = lane & 31, hi = lane >> 5;
    const int combo = F.vcu >> 6, g = combo >> 1, half = combo & 1, cidx = F.vcu & 63;
    const int c_lo = (cidx * NCH) >> 6, c_hi = ((cidx + 1) * NCH) >> 6;
    const int h = 8 * g + wid;
    LAS unsigned char* lds = F.lds + RING_OFF;
    const unsigned lds0 = (unsigned)(size_t)lds;
    const lds_cptr lds3 = (lds_cptr)lds;
    const int cp_hi = c_hi < 256 ? c_hi : 256;
    const int a0 = c_lo >= 2 ? c_lo - 2 : 0;
    const int npt = c_lo < 256 ? (cp_hi - 1) - a0 + 1 : 0;
    const int cs_lo = c_lo > 256 ? c_lo : 256;
#define T0_OF(c) (((c) < 2) ? 2 - (c) : 0)
#define POS_OF(c, ti) ((c) < 256 ? ((c) - 2 + (ti)) - a0 : npt + 3 * ((c) - cs_lo) + (ti))
#define NEW_OF(c, ti) ((c) >= 256 || (c) == c_lo || (ti) == 2)
#define QTOK_OF(c) ((c) < 256 ? (size_t)64 * (c) + 32 * half : (size_t)SEQ + 64 * ((c) - 256) + 32 * half)
    const size_t koff = (size_t)lane * KVW + g * 64 + wid * 8, voff = (size_t)(16 * (wid & 3) + (lane >> 2)) * KVW + g * 64 + (wid >> 2) * 32 + (lane & 3) * 8;
#define TILE_DMA_A(c, ti) do { const bf16 *kb_, *vb_; \
        if ((c) < 256) { const size_t r0_ = (size_t)64 * ((c) - 2 + (ti)) * KVW; kb_ = Kg + r0_; vb_ = Vg + r0_; } \
        else if ((ti) < 2) { const size_t r0_ = ((size_t)((c) - 256) * 128 + 64 * (ti)) * KVW; kb_ = CK + r0_; vb_ = CV + r0_; } \
        else { const size_t r0_ = ((size_t)SEQ + 64 * ((c) - 256)) * KVW; kb_ = Kg + r0_; vb_ = Vg + r0_; } \
        const unsigned s_ = (unsigned)__builtin_amdgcn_readfirstlane(lds0 + A2_RING + (POS_OF(c, ti) % NSL) * SLOTB + wid * 1024); \
        glds16(kb_ + koff, s_); glds16(vb_ + voff, s_ + 8192); } while (0)
#define Q_DMA_A(c) do { const size_t qt_ = QTOK_OF(c); _Pragma("unroll") for (int i_ = 0; i_ < 4; ++i_) glds16(Q + (qt_ + 8 * i_ + (lane >> 3)) * DM + h * 64 + (lane & 7) * 8, (unsigned)__builtin_amdgcn_readfirstlane(lds0 + A2_Q + wid * 4096 + i_ * 1024)); } while (0)
#define STEP_NEXT(c, ti) do { if ((ti) < 2) ++(ti); else { ++(c); (ti) = T0_OF(c); } } while (0)
    int c3 = c_lo, t3 = T0_OF(c_lo);
    Q_DMA_A(c_lo);
#pragma unroll 1
    for (int k = 0; k < 3; ++k) { if (c3 < c_hi) { if (NEW_OF(c3, t3)) TILE_DMA_A(c3, t3); STEP_NEXT(c3, t3); } }
    const float gqm = wave_max(fabsf(qg[lane])), gkm = wave_max(fabsf(kg[lane]));
    const float kc = sqrtf(__uint_as_float(__hip_atomic_load(F.ctl + CW_KMAX_A, __ATOMIC_RELAXED, __HIP_MEMORY_SCOPE_AGENT)));
    const float bm = wave_max(lane < 32 ? table[lane * 16 + h] : -1e30f);
    const float bound = gqm * fmaxf(8.f * gkm, kc) * 1.01f + bm;
    const float sinkp = __builtin_amdgcn_exp2f((a.in[11][h] - bound) * LOG2E);
    LAS float* TTw = (LAS float*)(lds + A2_TT) + wid * 256;
    for (int i = lane; i < 255; i += 64) TTw[i] = (table[t5_bucket(i - 191) * 16 + h] - bound) * LOG2E;
    const LAS float* tql = TTw + (63 - 32 * half - r32 + 4 * hi);
    const lds_cptr kp0 = lds3 + A2_RING + hi * 1024 + r32 * 16;
    const lds_cptr vp0 = lds3 + A2_RING + 8192 + ((lane >> 4) & 1) * 32 + (lane & 3) * 8 + (4 * hi + ((lane & 15) >> 2)) * 64;
    LAS float* wsf = (LAS float*)(lds + A2_WSF) + wid * 64;
    asm volatile("s_waitcnt vmcnt(0) lgkmcnt(0)\n\ts_barrier" ::: "memory");
    f32x16 o[2]; o[0] = f32x16{}; o[1] = f32x16{};
    float l_reg = 0.f;
    u32x4 pw[4];
#pragma unroll
    for (int s = 0; s < 4; ++s) pw[s] = (u32x4){0u, 0u, 0u, 0u};
    bf16x8 qr[4];
    v4u gpre[4];
    { const size_t qt0 = QTOK_OF(c_lo);
#pragma unroll
      for (int i = 0; i < 4; ++i) gpre[i] = *(const GAS v4u*)(Gt + (qt0 + i * 8 + (lane >> 3)) * DM + h * 64 + (lane & 7) * 8); }
    int c = c_lo, ti = T0_OF(c_lo);
    int pc = -1, pv_pos = 0;
    bool p_last = false;
    int ops_prev = 4;
    for (;;) {
        const bool qk_on = c < c_hi;
        int ops = 0;
        if (qk_on && ti == T0_OF(c)) {
#pragma unroll
            for (int d0 = 0; d0 < 4; ++d0) qr[d0] = *(const __attribute__((address_space(3))) bf16x8*)(lds3 + A2_Q + wid * 4096 + r32 * 128 + (2 * d0 + hi) * 16);
        }
        f32x16 p0, p1;
        {
            const int pos = qk_on ? POS_OF(c, ti) : pv_pos;
            const int tq = qk_on ? ti : 2;
            const lds_cptr kp = kp0 + (pos % NSL) * SLOTB, vp = vp0 + ((pc >= 0 ? pv_pos : pos) % NSL) * SLOTB;
            bf16x8 kf[8];
#pragma unroll
            for (int d0 = 0; d0 < 4; ++d0) { kf[2 * d0] = *(const __attribute__((address_space(3))) bf16x8*)(kp + d0 * 2048); kf[2 * d0 + 1] = *(const __attribute__((address_space(3))) bf16x8*)(kp + d0 * 2048 + 512); }
            const LAS float* tq_ = tql + 64 * tq;
#pragma unroll
            for (int r = 0; r < 16; ++r) { p0[r] = tq_[(r & 3) + 8 * (r >> 2)]; p1[r] = tq_[32 + (r & 3) + 8 * (r >> 2)]; }
            __builtin_amdgcn_s_setprio(1);
#pragma unroll
            for (int d0 = 0; d0 < 4; ++d0) { p0 = __builtin_amdgcn_mfma_f32_32x32x16_bf16(kf[2 * d0], qr[d0], p0, 0, 0, 0); p1 = __builtin_amdgcn_mfma_f32_32x32x16_bf16(kf[2 * d0 + 1], qr[d0], p1, 0, 0, 0); }
            bf16x8 vf[8];
#pragma unroll
            for (int i = 0; i < 8; ++i) { const s16x4 lo = vtr(vp + (i >> 2) * 4096 + (i & 3) * 1024), hh = vtr(vp + (i >> 2) * 4096 + (i & 3) * 1024 + 512); vf[i] = (bf16x8){lo[0], lo[1], lo[2], lo[3], hh[0], hh[1], hh[2], hh[3]}; }
#pragma unroll
            for (int ks = 0; ks < 4; ++ks) { o[0] = __builtin_amdgcn_mfma_f32_32x32x16_bf16(__builtin_bit_cast(bf16x8, pw[ks]), vf[ks], o[0], 0, 0, 0); o[1] = __builtin_amdgcn_mfma_f32_32x32x16_bf16(__builtin_bit_cast(bf16x8, pw[ks]), vf[4 + ks], o[1], 0, 0, 0); }
            __builtin_amdgcn_s_setprio(0);
        }
        if (p_last) {
            l_reg += __shfl_xor(l_reg, 32);
            l_reg += sinkp;
            if (hi == 0) wsf[r32] = l_reg;
            LDS_WAIT(); asm volatile("" ::: "memory");
            LAS unsigned short* stg = (LAS unsigned short*)(lds + A2_OST) + wid * 2048;
#pragma unroll
            for (int r = 0; r < 16; ++r) { const int orow = crow(r, hi); const float rl = __builtin_amdgcn_rcpf(wsf[orow]);
#pragma unroll
                for (int d0 = 0; d0 < 2; ++d0) stg[orow * 64 + d0 * 32 + r32] = (unsigned short)(f2bf(o[d0][r] * rl)); }
            LDS_WAIT(); asm volatile("" ::: "memory");
            const size_t qtok = QTOK_OF(pc);
#pragma unroll
            for (int i = 0; i < 4; ++i) { const int row = i * 8 + (lane >> 3), ch = lane & 7;
                const v4u ov = *(const LAS v4u*)(stg + row * 64 + ch * 8);
                const v4u gvv = gpre[i];
                v4u res;
#pragma unroll
                for (int e = 0; e < 4; ++e) { const float a0_ = __uint_as_float(ov[e] << 16) * __uint_as_float(gvv[e] << 16), a1_ = __uint_as_float(ov[e] & 0xffff0000u) * __uint_as_float(gvv[e] & 0xffff0000u); res[e] = cvtpk(a0_, a1_); }
                *(GAS v4u*)(O + (qtok + row) * DM + h * 64 + ch * 8) = res; }
            ops += 4;
            o[0] = f32x16{}; o[1] = f32x16{}; l_reg = 0.f;
            if (qk_on) {
                const size_t qt2 = QTOK_OF(c);
#pragma unroll
                for (int i = 0; i < 4; ++i) gpre[i] = *(const GAS v4u*)(Gt + (qt2 + i * 8 + (lane >> 3)) * DM + h * 64 + (lane & 7) * 8);
                ops += 4; }
        }
        if (!qk_on) break;
        if (c3 < c_hi) { if (NEW_OF(c3, t3)) { TILE_DMA_A(c3, t3); ops += 2; } STEP_NEXT(c3, t3); }
        if (ti == T0_OF(c) && c + 1 < c_hi) { asm volatile("s_waitcnt lgkmcnt(0)" ::: "memory"); Q_DMA_A(c + 1); ops += 4; }
        {
            float sacc = 0.f;
#pragma unroll
            for (int r = 0; r < 16; ++r) { p0[r] = __builtin_amdgcn_exp2f(p0[r]); p1[r] = __builtin_amdgcn_exp2f(p1[r]); sacc += p0[r] + p1[r]; }
            l_reg += sacc;
#pragma unroll
            for (int s = 0; s < 2; ++s)
#pragma unroll
                for (int i = 0; i < 4; ++i) { pw[s][i] = cvtpk(p0[8 * s + 2 * i], p0[8 * s + 2 * i + 1]); pw[2 + s][i] = cvtpk(p1[8 * s + 2 * i], p1[8 * s + 2 * i + 1]); }
        }
        const bool short_chunk = T0_OF(c) != 0;
        wait_bar_n<0>(short_chunk ? 0 : ops + ops_prev);
        ops_prev = ops;
        pc = c; pv_pos = POS_OF(c, ti); p_last = ti == 2;
        STEP_NEXT(c, ti);
    }
    asm volatile("s_waitcnt vmcnt(0) lgkmcnt(0)\n\ts_barrier" ::: "memory");
#undef T0_OF
#undef POS_OF
#undef NEW_OF
#undef QTOK_OF
#undef TILE_DMA_A
#undef Q_DMA_A
#undef STEP_NEXT
}
}

__global__ void __launch_bounds__(NWAVES * 64, 2) mk_fwd(Args args) {
    extern __shared__ __attribute__((aligned(16))) unsigned char lds[];
    Frame F; F.tacc = 0;
    F.lds = (LAS unsigned char*)lds;
    F.MISC = (volatile LAS unsigned*)(F.lds + MISC_OFF);
    F.tid = threadIdx.x; F.lane = F.tid & 63; F.wave = __builtin_amdgcn_readfirstlane(F.tid >> 6);
    F.G = gridDim.x; { const int bx = blockIdx.x; F.vcu = (F.G % 8 == 0) ? (bx % 8) * (F.G / 8) + bx / 8 : bx; }
    unsigned char* ws = args.ws;
    F.ctl = (gu32*)(ws + WS_CTL);
    for (int u = F.tid; u < (LDS_BYTES - LDSCTL_OFF) / 4; u += NWAVES * 64) ((LAS unsigned*)(F.lds + LDSCTL_OFF))[u] = 0u;
    __syncthreads();
    XcdBarrier bar = xcd_barrier_post((unsigned*)(F.ctl + CW_BAR), F.MISC + 8);
    bf16* XN = (bf16*)(ws + WS_XN);
    float* slab = (float*)(ws + WS_SLAB);
    float* out = args.out;

#ifndef DUP_PHASE
#define DUP_PHASE -1
#endif
#define REPS_ON(k) int nrep_##k = 2; asm volatile("" : "+s"(nrep_##k)); for (int rep_ = 0; rep_ < nrep_##k; ++rep_)
#define REPS_OFF(k)
#define REPS_SEL(k) REPS_SEL2(k, DUP_PHASE)
#define REPS(k) REPS_##k
#if DUP_PHASE == 0
#define REPS_0 REPS_ON(0)
#else
#define REPS_0
#endif
#if DUP_PHASE == 1
#define REPS_1 REPS_ON(1)
#else
#define REPS_1
#endif
#if DUP_PHASE == 2
#define REPS_2 REPS_ON(2)
#else
#define REPS_2
#endif
#if DUP_PHASE == 3
#define REPS_3 REPS_ON(3)
#else
#define REPS_3
#endif
#if DUP_PHASE == 4
#define REPS_4 REPS_ON(4)
#else
#define REPS_4
#endif
#if DUP_PHASE == 5
#define REPS_5 REPS_ON(5)
#else
#define REPS_5
#endif
#if DUP_PHASE == 6
#define REPS_6 REPS_ON(6)
#else
#define REPS_6
#endif
    KSEG_BEGIN(10) REPS(0) { p0_prologue(F, args);
    xcd_barrier(bar); } KSEG_END(10)
    KSEG_BEGIN(11) REPS(1) {
        pg8::Gemm g{XN, (const bf16*)(ws + WS_WINA), M, NIN_A, DM}; pg8::StaticOrder S; S.init(M, NIN_A, F.G, (int)blockIdx.x);
        pg8::EpiIn E{0, (bf16*)(ws + WS_QA), (bf16*)(ws + WS_KA), (bf16*)(ws + WS_VA), (bf16*)(ws + WS_GA), 128, args.in[9], args.in[10], nullptr,
                     out + O_KAP, out + O_VAP, out + O_KAS, out + O_VAS, 128, 2, C2, nullptr};
        pg8::gemm_phase<pg8::EpiIn, pg8::StaticOrder, true, true>(F.lds + RING_OFF, g, S, E, PROBE_SEG == 31 ? &F.tacc : nullptr);
        { const int busy = (M / 256) * (NIN_A / 256) - 2 * F.G;
          if ((int)blockIdx.x >= busy && F.wave < 4) { side_weights(F, args, ((int)blockIdx.x - busy) * 4 + F.wave, (F.G - busy) * 4);
              side_cache_b_conv(F, args, ((int)blockIdx.x - busy) * 4 + F.wave, (F.G - busy) * 4, 0, NB * 256); } }
    xcd_barrier(bar); } KSEG_END(11)
    KSEG_BEGIN(12) REPS(2) { attn::attn_phase_a(F, args);
    xcd_barrier(bar); } KSEG_END(12)
    KSEG_BEGIN(13) REPS(3) {
        pg8::Gemm g{XN, (const bf16*)(ws + WS_WOUTA), SEQ, DM, DM}; pg8::StaticOrder S; S.init(SEQ, DM, F.G, (int)blockIdx.x);
        pg8::EpiOut E{0, args.in[0], args.in[1], (bf16*)(ws + WS_QA), nullptr, slab};
        KSEG_BEGIN(20) pg8::gemm_phase<pg8::EpiOut, pg8::StaticOrder, true, true>(F.lds + RING_OFF, g, S, E); KSEG_END(20)
        KSEG_BEGIN(21)
        tail_outproj<0>(F.lds + RING_OFF, XN, (const bf16*)(ws + WS_WOUTA), (int)blockIdx.x, args.in[1], (bf16*)(ws + WS_QA), slab, nullptr);
        KSEG_END(21)
    xcd_barrier(bar); } KSEG_END(13)
    KSEG_BEGIN(14) REPS(4) {
        pg8::Gemm g{(const bf16*)(ws + WS_QA), (const bf16*)(ws + WS_WINB), M, NIN_B, DM}; pg8::StaticOrder S; S.init(M, NIN_B, F.G, (int)blockIdx.x);
        pg8::EpiIn E{1, (bf16*)(ws + WS_QB), (bf16*)(ws + WS_KB), (bf16*)(ws + WS_VB), (bf16*)(ws + WS_GB), 1024, args.in[15], args.in[16], slab,
                     out + O_KBP, out + O_VBP, out + O_KBS, out + O_VBS, 512, 16, C2, (LAS float*)(F.lds + RING_BYTES + 1024)};
        pg8::gemm_phase<pg8::EpiIn, pg8::StaticOrder, true, true>(F.lds + RING_OFF, g, S, E, PROBE_SEG == 30 ? &F.tacc : nullptr);
        { const int busy = (M / 256) * (NIN_B / 256) - 4 * F.G;
          if ((int)blockIdx.x >= busy && F.wave < 2) side_cache_b_conv(F, args, ((int)blockIdx.x - busy) * 2 + F.wave, (F.G - busy) * 2, NB * 256, NB * 512); }
    xcd_barrier(bar); } KSEG_END(14)
    KSEG_BEGIN(15) REPS(5) { attn::attn_phase<1>(F, args);
    xcd_barrier(bar); } KSEG_END(15)
    KSEG_BEGIN(16) REPS(6) {
        pg8::Gemm g{XN, (const bf16*)(ws + WS_WOUTB), SEQ, DM, DM}; pg8::StaticOrder S; S.init(SEQ, DM, F.G, (int)blockIdx.x);
        pg8::EpiOut E{1, nullptr, nullptr, (bf16*)(ws + WS_QA), out + O_Y, nullptr};
        pg8::gemm_phase<pg8::EpiOut, pg8::StaticOrder, true, true>(F.lds + RING_OFF, g, S, E);
        tail_outproj<1>(F.lds + RING_OFF, XN, (const bf16*)(ws + WS_WOUTB), (int)blockIdx.x, nullptr, (bf16*)(ws + WS_QA), nullptr, out + O_Y);
    }
    KSEG_END(16)
#if PROBE_SEG
    if (blockIdx.x == 0) {
        const unsigned long long t0 = __builtin_amdgcn_s_memrealtime(), dt = 8ull * (unsigned long long)__builtin_amdgcn_readfirstlane((unsigned)F.tacc);
        while (__builtin_amdgcn_s_memrealtime() - t0 < dt) __builtin_amdgcn_s_sleep(32);
    }
#endif
}
extern "C" void kernel_launch(void* const* d_in, const int* in_sizes, int n_in, void* d_out, int out_size, void* d_ws, size_t ws_size, hipStream_t stream) {
    static int grid = 0;
    if (grid == 0) {
        if (n_in != 19 || out_size != (int)O_END || ws_size < WS_END) { fprintf(stderr, "kernel_launch: unexpected shapes (n_in %d, out %d, ws %zu)\n", n_in, out_size, ws_size); grid = -1; return; }
        int dev = 0, cus = 0, per_cu = 0;
        if (hipGetDevice(&dev) != hipSuccess || hipDeviceGetAttribute(&cus, hipDeviceAttributeMultiprocessorCount, dev) != hipSuccess) { grid = -1; return; }
        if (hipFuncSetAttribute((const void*)mk_fwd, hipFuncAttributeMaxDynamicSharedMemorySize, LDS_BYTES) != hipSuccess) { fprintf(stderr, "kernel_launch: hipFuncSetAttribute failed\n"); grid = -1; return; }
        if (hipOccupancyMaxActiveBlocksPerMultiprocessor(&per_cu, (const void*)mk_fwd, NWAVES * 64, LDS_BYTES) != hipSuccess || per_cu < 1) { fprintf(stderr, "kernel_launch: occupancy query says %d blocks per CU\n", per_cu); }
        (void)hipGetLastError();
        grid = cus;
        if (grid != 256) { fprintf(stderr, "kernel_launch: built for 256 CUs, found %d\n", cus); grid = -1; return; }
    }
    if (grid < 0) return;
    (void)hipMemsetAsync((char*)d_ws + WS_CTL, 0, CTL_ZERO_BYTES, stream);
    Args a{};
    for (int i = 0; i < 19; ++i) a.in[i] = (const float*)d_in[i];
    a.out = (float*)d_out; a.ws = (unsigned char*)d_ws;
    hipLaunchKernelGGL(mk_fwd, dim3(grid), dim3(NWAVES * 64), LDS_BYTES, stream, a);
}
```

```cpp
#include <hip/hip_runtime.h>
#include <cstdio>
#include <cstdint>
#include <cmath>
namespace pg8 {
#define PG8_LAS __attribute__((address_space(3)))
typedef unsigned short bf16_t;
typedef short bf16x8 __attribute__((ext_vector_type(8)));
typedef float f32x4 __attribute__((ext_vector_type(4)));
typedef unsigned u32x4 __attribute__((ext_vector_type(4)));
constexpr int BM = 256, BK = 64, HALF = 128, HTB = HALF * BK * 2  , STAGE_BYTES = 8 * HTB, NXCD = 8, WGM = 8;

__host__ __device__ __forceinline__ int lds_byte(int r, int c) { const int st = (r >> 4) * 2 + (c >> 5), rr = r & 15, cc = c & 31, ob = rr * 64 + cc * 2; return st * 1024 + (ob ^ (((ob >> 9) & 1) << 5)); }
__host__ __device__ __forceinline__ void stage_rc(int b, int& R, int& C) { const int st = b / 1024, sb = b % 1024, swz = sb ^ (((sb >> 9) & 1) << 5); R = (st >> 1) * 16 + swz / 64; C = (st & 1) * 32 + (swz % 64) / 2; }
__host__ __device__ __forceinline__ int perm32(int rho) { const int n = rho >> 4, i = rho & 15; return 8 * (i >> 2) + 4 * n + (i & 3); }

struct Unit { int pm, pn; };
struct Gemm { const bf16_t* A; const bf16_t* Bt; int M, N, K; };

struct StaticOrder {
    int nM, nN, nwg, G, c;
    __host__ __device__ void init(int M, int N, int G_, int c_) { nM = M / BM; nN = N / BM; nwg = nM * nN; G = G_; c = c_; }
    __host__ __device__ bool next(int i, Unit& u) const {
        const long L = (long)i * G + c; if (L >= nwg) return false;
        int wgid = (int)L; { const int q = nwg / NXCD, r = nwg % NXCD, xcd = wgid % NXCD, off = wgid / NXCD; wgid = (xcd < r ? xcd * (q + 1) : r * (q + 1) + (xcd - r) * q) + off; }
        const int nig = WGM * nN, gid = wgid / nig, fm = gid * WGM, gsz = (nM - fm) < WGM ? (nM - fm) : WGM;
        u.pm = fm + ((wgid % nig) % gsz); u.pn = (wgid % nig) / gsz; return true;
    }
    __device__ __forceinline__ void a_ready(const Unit&) const {}
    __device__ __forceinline__ void done(const Unit&) const {}
};
__device__ __forceinline__ unsigned cvt_pk_bf16(float lo, float hi) { unsigned r; asm volatile("v_cvt_pk_bf16_f32 %0, %1, %2" : "=v"(r) : "v"(lo), "v"(hi)); return r; }
__device__ __forceinline__ void st16_wt(void* p, u32x4 v) { asm volatile("global_store_dwordx4 %0, %1, off sc1\n\ts_nop 1" :: "v"(p), "v"(v) : "memory"); }
constexpr int SEQ_ = 16384;
constexpr float NORM_EPS = 1e-6f;
struct EpiIn {
    static constexpr bool PERM = true, AFTER_DRAIN = false;
    int layer;
    bf16_t *Q, *Kb, *Vb, *G; int kvw;
    const float *qg, *kg;
    const float* slab;
    float *okp, *ovp, *oks, *ovs; int keep, nkv;
    float c2;
    PG8_LAS float* rstd_lds;
    template <int TYPE>
    __device__ __forceinline__ void tile(const f32x4 (&acc)[2][2][4][2], int row0, int rl0, int dcol, int fq, bf16_t* dst, int ld, const float* gp, float sc, float* o_p, float* o_s, int head) const {
        f32x4 gv[2][2];
        if (TYPE < 2) {
#pragma unroll
            for (int bj = 0; bj < 2; ++bj)
#pragma unroll
                for (int n = 0; n < 2; ++n) gv[bj][n] = *(const f32x4*)(gp + 32 * bj + dcol + 4 * n) * sc; }
#pragma unroll
        for (int ai = 0; ai < 2; ++ai)
#pragma unroll
            for (int m = 0; m < 4; ++m) {
                const int row = row0 + ai * HALF + m * 16;
                const float rs = slab ? rstd_lds[ai * HALF + rl0 + m * 16] : 1.f;
                f32x4 v[2][2];
#pragma unroll
                for (int bj = 0; bj < 2; ++bj)
#pragma unroll
                    for (int n = 0; n < 2; ++n) v[bj][n] = acc[ai][bj][m][n] * rs;
                if (TYPE < 2) {
                    float ss = 0.f;
#pragma unroll
                    for (int bj = 0; bj < 2; ++bj)
#pragma unroll
                        for (int n = 0; n < 2; ++n) { const f32x4 x = v[bj][n]; ss += (x[0] * x[0] + x[1] * x[1]) + (x[2] * x[2] + x[3] * x[3]); }
                    ss += __shfl_xor(ss, 16); ss += __shfl_xor(ss, 32);
                    const float r = rsqrtf(ss * (1.f / 64.f) + NORM_EPS);
#pragma unroll
                    for (int bj = 0; bj < 2; ++bj)
#pragma unroll
                        for (int n = 0; n < 2; ++n) v[bj][n] = v[bj][n] * r * gv[bj][n];
                } else if (TYPE == 3) {
#pragma unroll
                    for (int bj = 0; bj < 2; ++bj)
#pragma unroll
                        for (int n = 0; n < 2; ++n)
#pragma unroll
                            for (int e = 0; e < 4; ++e) { const float x = v[bj][n][e]; v[bj][n][e] = x * __builtin_amdgcn_rcpf(1.f + __builtin_amdgcn_exp2f(-1.4426950408889634f * x)); }
                }
                if ((TYPE == 1 || TYPE == 2) && row >= SEQ_ - keep) {
                    float* op;
                    if (row < SEQ_) op = o_p + ((size_t)(row - (SEQ_ - keep)) * nkv + head) * 64 + dcol;
                    else { const int r_ = row - SEQ_; op = o_s + (((size_t)(r_ >> 6) * keep + (keep - 64) + (r_ & 63)) * nkv + head) * 64 + dcol; }
#pragma unroll
                    for (int bj = 0; bj < 2; ++bj) { *(f32x4*)(op + 32 * bj) = v[bj][0]; *(f32x4*)(op + 32 * bj + 4) = v[bj][1]; }
                }
#pragma unroll
                for (int bj = 0; bj < 2; ++bj) { u32x4 w; w.x = cvt_pk_bf16(v[bj][0][0], v[bj][0][1]); w.y = cvt_pk_bf16(v[bj][0][2], v[bj][0][3]); w.z = cvt_pk_bf16(v[bj][1][0], v[bj][1][1]); w.w = cvt_pk_bf16(v[bj][1][2], v[bj][1][3]);
                    st16_wt(dst + (size_t)row * ld + 32 * bj, w); }
            }
    }
    __device__ __forceinline__ void operator()(const f32x4 (&acc)[2][2][4][2], const Unit& u, int wr, int wc, int fr, int fq) const {
        int type, head;
        if (layer == 0) { if (u.pn < 4) { type = 0; head = 4 * u.pn + wc; } else if (u.pn == 4) { type = wc < 2 ? 1 : 2; head = wc & 1; } else { type = 3; head = 4 * (u.pn - 5) + wc; } }
        else { type = u.pn >> 2; head = 4 * (u.pn & 3) + wc; }
        const int row0 = u.pm * BM + wr * 64 + fr, rl0 = wr * 64 + fr, dcol = 8 * fq, co = head * 64 + dcol;
        if (slab) {
            const int t = threadIdx.x;
            if (t < BM) { const f32x4* sp = (const f32x4*)(slab + (size_t)(u.pm * BM + t) * 16); const f32x4 a = sp[0], b = sp[1], c = sp[2], d = sp[3];
                const f32x4 s = (a + b) + (c + d); rstd_lds[t] = rsqrtf(((s[0] + s[1]) + (s[2] + s[3])) * (1.f / 1024.f) + NORM_EPS); }
            asm volatile("s_waitcnt lgkmcnt(0)\n\ts_barrier" ::: "memory");
        }
        if (type == 0) tile<0>(acc, row0, rl0, dcol, fq, Q + co, 1024, qg, c2, nullptr, nullptr, head);
        else if (type == 1) tile<1>(acc, row0, rl0, dcol, fq, Kb + co, kvw, kg, 1.f, okp, oks, head);
        else if (type == 2) tile<2>(acc, row0, rl0, dcol, fq, Vb + co, kvw, nullptr, 1.f, ovp, ovs, head);
        else tile<3>(acc, row0, rl0, dcol, fq, G + co, 1024, nullptr, 1.f, nullptr, nullptr, head);
    }
};
struct EpiOut {
    static constexpr bool PERM = true, AFTER_DRAIN = false;
    int layer;
    const float *base_p, *base_s;
    bf16_t* yb;
    float* out;
    float* slab;
    __device__ __forceinline__ void operator()(const f32x4 (&acc)[2][2][4][2], const Unit& u, int wr, int wc, int fr, int fq) const {
        const int row0 = u.pm * BM + wr * 64 + fr, col0 = u.pn * BM + wc * 32 + 8 * fq;
        if (layer == 0) {
#pragma unroll
            for (int ai = 0; ai < 2; ++ai) {
                f32x4 b[4][2][2];
#pragma unroll
                for (int m = 0; m < 4; ++m) { const int row = row0 + ai * HALF + m * 16;
                    const float* bp = (row < SEQ_ ? base_p + (size_t)row * 1024 : base_s + (size_t)(row - SEQ_) * 1024) + col0;
#pragma unroll
                    for (int bj = 0; bj < 2; ++bj) { b[m][bj][0] = __builtin_nontemporal_load((const f32x4*)(bp + bj * HALF)); b[m][bj][1] = __builtin_nontemporal_load((const f32x4*)(bp + bj * HALF + 4)); } }
#pragma unroll
                for (int m = 0; m < 4; ++m) { const int row = row0 + ai * HALF + m * 16; float ss = 0.f;
#pragma unroll
                    for (int bj = 0; bj < 2; ++bj) { const f32x4 y0 = acc[ai][bj][m][0] + b[m][bj][0], y1 = acc[ai][bj][m][1] + b[m][bj][1];
                        ss += ((y0[0] * y0[0] + y0[1] * y0[1]) + (y0[2] * y0[2] + y0[3] * y0[3])) + ((y1[0] * y1[0] + y1[1] * y1[1]) + (y1[2] * y1[2] + y1[3] * y1[3]));
                        u32x4 w; w.x = cvt_pk_bf16(y0[0], y0[1]); w.y = cvt_pk_bf16(y0[2], y0[3]); w.z = cvt_pk_bf16(y1[0], y1[1]); w.w = cvt_pk_bf16(y1[2], y1[3]);
                        *(u32x4*)(yb + (size_t)row * 1024 + col0 + bj * HALF) = w; }
                    ss += __shfl_xor(ss, 16); ss += __shfl_xor(ss, 32); if (fq == 0) slab[(size_t)row * 16 + 4 * u.pn + wc] = ss; }
            }
        } else {
#pragma unroll
            for (int ai = 0; ai < 2; ++ai) {
                u32x4 b[4][2];
#pragma unroll
                for (int m = 0; m < 4; ++m) { const int row = row0 + ai * HALF + m * 16;
#pragma unroll
                    for (int bj = 0; bj < 2; ++bj) b[m][bj] = *(const u32x4*)(yb + (size_t)row * 1024 + col0 + bj * HALF); }
#pragma unroll
                for (int m = 0; m < 4; ++m) { const int row = row0 + ai * HALF + m * 16; float* op = out + (size_t)row * 1024 + col0;
#pragma unroll
                    for (int bj = 0; bj < 2; ++bj) { const u32x4 w = b[m][bj];
                        const f32x4 r0 = {__uint_as_float(w.x << 16), __uint_as_float(w.x & 0xffff0000u), __uint_as_float(w.y << 16), __uint_as_float(w.y & 0xffff0000u)};
                        const f32x4 r1 = {__uint_as_float(w.z << 16), __uint_as_float(w.z & 0xffff0000u), __uint_as_float(w.w << 16), __uint_as_float(w.w & 0xffff0000u)};
                        *(f32x4*)(op + bj * HALF) = acc[ai][bj][m][0] + r0; *(f32x4*)(op + bj * HALF + 4) = acc[ai][bj][m][1] + r1; } }
            }
        }
    }
};
template <class Epi, class Sched, bool ALIGN_EPI = false, bool SP2 = false>
__device__ __forceinline__ void gemm_phase(PG8_LAS unsigned char* lds, const Gemm g, const Sched& S, const Epi& E, unsigned long long* tepi = nullptr) {
    int tid_ = threadIdx.x; asm volatile("" : "+v"(tid_));
    const int tid = tid_, wid = __builtin_amdgcn_readfirstlane(tid >> 6), lane = tid & 63, wr = wid >> 2, wc = wid & 3, fr = lane & 15, fq = lane >> 4;
    const int K = g.K, nt = K / BK;
    unsigned voffA[2], voffB[2];
#pragma unroll
    for (int i = 0; i < 2; ++i) { int R, C; stage_rc(tid * 16 + i * 8192, R, C); const int Rb = Epi::PERM ? ((R & ~31) + perm32(R & 31)) : R;
        voffA[i] = (unsigned)(R * K + C) * 2u; voffB[i] = (unsigned)(Rb * K + C) * 2u; }
    const size_t kstep = (size_t)(BK * 2);
    const size_t hstep = (size_t)HALF * K * 2;
    const size_t tstep = 2 * hstep;
    const unsigned ldsw = (unsigned)wid * 1024u;
    const int aoff = lds_byte(wr * 64 + fr, fq * 8), boff = lds_byte(wc * 32 + fr, fq * 8);
#define PG8_SA(b, h) (((b) * 2 + (h)) * HTB)
#define PG8_SB(b, h) ((4 + (b) * 2 + (h)) * HTB)
#define PG8_STAGE(bufoff, gbase, voff) do { _Pragma("unroll") for (int _i = 0; _i < 2; ++_i) \
        __builtin_amdgcn_global_load_lds((const unsigned*)((const char*)(gbase) + (voff)[_i]), (PG8_LAS unsigned*)(lds + (bufoff) + ldsw + _i * 8192), 16, 0, 0); } while (0)
#define PG8_LDA(dst, b, h) do { _Pragma("unroll") for (int m = 0; m < 4; ++m) _Pragma("unroll") for (int k = 0; k < 2; ++k) dst[m][k] = *(const PG8_LAS bf16x8*)(lds + PG8_SA(b, h) + aoff + m * 2048 + k * 1024); } while (0)
#define PG8_LDB(dst, b, h) do { _Pragma("unroll") for (int n = 0; n < 2; ++n) _Pragma("unroll") for (int k = 0; k < 2; ++k) dst[n][k] = *(const PG8_LAS bf16x8*)(lds + PG8_SB(b, h) + boff + n * 2048 + k * 1024); } while (0)
#define PG8_MMA(ai, bj, At, Bt) do { __builtin_amdgcn_s_setprio(1); _Pragma("unroll") for (int m = 0; m < 4; ++m) _Pragma("unroll") for (int n = 0; n < 2; ++n) _Pragma("unroll") for (int k = 0; k < 2; ++k) \
        acc[ai][bj][m][n] = __builtin_amdgcn_mfma_f32_16x16x32_bf16(Bt[n][k], At[m][k], acc[ai][bj][m][n], 0, 0, 0); __builtin_amdgcn_s_setprio(0); } while (0)
#define PG8_WAIT_V(n) asm volatile("s_waitcnt vmcnt(" #n ")" ::: "memory")
#define PG8_WAIT_L(n) asm volatile("s_waitcnt lgkmcnt(" #n ")" ::: "memory")
#define PG8_BAR __builtin_amdgcn_s_barrier()
#define PG8_SCHED __builtin_amdgcn_sched_barrier(0)
    Unit cur, nxt; int ui = 0;
    if (!S.next(0, cur)) return;
    f32x4 acc[2][2][4][2];
#pragma unroll
    for (int a = 0; a < 2; ++a)
#pragma unroll
        for (int b = 0; b < 2; ++b)
#pragma unroll
            for (int m = 0; m < 4; ++m)
#pragma unroll
                for (int n = 0; n < 2; ++n) acc[a][b][m][n] = (f32x4){0.f, 0.f, 0.f, 0.f};
    bf16x8 At[4][2], B0[2][2], B1[2][2];
    const char* cA = (const char*)g.A + (size_t)cur.pm * tstep; const char* cB = (const char*)g.Bt + (size_t)cur.pn * tstep;
    S.a_ready(cur);
    if constexpr (SP2) {
        PG8_STAGE(PG8_SB(0, 0), cB, voffB); PG8_STAGE(PG8_SB(0, 1), cB + hstep, voffB); PG8_STAGE(PG8_SA(0, 0), cA, voffA); PG8_STAGE(PG8_SA(0, 1), cA + hstep, voffA);
        if (wr == 1) PG8_BAR;
        PG8_WAIT_V(2); PG8_BAR;
        PG8_STAGE(PG8_SB(1, 0), cB + kstep, voffB); PG8_STAGE(PG8_SA(1, 0), cA + kstep, voffA); PG8_STAGE(PG8_SB(1, 1), cB + hstep + kstep, voffB);
        PG8_WAIT_V(6); PG8_BAR;
    } else {
        PG8_STAGE(PG8_SB(0, 0), cB, voffB); PG8_STAGE(PG8_SA(0, 0), cA, voffA); PG8_STAGE(PG8_SB(0, 1), cB + hstep, voffB); PG8_STAGE(PG8_SA(0, 1), cA + hstep, voffA);
        if (wr == 1) PG8_BAR;
        PG8_WAIT_V(4); PG8_BAR;
        PG8_STAGE(PG8_SB(1, 0), cB + kstep, voffB); PG8_STAGE(PG8_SA(1, 0), cA + kstep, voffA); PG8_STAGE(PG8_SB(1, 1), cB + hstep + kstep, voffB);
        PG8_WAIT_V(6); PG8_BAR;
    }
    for (;;) {
        const bool has_next = S.next(ui + 1, nxt);
        const char* nA = has_next ? (const char*)g.A + (size_t)nxt.pm * tstep : cA; const char* nB = has_next ? (const char*)g.Bt + (size_t)nxt.pn * tstep : cB;
        for (int t = 0; t < nt; t += 2) {
            const bool last = (t == nt - 2);
            const char* a1 = cA + (size_t)(t + 1) * kstep;
            const char* a2 = last ? nA : cA + (size_t)(t + 2) * kstep; const char* b2 = last ? nB : cB + (size_t)(t + 2) * kstep;
            const char* a3 = a2 + kstep; const char* b3 = b2 + kstep;
            if (last && has_next) S.a_ready(nxt);
            if constexpr (SP2) {
            PG8_LDB(B0, 0, 0); PG8_LDB(B1, 0, 1); PG8_SCHED; PG8_LDA(At, 0, 0); PG8_STAGE(PG8_SA(1, 1), a1 + hstep, voffA);
            PG8_WAIT_V(8); PG8_WAIT_L(0); PG8_BAR; PG8_MMA(0, 0, At, B0); PG8_MMA(0, 1, At, B1); PG8_BAR; PG8_SCHED;
            PG8_LDA(At, 0, 1); PG8_STAGE(PG8_SB(0, 0), b2, voffB); PG8_STAGE(PG8_SB(0, 1), b2 + hstep, voffB); PG8_STAGE(PG8_SA(0, 0), a2, voffA);
            PG8_WAIT_V(8); PG8_WAIT_L(0); PG8_BAR; PG8_MMA(1, 0, At, B0); PG8_MMA(1, 1, At, B1); PG8_BAR; PG8_SCHED;
            PG8_LDB(B0, 1, 0); PG8_LDB(B1, 1, 1); PG8_SCHED; PG8_LDA(At, 1, 0); PG8_STAGE(PG8_SA(0, 1), a2 + hstep, voffA);
            PG8_WAIT_V(8); PG8_WAIT_L(0); PG8_BAR; PG8_MMA(0, 0, At, B0); PG8_MMA(0, 1, At, B1); PG8_BAR; PG8_SCHED;
            PG8_LDA(At, 1, 1); PG8_STAGE(PG8_SB(1, 0), b3, voffB); PG8_STAGE(PG8_SB(1, 1), b3 + hstep, voffB); PG8_STAGE(PG8_SA(1, 0), a3, voffA);
            PG8_WAIT_V(8); PG8_WAIT_L(0); PG8_BAR; PG8_MMA(1, 0, At, B0); PG8_MMA(1, 1, At, B1); PG8_BAR; PG8_SCHED;
            } else {
            PG8_LDB(B0, 0, 0); PG8_SCHED; PG8_LDA(At, 0, 0); PG8_STAGE(PG8_SA(1, 1), a1 + hstep, voffA);
            PG8_WAIT_L(8); PG8_BAR; PG8_WAIT_L(0); PG8_MMA(0, 0, At, B0); PG8_BAR; PG8_SCHED;
            PG8_LDB(B1, 0, 1); PG8_STAGE(PG8_SB(0, 0), b2, voffB);
            PG8_BAR; PG8_WAIT_L(0); PG8_MMA(0, 1, At, B1); PG8_BAR;
            PG8_LDA(At, 0, 1); PG8_STAGE(PG8_SA(0, 0), a2, voffA);
            PG8_BAR; PG8_WAIT_L(0); PG8_MMA(1, 0, At, B0); PG8_BAR; PG8_SCHED;
            PG8_STAGE(PG8_SB(0, 1), b2 + hstep, voffB);
            PG8_WAIT_V(6); PG8_BAR; PG8_MMA(1, 1, At, B1); PG8_BAR;
            PG8_LDB(B0, 1, 0); PG8_SCHED; PG8_LDA(At, 1, 0); PG8_STAGE(PG8_SA(0, 1), a2 + hstep, voffA);
            PG8_WAIT_L(8); PG8_BAR; PG8_WAIT_L(0); PG8_MMA(0, 0, At, B0); PG8_BAR; PG8_SCHED;
            PG8_LDB(B1, 1, 1); PG8_STAGE(PG8_SB(1, 0), b3, voffB);
            PG8_BAR; PG8_WAIT_L(0); PG8_MMA(0, 1, At, B1); PG8_BAR;
            PG8_LDA(At, 1, 1); PG8_STAGE(PG8_SA(1, 0), a3, voffA);
            PG8_BAR; PG8_WAIT_L(0); PG8_MMA(1, 0, At, B0); PG8_BAR; PG8_SCHED;
            PG8_STAGE(PG8_SB(1, 1), b3 + hstep, voffB);
            PG8_WAIT_V(6); PG8_BAR; PG8_MMA(1, 1, At, B1); PG8_BAR;
            }
        }
        if constexpr (ALIGN_EPI) { if (wr == 0) PG8_BAR; }
        if constexpr (!Epi::AFTER_DRAIN) { unsigned long long te0_ = 0; if (tepi) te0_ = __builtin_amdgcn_s_memrealtime(); E(acc, cur, wr, wc, fr, fq); S.done(cur); if (tepi) *tepi += __builtin_amdgcn_s_memrealtime() - te0_; }
        if (!has_next) break;
#pragma unroll
        for (int a = 0; a < 2; ++a)
#pragma unroll
            for (int b = 0; b < 2; ++b)
#pragma unroll
                for (int m = 0; m < 4; ++m)
#pragma unroll
                    for (int n = 0; n < 2; ++n) acc[a][b][m][n] = (f32x4){0.f, 0.f, 0.f, 0.f};
        cur = nxt; cA = nA; cB = nB; ++ui;
        if constexpr (ALIGN_EPI) { if (wr == 1) PG8_BAR; }
    }
    PG8_WAIT_V(0);
    if constexpr (!ALIGN_EPI) { if (wr == 0) PG8_BAR; }
    PG8_BAR;
    if constexpr (Epi::AFTER_DRAIN) { E.fused(acc, cur, wr, wc, fr, fq, lds, wid, lane); S.done(cur); }
#undef PG8_SA
#undef PG8_SB
#undef PG8_STAGE
#undef PG8_LDA
#undef PG8_LDB
#undef PG8_MMA
#undef PG8_WAIT_V
#undef PG8_WAIT_L
#undef PG8_BAR
#undef PG8_SCHED
}
}
#define GAS __attribute__((address_space(1)))
#define LAS __attribute__((address_space(3)))
typedef unsigned short bf16;
typedef unsigned v4u __attribute__((ext_vector_type(4)));
typedef float f32x4 __attribute__((ext_vector_type(4)));
typedef short bf16x8 __attribute__((ext_vector_type(8)));
typedef GAS unsigned gu32;
typedef GAS unsigned long long gu64;
#define RLX_AGENT __ATOMIC_RELAXED, __HIP_MEMORY_SCOPE_AGENT
#define LDS_WAIT() asm volatile("s_waitcnt lgkmcnt(0)" ::: "memory")
#define VM_WAIT() asm volatile("s_waitcnt vmcnt(0)" ::: "memory")
__device__ __forceinline__ unsigned long long rt() { return __builtin_amdgcn_s_memrealtime(); }
__device__ __forceinline__ unsigned f2bf(float f) { unsigned u = __builtin_bit_cast(unsigned, f); return (u + 0x7fffu + ((u >> 16) & 1u)) >> 16; }
__device__ __forceinline__ unsigned pk2(float lo, float hi) { return f2bf(lo) | (f2bf(hi) << 16); }

#define XB_TMO      128
#define XB_XCNT(j)  (256  + 64 * (j))
#define XB_XSUB(j)  (1280 + 64 * (j))
#define XB_XGEN(j)  (2304 + 64 * (j))
#define XB_TOP      3328
#define XB_TOPGEN   3392
#define XCD_BAR_WORDS 3456
#define XB_SPIN_CAP (1u << 18)

__device__ __forceinline__ unsigned xb_ld(unsigned* p)              { return __hip_atomic_load(p, __ATOMIC_RELAXED, __HIP_MEMORY_SCOPE_AGENT); }
__device__ __forceinline__ unsigned xb_add(unsigned* p, unsigned v) { return __hip_atomic_fetch_add(p, v, __ATOMIC_RELAXED, __HIP_MEMORY_SCOPE_AGENT); }
__device__ __forceinline__ unsigned xb_xcc_id() { return (unsigned)__builtin_amdgcn_s_getreg((3 << 11) | 20) & 0xFu; }
#define XB_SPIN(cond, bar) do { unsigned _sp = 0; while (cond) { __builtin_amdgcn_s_sleep(1); \
    if ((++_sp & 255u) == 0u) { if (xb_ld(&(bar)[XB_TMO])) break; if (_sp > XB_SPIN_CAP) { atomicAdd(&(bar)[XB_TMO], 1u); break; } } } } while (0)

struct XcdBarrier {
    unsigned* bar; unsigned x;
    volatile LAS unsigned* st;
};

__device__ __forceinline__ XcdBarrier xcd_barrier_post(unsigned* bar, volatile LAS unsigned* st) {
    XcdBarrier b; b.bar = bar; b.x = xb_xcc_id(); b.st = st;
    if (threadIdx.x == 0) (void)xb_add(&bar[XB_XCNT(b.x)], 1u);
    return b;
}
__device__ __forceinline__ void xcd_barrier_complete(unsigned* bar, unsigned x, unsigned& nloc, unsigned& nx) {
    const unsigned G = gridDim.x * gridDim.y * gridDim.z;
    unsigned sum, cnt, mine, sp = 0u;
    for (;;) {
        sum = 0u; cnt = 0u; mine = 0u;
#pragma unroll
        for (unsigned j = 0; j < 16; ++j) { const unsigned c = xb_ld(&bar[XB_XCNT(j)]); sum += c; cnt += (c > 0u) ? 1u : 0u; mine = (j == x) ? c : mine; }
        if (sum == G) break;
        __builtin_amdgcn_s_sleep(1);
        if ((++sp & 255u) == 0u) { if (xb_ld(&bar[XB_TMO])) break; if (sp > XB_SPIN_CAP) { atomicAdd(&bar[XB_TMO], 1u); break; } }
    }
    nloc = mine > 0u ? mine : 1u; nx = cnt > 0u ? cnt : 1u;
}

__device__ __forceinline__ void xcd_barrier(const XcdBarrier& b) {
    asm volatile("s_waitcnt vmcnt(0)" ::: "memory");
    __syncthreads();
    if (threadIdx.x == 0) {
        unsigned* bar = b.bar;
        __builtin_amdgcn_s_waitcnt(0);
        unsigned nloc = b.st[0], nx = b.st[1];
        if (nloc == 0u) { xcd_barrier_complete(bar, b.x, nloc, nx); b.st[0] = nloc; b.st[1] = nx; }
        const unsigned old = xb_add(&bar[XB_XSUB(b.x)], 1u);
        const unsigned gen = old / nloc;
        if (old + 1u == (gen + 1u) * nloc) {
            __builtin_amdgcn_fence(__ATOMIC_RELEASE, "agent");
            asm volatile("s_waitcnt vmcnt(0)" ::: "memory");
            const unsigned og = xb_add(&bar[XB_TOP], 1u);
            const unsigned tg = og / nx;
            if (og + 1u == (tg + 1u) * nx) xb_add(&bar[XB_TOPGEN], 1u);
            else XB_SPIN(xb_ld(&bar[XB_TOPGEN]) == tg, bar);
            __builtin_amdgcn_fence(__ATOMIC_ACQUIRE, "agent");
            xb_add(&bar[XB_XGEN(b.x)], 1u);
            asm volatile("s_waitcnt vmcnt(0)" ::: "memory");
        } else {
            XB_SPIN(xb_ld(&bar[XB_XGEN(b.x)]) == gen, bar);
            __builtin_amdgcn_fence(__ATOMIC_ACQUIRE, "agent");
            asm volatile("s_waitcnt vmcnt(0)" ::: "memory");
        }
    }
    __syncthreads();
}
constexpr int NWAVES = 8;
constexpr int DM = 1024, SEQ = 16384, NB = 16, MS = NB * 64, M = SEQ + MS;
constexpr int NIN_A = 2304, NIN_B = 4096;
constexpr float EPS = 1e-6f, LOG2E = 1.4426950408889634f, C2 = 0.125f * 1.4426950408889634f;
constexpr size_t O_Y = 0, O_KAP = 17825792, O_VAP = 17842176, O_KBP = 17858560, O_VBP = 18382848, O_KAS = 18907136, O_VAS = 19169280, O_KBS = 19431424, O_VBS = 27820032, O_END = 36208640;
constexpr size_t KiB = 1024, MiB = 1u << 20;
constexpr size_t WS_CTL = 0, CTL_ZERO_BYTES = 256 * KiB;
constexpr size_t WS_WINA = 256 * KiB;
constexpr size_t WS_WOUTA = WS_WINA + (size_t)NIN_A * DM * 2;
constexpr size_t WS_WINB = WS_WOUTA + (size_t)DM * DM * 2;
constexpr size_t WS_WOUTB = WS_WINB + (size_t)NIN_B * DM * 2;
constexpr size_t WS_SLAB = WS_WOUTB + (size_t)DM * DM * 2;
constexpr size_t ACT = (size_t)M * DM * 2;
constexpr size_t WS_XN = 18 * MiB;
constexpr size_t WS_QA = WS_XN + ACT;
constexpr size_t WS_GA = WS_QA + ACT, WS_KA = WS_GA + ACT, WS_VA = WS_KA + (size_t)M * 128 * 2;
constexpr size_t WS_QB = WS_GA;
constexpr size_t WS_KB = WS_QB + ACT, WS_VB = WS_KB + ACT, WS_GB = WS_VB + ACT;
constexpr size_t WS_CKA = WS_GB + ACT, WS_CVA = WS_CKA + (size_t)NB * 128 * 128 * 2, WS_CKB = WS_CVA + (size_t)NB * 128 * 128 * 2, WS_CVB = WS_CKB + (size_t)NB * 512 * 1024 * 2;
constexpr size_t WS_END = WS_CVB + (size_t)NB * 512 * 1024 * 2;
static_assert(WS_SLAB + (size_t)M * 16 * 4 <= WS_XN && WS_VA + (size_t)M * 128 * 2 <= WS_CKA && WS_QB >= WS_QA + ACT && WS_END <= 256 * MiB, "d_ws map");
constexpr int CW_KMAX_A = 64, CW_KMAX_B = 128;
constexpr int CW_BAR = 4096;
constexpr int RING_OFF = 0, RING_BYTES = 131072;
constexpr int PHASE_BYTES = 159744;
constexpr int LDSCTL_OFF = PHASE_BYTES, MISC_OFF = LDSCTL_OFF + 320;
constexpr int LDS_BYTES = 163840;
constexpr int AT_NS = 4;
constexpr int AT_SLOT = 0, AT_SLOTB = 16384  , AT_TAB = AT_NS * AT_SLOTB, AT_TABB = 49152, AT_WSF = AT_TAB + AT_TABB, AT_OST = AT_WSF + NWAVES * 256, AT_END = AT_OST + NWAVES * 4096;
static_assert(AT_END <= PHASE_BYTES && MISC_OFF + 128 <= LDS_BYTES, "attention LDS map");

#ifndef PROBE_SEG
#define PROBE_SEG 0
#endif
#ifndef PROBE_LAYER
#define PROBE_LAYER 1
#endif
#if PROBE_SEG
#define KSEG_BEGIN(s) unsigned long long ks_t0_##s = 0; if (PROBE_SEG == (s)) ks_t0_##s = __builtin_amdgcn_s_memrealtime();
#define KSEG_END(s) if (PROBE_SEG == (s)) F.tacc += __builtin_amdgcn_s_memrealtime() - ks_t0_##s;
#define PSEG_BEGIN(s) unsigned long long ps_t0_##s = 0; if (PROBE_SEG == (s) && LAYER == PROBE_LAYER) ps_t0_##s = __builtin_amdgcn_s_memrealtime();
#define PSEG_END(s) if (PROBE_SEG == (s) && LAYER == PROBE_LAYER) F.tacc += __builtin_amdgcn_s_memrealtime() - ps_t0_##s;
#else
#define PSEG_BEGIN(s)
#define PSEG_END(s)
#define KSEG_BEGIN(s)
#define KSEG_END(s)
#endif
struct Frame {
    unsigned long long tacc;
    LAS unsigned char* lds;
    volatile LAS unsigned* MISC;
    gu32* ctl;
    int tid, lane, wave;
    int vcu, G;
};
struct Args { const float* in[19]; float* out; unsigned char* ws; };

__device__ __forceinline__ float wave_sum(float v) {
#pragma unroll
    for (int o = 1; o < 64; o <<= 1) v += __shfl_xor(v, o);
    return v;
}
__device__ __forceinline__ float wave_max(float v) {
#pragma unroll
    for (int o = 1; o < 64; o <<= 1) v = fmaxf(v, __shfl_xor(v, o));
    return v;
}
__device__ __forceinline__ int phys_col(int c) { return (c & ~255) | (((c >> 5) & 1) << 7) | (((c >> 6) & 3) << 5) | (c & 31); }

__device__ __forceinline__ void p0_transpose_item(const float* W, int K, int N, bf16* WT, bool permute, const float* gain, LAS float* scr, int item, int lane) {
    const int nblk = N / 32, kb = item / nblk, nb = item % nblk, k0 = 64 * kb, n0 = 32 * nb;
    const float* src = W + (size_t)(k0 + (lane >> 5)) * N + n0 + (lane & 31);
    float w[32];
#pragma unroll
    for (int i = 0; i < 32; ++i) w[i] = __builtin_nontemporal_load(src + (size_t)(2 * i) * N);
    if (gain) {
#pragma unroll
        for (int i = 0; i < 32; ++i) w[i] *= gain[k0 + 2 * i + (lane >> 5)]; }
#pragma unroll
    for (int i = 0; i < 32; ++i) scr[(2 * i + (lane >> 5)) * 33 + (lane & 31)] = w[i];
    LDS_WAIT(); asm volatile("" ::: "memory");
    const int c = lane & 7;
    const int r0 = permute ? phys_col(n0) : n0;
#pragma unroll
    for (int j = 0; j < 4; ++j) { const int n = (lane >> 3) + 8 * j; const LAS float* s = scr + (8 * c) * 33 + n;
        v4u o; o.x = pk2(s[0 * 33], s[1 * 33]); o.y = pk2(s[2 * 33], s[3 * 33]); o.z = pk2(s[4 * 33], s[5 * 33]); o.w = pk2(s[6 * 33], s[7 * 33]);
        *(GAS v4u*)(WT + (size_t)(r0 + n) * K + k0 + 8 * c) = o; }
    LDS_WAIT(); asm volatile("" ::: "memory");
}
struct Row4 { f32x4 v[4]; };
__device__ __forceinline__ void row_load(Row4& r, const float* p, int lane) {
#pragma unroll
    for (int j = 0; j < 4; ++j) r.v[j] = __builtin_nontemporal_load((const GAS f32x4*)p + lane + 64 * j); }
__device__ __forceinline__ void row_store_bf16(const Row4& r, bf16* o, int lane) {
#pragma unroll
    for (int j = 0; j < 4; ++j) ((GAS unsigned long long*)o)[lane + 64 * j] = (unsigned long long)pk2(r.v[j].x, r.v[j].y) | ((unsigned long long)pk2(r.v[j].z, r.v[j].w) << 32); }
__device__ __forceinline__ void row_store_f32(const Row4& r, float* o, int lane) {
#pragma unroll
    for (int j = 0; j < 4; ++j) __builtin_nontemporal_store(r.v[j], (GAS f32x4*)o + lane + 64 * j); }
__device__ __forceinline__ const float* x_row(const Args& a, int m) { return m < SEQ ? a.in[0] + (size_t)m * DM : a.in[1] + (size_t)(m - SEQ) * DM; }
__device__ __forceinline__ void rms_finish(Row4& r, const Row4& g, bf16* o, int lane) {
    float s = 0.f;
#pragma unroll
    for (int j = 0; j < 4; ++j) s += (r.v[j].x * r.v[j].x + r.v[j].y * r.v[j].y) + (r.v[j].z * r.v[j].z + r.v[j].w * r.v[j].w);
    const float rs = rsqrtf(wave_sum(s) * (1.f / DM) + EPS);
#pragma unroll
    for (int j = 0; j < 4; ++j) r.v[j] = r.v[j] * rs * g.v[j];
    row_store_bf16(r, o, lane);
}
__device__ __forceinline__ float row_maxnorm2(const Row4& r) {
    float qm = 0.f;
#pragma unroll
    for (int j = 0; j < 4; ++j) { float q = (r.v[j].x * r.v[j].x + r.v[j].y * r.v[j].y) + (r.v[j].z * r.v[j].z + r.v[j].w * r.v[j].w);
#pragma unroll
        for (int d = 1; d < 16; d <<= 1) q += __shfl_xor(q, d);
        qm = fmaxf(qm, q); }
    return qm;
}
__device__ __forceinline__ void cache_rows_a(const float* srck, const float* srcv, bf16* dbk, bf16* dbv, float* dok, float* dov, int row, gu32* kmax, int lane) {
    constexpr int L = 128, W = 128;
    const int b = row / L, j = row % L;
    const size_t so = (size_t)row * W, oo = ((size_t)b * L + (j - 64)) * W;
    const float k0 = srck[so + 2 * lane], k1 = srck[so + 2 * lane + 1], v0 = srcv[so + 2 * lane], v1 = srcv[so + 2 * lane + 1];
    ((GAS unsigned*)(dbk + so))[lane] = pk2(k0, k1); ((GAS unsigned*)(dbv + so))[lane] = pk2(v0, v1);
    if (j >= 64) { dok[oo + 2 * lane] = k0; dok[oo + 2 * lane + 1] = k1; dov[oo + 2 * lane] = v0; dov[oo + 2 * lane + 1] = v1; }
    float q = k0 * k0 + k1 * k1;
#pragma unroll
    for (int d = 1; d < 32; d <<= 1) q += __shfl_xor(q, d);
    q = fmaxf(q, __shfl_xor(q, 32));
    if (lane == 0) __hip_atomic_fetch_max(kmax, __float_as_uint(q), __ATOMIC_RELAXED, __HIP_MEMORY_SCOPE_AGENT);
}
__device__ __forceinline__ void p0_prologue(Frame& F, const Args& a) {
    LAS float* scr = (LAS float*)(F.lds + RING_OFF + F.wave * 16384);
    const int gw = F.vcu * NWAVES + F.wave, NGW = F.G * NWAVES, lane = F.lane;
    unsigned char* ws = a.ws;
    bf16* XN = (bf16*)(ws + WS_XN);
    {
        Row4 g, a0, a1, b0, b1; row_load(g, a.in[7], lane);
        const int S = NGW;
        int m = gw;
#define XLOAD(R0, R1, mm) do { if ((mm) < M) row_load(R0, x_row(a, (mm)), lane); if ((mm) + S < M) row_load(R1, x_row(a, (mm) + S), lane); } while (0)
#define XFIN(R0, R1, mm) do { if ((mm) < M) rms_finish(R0, g, XN + (size_t)(mm) * DM, lane); if ((mm) + S < M) rms_finish(R1, g, XN + (size_t)((mm) + S) * DM, lane); } while (0)
        XLOAD(a0, a1, m);
        for (; m < M; m += 4 * S) {
            XLOAD(b0, b1, m + 2 * S);
            XFIN(a0, a1, m);
            XLOAD(a0, a1, m + 4 * S);
            XFIN(b0, b1, m + 2 * S);
        }
#undef XLOAD
#undef XFIN
    }
    constexpr int I_INA = (DM / 64) * (NIN_A / 32);
    for (int it = gw; it < I_INA; it += NGW) p0_transpose_item(a.in[8], DM, NIN_A, (bf16*)(ws + WS_WINA), true, nullptr, scr, it, lane);
    for (int r = gw; r < NB * 128; r += NGW)
        cache_rows_a(a.in[2], a.in[3], (bf16*)(ws + WS_CKA), (bf16*)(ws + WS_CVA), a.out + O_KAS, a.out + O_VAS, r, F.ctl + CW_KMAX_A, lane);
}
__device__ __forceinline__ void side_weights(Frame& F, const Args& a, int w, int nw) {
    LAS float* scr = (LAS float*)(F.lds + RING_OFF + F.wave * 16384);
    unsigned char* ws = a.ws;
    constexpr int I_O = (DM / 64) * (DM / 32), I_INB = (DM / 64) * (NIN_B / 32);
    for (int it = w; it < I_O + I_INB + I_O; it += nw) {
        int r = it;
        if (r < I_O) { p0_transpose_item(a.in[12], DM, DM, (bf16*)(ws + WS_WOUTA), false, nullptr, scr, r, F.lane); continue; } r -= I_O;
        if (r < I_INB) { p0_transpose_item(a.in[14], DM, NIN_B, (bf16*)(ws + WS_WINB), true, a.in[13], scr, r, F.lane); continue; } r -= I_INB;
        p0_transpose_item(a.in[18], DM, DM, (bf16*)(ws + WS_WOUTB), false, nullptr, scr, r, F.lane);
    }
}
__device__ __forceinline__ void side_cache_b_conv(Frame& F, const Args& a, int w, int nw, int r_lo, int r_hi) {
    unsigned char* ws = a.ws; const int lane = F.lane;
    const float* srck = a.in[4]; const float* srcv = a.in[5];
    bf16* dbk = (bf16*)(ws + WS_CKB); bf16* dbv = (bf16*)(ws + WS_CVB); float* dok = a.out + O_KBS; float* dov = a.out + O_VBS;
    const int NR = r_hi;
    Row4 ka, va, kb, vb; float qm = 0.f;
#define CB_LOAD(K_, V_, r) do { row_load(K_, srck + (size_t)(r) * DM, lane); row_load(V_, srcv + (size_t)(r) * DM, lane); } while (0)
#define CB_FIN(K_, V_, r) do { const size_t so_ = (size_t)(r) * DM; row_store_bf16(K_, dbk + so_, lane); row_store_bf16(V_, dbv + so_, lane); \
        if (((r) & 511) >= 64) { const size_t oo_ = so_ - 64 * DM; row_store_f32(K_, dok + oo_, lane); row_store_f32(V_, dov + oo_, lane); }     \
        qm = fmaxf(qm, row_maxnorm2(K_)); } while (0)
    int r = r_lo + w;
    if (r < NR) CB_LOAD(ka, va, r);
    for (; r < NR; r += 2 * nw) {
        const int r1 = r + nw, r2 = r + 2 * nw;
        if (r1 < NR) CB_LOAD(kb, vb, r1);
        CB_FIN(ka, va, r);
        if (r2 < NR) CB_LOAD(ka, va, r2);
        if (r1 < NR) CB_FIN(kb, vb, r1);
    }
#undef CB_LOAD
#undef CB_FIN
    qm = wave_max(qm);
    if (lane == 0) __hip_atomic_fetch_max(F.ctl + CW_KMAX_B, __float_as_uint(qm), __ATOMIC_RELAXED, __HIP_MEMORY_SCOPE_AGENT);
}
__device__ __forceinline__ void side_cache_b_copy(Frame& F, const Args& a, int w, int nw, int r_lo, int r_hi) {
    const int lane = F.lane;
    const float* srck = a.in[4]; const float* srcv = a.in[5]; float* dok = a.out + O_KBS; float* dov = a.out + O_VBS;
    const int NR = r_hi;
    Row4 ka, va, kb, vb;
#define CP_SRC(r) ((size_t)((r) / 448) * 512 + 64 + (r) % 448)
#define CP_DST(r) ((size_t)((r) / 448) * 512 + (r) % 448)
#define CP_LOAD(K_, V_, r) do { const size_t so_ = CP_SRC(r) * DM; row_load(K_, srck + so_, lane); row_load(V_, srcv + so_, lane); } while (0)
#define CP_FIN(K_, V_, r) do { const size_t oo_ = CP_DST(r) * DM; row_store_f32(K_, dok + oo_, lane); row_store_f32(V_, dov + oo_, lane); } while (0)
    int r = r_lo + w;
    if (r < NR) CP_LOAD(ka, va, r);
    for (; r < NR; r += 2 * nw) {
        const int r1 = r + nw, r2 = r + 2 * nw;
        if (r1 < NR) CP_LOAD(kb, vb, r1);
        CP_FIN(ka, va, r);
        if (r2 < NR) CP_LOAD(ka, va, r2);
        if (r1 < NR) CP_FIN(kb, vb, r1);
    }
#undef CP_SRC
#undef CP_DST
#undef CP_LOAD
#undef CP_FIN
}
template <int LAYER> __device__ __forceinline__ void tail_outproj(LAS unsigned char* lds, const bf16* A, const bf16* Bt, int c, const float* xs, bf16* yb, float* slab, float* out) {
    int tid_ = threadIdx.x; asm volatile("" : "+v"(tid_));
    const int tid = tid_, lane = tid & 63, wid = __builtin_amdgcn_readfirstlane(tid >> 6), fr = lane & 15, fq = lane >> 4;
    const int rb = c >> 4, cb = c & 15, row0 = SEQ + 64 * rb, col0 = 64 * cb;
    const bf16* ap = A + (size_t)(row0 + fr) * DM + 128 * wid + 8 * fq;
    const bf16* bp = Bt + (size_t)(col0 + fr) * DM + 128 * wid + 8 * fq;
    bf16x8 af[4][4], bfr[4][4];
#pragma unroll
    for (int m = 0; m < 4; ++m)
#pragma unroll
        for (int ks = 0; ks < 4; ++ks) { af[m][ks] = *(const GAS bf16x8*)(ap + (size_t)(16 * m) * DM + 32 * ks); bfr[m][ks] = *(const GAS bf16x8*)(bp + (size_t)(16 * m) * DM + 32 * ks); }
    f32x4 acc[4][4];
#pragma unroll
    for (int m = 0; m < 4; ++m)
#pragma unroll
        for (int n = 0; n < 4; ++n) { acc[m][n] = (f32x4){0.f, 0.f, 0.f, 0.f};
#pragma unroll
            for (int ks = 0; ks < 4; ++ks) acc[m][n] = __builtin_amdgcn_mfma_f32_16x16x32_bf16(bfr[n][ks], af[m][ks], acc[m][n], 0, 0, 0); }
    LAS float* part = (LAS float*)lds + wid * 4096;
#pragma unroll
    for (int m = 0; m < 4; ++m)
#pragma unroll
        for (int n = 0; n < 4; ++n) *(LAS f32x4*)(part + (16 * m + fr) * 64 + 16 * n + 4 * fq) = acc[m][n];
    __syncthreads();
    const int r = tid >> 3, c8 = (tid & 7) * 8;
    f32x4 s0 = (f32x4){0.f, 0.f, 0.f, 0.f}, s1 = s0;
#pragma unroll
    for (int w = 0; w < 8; ++w) { const LAS float* p = (const LAS float*)lds + w * 4096 + r * 64 + c8; s0 += *(const LAS f32x4*)p; s1 += *(const LAS f32x4*)(p + 4); }
    const int row = row0 + r;
    if (LAYER == 1) {
        const v4u w = *(const GAS v4u*)(yb + (size_t)row * DM + col0 + c8);
        const f32x4 r0 = {__uint_as_float(w.x << 16), __uint_as_float(w.x & 0xffff0000u), __uint_as_float(w.y << 16), __uint_as_float(w.y & 0xffff0000u)};
        const f32x4 r1 = {__uint_as_float(w.z << 16), __uint_as_float(w.z & 0xffff0000u), __uint_as_float(w.w << 16), __uint_as_float(w.w & 0xffff0000u)};
        float* op = out + (size_t)row * DM + col0 + c8;
        *(GAS f32x4*)op = s0 + r0; *(GAS f32x4*)(op + 4) = s1 + r1;
        __syncthreads();
        return;
    }
    const float* xp = xs + (size_t)(row - SEQ) * DM + col0 + c8;
    const f32x4 y0 = s0 + *(const GAS f32x4*)xp, y1 = s1 + *(const GAS f32x4*)(xp + 4);
    v4u wv; wv.x = pk2(y0[0], y0[1]); wv.y = pk2(y0[2], y0[3]); wv.z = pk2(y1[0], y1[1]); wv.w = pk2(y1[2], y1[3]);
    *(GAS v4u*)(yb + (size_t)row * DM + col0 + c8) = wv;
    float ss = ((y0[0] * y0[0] + y0[1] * y0[1]) + (y0[2] * y0[2] + y0[3] * y0[3])) + ((y1[0] * y1[0] + y1[1] * y1[1]) + (y1[2] * y1[2] + y1[3] * y1[3]));
    ss += __shfl_xor(ss, 1); ss += __shfl_xor(ss, 2); ss += __shfl_xor(ss, 4);
    if ((tid & 7) == 0) slab[(size_t)row * 16 + cb] = ss;
    __syncthreads();
}

namespace attn {
using bf16x8 = __attribute__((ext_vector_type(8))) short;
using s16x4 = __attribute__((ext_vector_type(4))) short;
using f32x16 = __attribute__((ext_vector_type(16))) float;
using u32x4 = pg8::u32x4;
typedef short v4i16_t __attribute__((ext_vector_type(4)));
typedef __attribute__((address_space(3))) const char* lds_cptr;
__device__ __forceinline__ int crow(int r, int hi) { return (r & 3) + 8 * (r >> 2) + 4 * hi; }
__device__ __forceinline__ s16x4 vtr(lds_cptr p) { return __builtin_bit_cast(s16x4, __builtin_amdgcn_ds_read_tr16_b64_v4i16((__attribute__((address_space(3))) v4i16_t*)p)); }
typedef float f32x2_t __attribute__((ext_vector_type(2))); typedef __bf16 bf16x2_t __attribute__((ext_vector_type(2)));
__device__ __forceinline__ unsigned cvtpk(float lo, float hi) { f32x2_t v = {lo, hi}; bf16x2_t b = __builtin_convertvector(v, bf16x2_t); return __builtin_bit_cast(unsigned, b); }
__device__ __forceinline__ int t5_bucket(int rel) {
    const int n = rel < 0 ? -rel : rel;
    int b = n;
    if (n >= 8) b = 8 + (n >= 12) + (n >= 16) + (n >= 23) + (n >= 32) + (n >= 46) + (n >= 64) + (n >= 91);
    return b + (rel > 0 ? 16 : 0);
}
__device__ __forceinline__ void glds16(const void* gsrc, unsigned lds_dst) { unsigned keep;
    asm volatile("s_mov_b32 %0, m0\n\ts_mov_b32 m0, %2\n\ts_nop 0\n\tglobal_load_lds_dwordx4 %1, off\n\ts_mov_b32 m0, %0" : "=&s"(keep) : "v"(gsrc), "s"(lds_dst) : "memory"); }
__device__ __forceinline__ float bf2f(unsigned short h) { return __uint_as_float((unsigned)h << 16); }

template <int LAYER>
__device__ __forceinline__ void attn_phase(Frame& F, const Args& a) {
    constexpr int P = LAYER == 0 ? 2 : 8;
    constexpr int KVW = LAYER == 0 ? 128 : 1024;
    constexpr int L = P * 64;
    constexpr int RT0 = LAYER == 0 ? 0 : 6;
    unsigned char* ws = a.ws;
    const bf16* Q = (const bf16*)(ws + (LAYER == 0 ? WS_QA : WS_QB));
    const bf16* Kg = (const bf16*)(ws + (LAYER == 0 ? WS_KA : WS_KB));
    const bf16* Vg = (const bf16*)(ws + (LAYER == 0 ? WS_VA : WS_VB));
    const bf16* Gt = (const bf16*)(ws + (LAYER == 0 ? WS_GA : WS_GB));
    const bf16* CK = (const bf16*)(ws + (LAYER == 0 ? WS_CKA : WS_CKB));
    const bf16* CV = (const bf16*)(ws + (LAYER == 0 ? WS_CVA : WS_CVB));
    bf16* O = (bf16*)(ws + WS_XN);
    const float* qg = a.in[LAYER == 0 ? 9 : 15]; const float* kg = a.in[LAYER == 0 ? 10 : 16];
    const float* table = a.in[LAYER == 0 ? 6 : 17];
    int tid_ = threadIdx.x; asm volatile("" : "+v"(tid_));
    const int tid = tid_, lane = tid & 63, wid = __builtin_amdgcn_readfirstlane(tid >> 6), r32 = lane & 31, hi = lane >> 5;
    const int h = F.vcu >> 4, sub = F.vcu & 15;
    const int kvh = LAYER == 0 ? (h >> 3) : h;
    LAS unsigned char* lds = F.lds + RING_OFF;
    const int cw = wid >> 1, half = wid & 1;
    const unsigned lds0 = (unsigned)(size_t)lds;
#define UNIT_PARAMS(ui_, X) const bool X##sample = (ui_) == 4; const int X##u0 = 4 * (4 * sub + (ui_)); const int X##nt = X##sample ? P + 1 : P + 4; \
        const int X##tb = X##sample ? 0 : (X##u0 >= P ? 0 : P - X##u0); const bool X##won = !X##sample || cw == 0; \
        const size_t X##qtok = X##sample ? (size_t)SEQ + 64 * sub + 32 * half : (size_t)64 * (X##u0 + cw) + 32 * half;
#define TILE_DMA_U(X, t, slot_) do { const bf16 *kb_, *vb_; \
            if (!X##sample) { const size_t r0_ = (size_t)64 * (X##u0 - P + (t)) * KVW; kb_ = Kg + r0_; vb_ = Vg + r0_; } \
            else if ((t) < P) { const size_t r0_ = ((size_t)sub * L + 64 * (t)) * KVW; kb_ = CK + r0_; vb_ = CV + r0_; } \
            else { const size_t r0_ = ((size_t)SEQ + 64 * sub) * KVW; kb_ = Kg + r0_; vb_ = Vg + r0_; } \
            const unsigned s_ = (unsigned)__builtin_amdgcn_readfirstlane(lds0 + AT_SLOT + ((slot_) & 3) * AT_SLOTB + wid * 1024); \
            glds16(kb_ + koff, s_); glds16(vb_ + voff, s_ + 8192); } while (0)
#define Q_DMA_U(X) do { if (X##won) { _Pragma("unroll") for (int i_ = 0; i_ < 4; ++i_) glds16(Q + (X##qtok + 8 * i_ + (lane >> 3)) * DM + h * 64 + (lane & 7) * 8, (unsigned)__builtin_amdgcn_readfirstlane(lds0 + AT_OST + wid * 4096 + i_ * 1024)); } } while (0)
#define WAIT_BAR(N) asm volatile("s_waitcnt vmcnt(" #N ") lgkmcnt(0)\n\ts_barrier" ::: "memory")
    const size_t koff = (size_t)lane * KVW + kvh * 64 + wid * 8, voff = (size_t)(16 * (wid & 3) + (lane >> 2)) * KVW + kvh * 64 + (wid >> 2) * 32 + (lane & 3) * 8;
    int sb = 0;
    {
        UNIT_PARAMS(0, f_)
        Q_DMA_U(f_); TILE_DMA_U(f_, f_tb, 0); TILE_DMA_U(f_, f_tb + 1, 1);
    }
    PSEG_BEGIN(1) PSEG_BEGIN(5)
    constexpr int NBR = LAYER == 0 ? 32 : 257;
    LAS float* brow = (LAS float*)(lds + AT_WSF);
    for (int i = tid; i < NBR; i += NWAVES * 64) brow[i] = LAYER == 0 ? table[i * 16 + h] : table[h * 257 + i];
    const float gqa = fabsf(qg[lane]), gka = fabsf(kg[lane]);
    const unsigned kcb = __hip_atomic_load(F.ctl + (LAYER == 0 ? CW_KMAX_A : CW_KMAX_B), __ATOMIC_RELAXED, __HIP_MEMORY_SCOPE_AGENT);
    const float sinkv = LAYER == 0 ? a.in[11][h] : 0.f;
    __syncthreads();
    float bm = -1e30f;
    for (int i = lane; i < NBR; i += 64) bm = fmaxf(bm, brow[i]);
    bm = wave_max(bm);
    const float gqm = wave_max(gqa), gkm = wave_max(gka), kc = sqrtf(__uint_as_float(kcb));
    const float bound = gqm * fmaxf(8.f * gkm, kc) * 1.01f + bm;
    const float cconst = LAYER == 0 ? 0.f : (brow[256 % NBR] - bound) * LOG2E;
    const float sinkp = LAYER == 0 ? __builtin_amdgcn_exp2f((sinkv - bound) * LOG2E) : 0.f;
    {
        LAS float* tab = (LAS float*)(lds + AT_TAB);
        for (int i = tid; i < 3 * 2 * 8 * 64 * 4; i += NWAVES * 64) {
            const int e = i & 3, ln = (i >> 2) & 63, q4 = (i >> 8) & 7, half = (i >> 11) & 1, rtv = i >> 12;
            const int R = 4 * q4 + e, key = 32 * (R >> 4) + crow(R & 15, ln >> 5), qi = 32 * half + (ln & 31), j = 64 * (RT0 + rtv) + key;
            float bv;
            if (LAYER == 0) bv = brow[t5_bucket(j - (P * 64 + qi))];
            else { int idx = P * 64 + qi - j; idx = idx < -128 ? -128 : (idx > 128 ? 128 : idx); bv = brow[(idx + 128) % NBR]; }
            tab[i] = (bv - bound) * LOG2E;
        }
    }
    __syncthreads();
    f32x16 cc16;
#pragma unroll
    for (int r = 0; r < 16; ++r) cc16[r] = cconst;
    asm volatile("" : "+v"(cc16));
    PSEG_END(5)
    const lds_cptr lds3 = (lds_cptr)lds;
    const lds_cptr kp0 = lds3 + AT_SLOT + hi * 1024 + r32 * 16;
    const lds_cptr vp0 = lds3 + AT_SLOT + 8192 + ((lane >> 4) & 1) * 32 + (lane & 3) * 8 + (4 * hi + ((lane & 15) >> 2)) * 64;
    const LAS f32x4* tabl = (const LAS f32x4*)(lds + AT_TAB) + lane;
    LAS float* wsf = (LAS float*)(lds + AT_WSF) + wid * 64;
    for (int ui = 0; ui < 5; ++ui) {
        PSEG_BEGIN(2)
        UNIT_PARAMS(ui, c_)
        const bool sample = c_sample, wave_on = c_won, has_next = ui < 4; const int nt = c_nt, t_begin = c_tb; const size_t qtok = c_qtok;
        UNIT_PARAMS(ui + 1, n_)
        f32x16 o[2]; o[0] = f32x16{}; o[1] = f32x16{};
        float l_reg = 0.f;
        if (ui == 0) WAIT_BAR(2); else WAIT_BAR(4);
        PSEG_END(2) PSEG_BEGIN(3)
        bf16x8 qr[4];
#pragma unroll
        for (int d0 = 0; d0 < 4; ++d0) qr[d0] = *(const __attribute__((address_space(3))) bf16x8*)(lds3 + AT_OST + wid * 4096 + r32 * 128 + (2 * d0 + hi) * 16);
        u32x4 pw[4];
#pragma unroll
        for (int s = 0; s < 4; ++s) pw[s] = (u32x4){0u, 0u, 0u, 0u};
        v4u gpre[4];
#pragma unroll
        for (int i = 0; i < 4; ++i) gpre[i] = (v4u){0u, 0u, 0u, 0u};
#define STEP_HEAD(t) const int sl = (t) - t_begin + sb;                    \
            if ((t) + 2 < nt) TILE_DMA_U(c_, (t) + 2, sl + 2);             \
            if ((t) == nt - 1) { \
                if (wave_on) { _Pragma("unroll") for (int i = 0; i < 4; ++i) gpre[i] = *(const GAS v4u*)(Gt + (qtok + i * 8 + (lane >> 3)) * DM + h * 64 + (lane & 7) * 8); } \
                asm volatile("" ::: "memory"); \
                if (has_next) { Q_DMA_U(n_); TILE_DMA_U(n_, n_tb, sl + 1); } }     \
            if ((t) == nt && has_next) TILE_DMA_U(n_, n_tb + 1, sl + 1);
#define STEP_TAIL(t) if ((t) + 2 < nt) WAIT_BAR(2); else if ((t) + 2 == nt || !has_next) WAIT_BAR(0); else WAIT_BAR(63);
        const int a_lo = wave_on ? (cw > t_begin ? cw : t_begin) : nt + 1, a_hi = wave_on ? (cw + P + 1 < nt ? cw + P + 1 : nt) : nt;
        int t = t_begin;
        for (; t < a_lo && t <= nt; ++t) { STEP_HEAD(t) STEP_TAIL(t) }
        for (; t <= a_hi; ++t) {
            STEP_HEAD(t)
            const int rt = t - cw;
            {
                const bool last = rt == P + 1 || t == nt, first = rt == 0 || t == t_begin;
                const int rtb = last ? rt - 1 : rt;
                const int ko = ((last ? sl - 1 : sl) & 3) * AT_SLOTB, vo = ((first ? sl : sl - 1) & 3) * AT_SLOTB;
                const lds_cptr kp = kp0 + ko, vp = vp0 + vo;
                bf16x8 kf[8];
#pragma unroll
                for (int d0 = 0; d0 < 4; ++d0) { kf[2 * d0] = *(const __attribute__((address_space(3))) bf16x8*)(kp + d0 * 2048); kf[2 * d0 + 1] = *(const __attribute__((address_space(3))) bf16x8*)(kp + d0 * 2048 + 512); }
                f32x16 p0, p1;
                __builtin_amdgcn_s_setprio(1);
                if (rtb >= RT0) { const LAS f32x4* tp = tabl + ((rtb - RT0) * 2 + half) * 8 * 64;
                    const f32x16 t0 = __builtin_shufflevector(__builtin_shufflevector(tp[0], tp[64], 0, 1, 2, 3, 4, 5, 6, 7), __builtin_shufflevector(tp[128], tp[192], 0, 1, 2, 3, 4, 5, 6, 7), 0, 1, 2, 3, 4, 5, 6, 7, 8, 9, 10, 11, 12, 13, 14, 15);
                    const f32x16 t1 = __builtin_shufflevector(__builtin_shufflevector(tp[256], tp[320], 0, 1, 2, 3, 4, 5, 6, 7), __builtin_shufflevector(tp[384], tp[448], 0, 1, 2, 3, 4, 5, 6, 7), 0, 1, 2, 3, 4, 5, 6, 7, 8, 9, 10, 11, 12, 13, 14, 15);
                    p0 = __builtin_amdgcn_mfma_f32_32x32x16_bf16(kf[0], qr[0], t0, 0, 0, 0); p1 = __builtin_amdgcn_mfma_f32_32x32x16_bf16(kf[1], qr[0], t1, 0, 0, 0); }
                else { p0 = __builtin_amdgcn_mfma_f32_32x32x16_bf16(kf[0], qr[0], cc16, 0, 0, 0); p1 = __builtin_amdgcn_mfma_f32_32x32x16_bf16(kf[1], qr[0], cc16, 0, 0, 0); }
#pragma unroll
                for (int d0 = 1; d0 < 4; ++d0) { p0 = __builtin_amdgcn_mfma_f32_32x32x16_bf16(kf[2 * d0], qr[d0], p0, 0, 0, 0); p1 = __builtin_amdgcn_mfma_f32_32x32x16_bf16(kf[2 * d0 + 1], qr[d0], p1, 0, 0, 0); }
                bf16x8 vf[8];
#pragma unroll
                for (int i = 0; i < 8; ++i) { const s16x4 lo = vtr(vp + (i >> 2) * 4096 + (i & 3) * 1024), hh = vtr(vp + (i >> 2) * 4096 + (i & 3) * 1024 + 512); vf[i] = (bf16x8){lo[0], lo[1], lo[2], lo[3], hh[0], hh[1], hh[2], hh[3]}; }
#pragma unroll
                for (int ks = 0; ks < 4; ++ks) { o[0] = __builtin_amdgcn_mfma_f32_32x32x16_bf16(__builtin_bit_cast(bf16x8, pw[ks]), vf[ks], o[0], 0, 0, 0); o[1] = __builtin_amdgcn_mfma_f32_32x32x16_bf16(__builtin_bit_cast(bf16x8, pw[ks]), vf[4 + ks], o[1], 0, 0, 0); }
                __builtin_amdgcn_s_setprio(0);
                float sacc = 0.f;
#pragma unroll
                for (int r = 0; r < 16; ++r) { p0[r] = __builtin_amdgcn_exp2f(p0[r]); p1[r] = __builtin_amdgcn_exp2f(p1[r]); sacc += p0[r] + p1[r]; }
                l_reg += last ? 0.f : sacc;
#pragma unroll
                for (int s = 0; s < 2; ++s)
#pragma unroll
                    for (int i = 0; i < 4; ++i) { pw[s][i] = cvtpk(p0[8 * s + 2 * i], p0[8 * s + 2 * i + 1]); pw[2 + s][i] = cvtpk(p1[8 * s + 2 * i], p1[8 * s + 2 * i + 1]); }
            }
            STEP_TAIL(t)
        }
        for (; t <= nt; ++t) { STEP_HEAD(t) STEP_TAIL(t) }
#undef STEP_HEAD
#undef STEP_TAIL
        PSEG_END(3) PSEG_BEGIN(4)
#undef TILE_DMA
#undef WAIT_BAR
        if (wave_on) {
            l_reg += __shfl_xor(l_reg, 32);
            l_reg += sinkp;
            if (hi == 0) wsf[r32] = l_reg;
            LDS_WAIT(); asm volatile("" ::: "memory");
            LAS unsigned short* stg = (LAS unsigned short*)(lds + AT_SLOT + (((nt - 2 - t_begin + sb) + (wid >> 2)) & 3) * AT_SLOTB + (wid & 3) * 4096);
#pragma unroll
            for (int r = 0; r < 16; ++r) { const int orow = crow(r, hi); const float rl = __builtin_amdgcn_rcpf(wsf[orow]);
#pragma unroll
                for (int d0 = 0; d0 < 2; ++d0) stg[orow * 64 + d0 * 32 + r32] = (unsigned short)(f2bf(o[d0][r] * rl)); }
            LDS_WAIT(); asm volatile("" ::: "memory");
#pragma unroll
            for (int i = 0; i < 4; ++i) { const int row = i * 8 + (lane >> 3), ch = lane & 7;
                const v4u ov = *(const LAS v4u*)(stg + row * 64 + ch * 8);
                const size_t go = (qtok + row) * DM + h * 64 + ch * 8;
                const v4u gvv = gpre[i];
                v4u res;
#pragma unroll
                for (int e = 0; e < 4; ++e) { const float a0 = __uint_as_float(ov[e] << 16) * __uint_as_float(gvv[e] << 16), a1 = __uint_as_float(ov[e] & 0xffff0000u) * __uint_as_float(gvv[e] & 0xffff0000u); res[e] = cvtpk(a0, a1); }
                *(GAS v4u*)(O + go) = res; }
        }
        sb += nt - t_begin;
        PSEG_END(4)
    }
    __syncthreads();
    PSEG_END(1)
}
template <int NV> __device__ __forceinline__ void wait_bar_n(int n) {
#define WB_(N) case N: asm volatile("s_waitcnt vmcnt(" #N ") lgkmcnt(0)\n\ts_barrier" ::: "memory"); break;
    switch (n) { WB_(0) WB_(2) WB_(4) WB_(6) WB_(8) WB_(10) WB_(12) WB_(14) WB_(16) WB_(18) WB_(20) WB_(22) WB_(24) WB_(26) WB_(28) default: asm volatile("s_waitcnt vmcnt(0) lgkmcnt(0)\n\ts_barrier" ::: "memory"); break; }
#undef WB_
}
__device__ __forceinline__ void attn_phase_a(Frame& F, const Args& a) {
    constexpr int P = 2, KVW = 128, NCH = 272, NSL = 5, SLOTB = 16384;
    constexpr int A2_RING = 0, A2_TT = NSL * SLOTB, A2_WSF = A2_TT + 8192, A2_Q = A2_WSF + 3072, A2_OST = A2_Q + NWAVES * 4096, A2_END = A2_OST + NWAVES * 4096;
    static_assert(A2_Q % 1024 == 0 && A2_END <= PHASE_BYTES, "layer A attention LDS map");
    unsigned char* ws = a.ws;
    const bf16* Q = (const bf16*)(ws + WS_QA); const bf16* Kg = (const bf16*)(ws + WS_KA); const bf16* Vg = (const bf16*)(ws + WS_VA); const bf16* Gt = (const bf16*)(ws + WS_GA);
    const bf16* CK = (const bf16*)(ws + WS_CKA); const bf16* CV = (const bf16*)(ws + WS_CVA);
    bf16* O = (bf16*)(ws + WS_XN);
    const float* qg = a.in[9]; const float* kg = a.in[10]; const float* table = a.in[6];
    int tid_ = threadIdx.x; asm volatile("" : "+v"(tid_));
    const int tid = tid_, lane = tid & 63, wid = __builtin_amdgcn_readfirstlane(tid >> 6), r32 = lane & 31, hi = lane >> 5;
    const int combo = F.vcu >> 6, g = combo >> 1, half = combo & 1, cidx = F.vcu & 63;
    const int c_lo = (cidx * NCH) >> 6, c_hi = ((cidx + 1) * NCH) >> 6;
    const int h = 8 * g + wid;
    LAS unsigned char* lds = F.lds + RING_OFF;
    const unsigned lds0 = (unsigned)(size_t)lds;
    const lds_cptr lds3 = (lds_cptr)lds;
    const int cp_hi = c_hi < 256 ? c_hi : 256;
    const int a0 = c_lo >= 2 ? c_lo - 2 : 0;
    const int npt = c_lo < 256 ? (cp_hi - 1) - a0 + 1 : 0;
    const int cs_lo = c_lo > 256 ? c_lo : 256;
#define T0_OF(c) (((c) < 2) ? 2 - (c) : 0)
#define POS_OF(c, ti) ((c) < 256 ? ((c) - 2 + (ti)) - a0 : npt + 3 * ((c) - cs_lo) + (ti))
#define NEW_OF(c, ti) ((c) >= 256 || (c) == c_lo || (ti) == 2)
#define QTOK_OF(c) ((c) < 256 ? (size_t)64 * (c) + 32 * half : (size_t)SEQ + 64 * ((c) - 256) + 32 * half)
    const size_t koff = (size_t)lane * KVW + g * 64 + wid * 8, voff = (size_t)(16 * (wid & 3) + (lane >> 2)) * KVW + g * 64 + (wid >> 2) * 32 + (lane & 3) * 8;
#define TILE_DMA_A(c, ti) do { const bf16 *kb_, *vb_; \
        if ((c) < 256) { const size_t r0_ = (size_t)64 * ((c) - 2 + (ti)) * KVW; kb_ = Kg + r0_; vb_ = Vg + r0_; } \
        else if ((ti) < 2) { const size_t r0_ = ((size_t)((c) - 256) * 128 + 64 * (ti)) * KVW; kb_ = CK + r0_; vb_ = CV + r0_; } \
        else { const size_t r0_ = ((size_t)SEQ + 64 * ((c) - 256)) * KVW; kb_ = Kg + r0_; vb_ = Vg + r0_; } \
        const unsigned s_ = (unsigned)__builtin_amdgcn_readfirstlane(lds0 + A2_RING + (POS_OF(c, ti) % NSL) * SLOTB + wid * 1024); \
        glds16(kb_ + koff, s_); glds16(vb_ + voff, s_ + 8192); } while (0)
#define Q_DMA_A(c) do { const size_t qt_ = QTOK_OF(c); _Pragma("unroll") for (int i_ = 0; i_ < 4; ++i_) glds16(Q + (qt_ + 8 * i_ + (lane >> 3)) * DM + h * 64 + (lane & 7) * 8, (unsigned)__builtin_amdgcn_readfirstlane(lds0 + A2_Q + wid * 4096 + i_ * 1024)); } while (0)
#define STEP_NEXT(c, ti) do { if ((ti) < 2) ++(ti); else { ++(c); (ti) = T0_OF(c); } } while (0)
    int c3 = c_lo, t3 = T0_OF(c_lo);
    Q_DMA_A(c_lo);
#pragma unroll 1
    for (int k = 0; k < 3; ++k) { if (c3 < c_hi) { if (NEW_OF(c3, t3)) TILE_DMA_A(c3, t3); STEP_NEXT(c3, t3); } }
    const float gqm = wave_max(fabsf(qg[lane])), gkm = wave_max(fabsf(kg[lane]));
    const float kc = sqrtf(__uint_as_float(__hip_atomic_load(F.ctl + CW_KMAX_A, __ATOMIC_RELAXED, __HIP_MEMORY_SCOPE_AGENT)));
    const float bm = wave_max(lane < 32 ? table[lane * 16 + h] : -1e30f);
    const float bound = gqm * fmaxf(8.f * gkm, kc) * 1.01f + bm;
    const float sinkp = __builtin_amdgcn_exp2f((a.in[11][h] - bound) * LOG2E);
    LAS float* TTw = (LAS float*)(lds + A2_TT) + wid * 256;
    for (int i = lane; i < 255; i += 64) TTw[i] = (table[t5_bucket(i - 191) * 16 + h] - bound) * LOG2E;
    const LAS float* tql = TTw + (63 - 32 * half - r32 + 4 * hi);
    const lds_cptr kp0 = lds3 + A2_RING + hi * 1024 + r32 * 16;
    const lds_cptr vp0 = lds3 + A2_RING + 8192 + ((lane >> 4) & 1) * 32 + (lane & 3) * 8 + (4 * hi + ((lane & 15) >> 2)) * 64;
    LAS float* wsf = (LAS float*)(lds + A2_WSF) + wid * 64;
    asm volatile("s_waitcnt vmcnt(0) lgkmcnt(0)\n\ts_barrier" ::: "memory");
    f32x16 o[2]; o[0] = f32x16{}; o[1] = f32x16{};
    float l_reg = 0.f;
    u32x4 pw[4];
#pragma unroll
    for (int s = 0; s < 4; ++s) pw[s] = (u32x4){0u, 0u, 0u, 0u};
    bf16x8 qr[4];
    v4u gpre[4];
    { const size_t qt0 = QTOK_OF(c_lo);
#pragma unroll
      for (int i = 0; i < 4; ++i) gpre[i] = *(const GAS v4u*)(Gt + (qt0 + i * 8 + (lane >> 3)) * DM + h * 64 + (lane & 7) * 8); }
    int c = c_lo, ti = T0_OF(c_lo);
    int pc = -1, pv_pos = 0;
    bool p_last = false;
    int ops_prev = 4;
    for (;;) {
        const bool qk_on = c < c_hi;
        int ops = 0;
        if (qk_on && ti == T0_OF(c)) {
#pragma unroll
            for (int d0 = 0; d0 < 4; ++d0) qr[d0] = *(const __attribute__((address_space(3))) bf16x8*)(lds3 + A2_Q + wid * 4096 + r32 * 128 + (2 * d0 + hi) * 16);
        }
        f32x16 p0, p1;
        {
            const int pos = qk_on ? POS_OF(c, ti) : pv_pos;
            const int tq = qk_on ? ti : 2;
            const lds_cptr kp = kp0 + (pos % NSL) * SLOTB, vp = vp0 + ((pc >= 0 ? pv_pos : pos) % NSL) * SLOTB;
            bf16x8 kf[8];
#pragma unroll
            for (int d0 = 0; d0 < 4; ++d0) { kf[2 * d0] = *(const __attribute__((address_space(3))) bf16x8*)(kp + d0 * 2048); kf[2 * d0 + 1] = *(const __attribute__((address_space(3))) bf16x8*)(kp + d0 * 2048 + 512); }
            const LAS float* tq_ = tql + 64 * tq;
#pragma unroll
            for (int r = 0; r < 16; ++r) { p0[r] = tq_[(r & 3) + 8 * (r >> 2)]; p1[r] = tq_[32 + (r & 3) + 8 * (r >> 2)]; }
            __builtin_amdgcn_s_setprio(1);
#pragma unroll
            for (int d0 = 0; d0 < 4; ++d0) { p0 = __builtin_amdgcn_mfma_f32_32x32x16_bf16(kf[2 * d0], qr[d0], p0, 0, 0, 0); p1 = __builtin_amdgcn_mfma_f32_32x32x16_bf16(kf[2 * d0 + 1], qr[d0], p1, 0, 0, 0); }
            bf16x8 vf[8];
#pragma unroll
            for (int i = 0; i < 8; ++i) { const s16x4 lo = vtr(vp + (i >> 2) * 4096 + (i & 3) * 1024), hh = vtr(vp + (i >> 2) * 4096 + (i & 3) * 1024 + 512); vf[i] = (bf16x8){lo[0], lo[1], lo[2], lo[3], hh[0], hh[1], hh[2], hh[3]}; }
#pragma unroll
            for (int ks = 0; ks < 4; ++ks) { o[0] = __builtin_amdgcn_mfma_f32_32x32x16_bf16(__builtin_bit_cast(bf16x8, pw[ks]), vf[ks], o[0], 0, 0, 0); o[1] = __builtin_amdgcn_mfma_f32_32x32x16_bf16(__builtin_bit_cast(bf16x8, pw[ks]), vf[4 + ks], o[1], 0, 0, 0); }
            __builtin_amdgcn_s_setprio(0);
        }
        if (p_last) {
            l_reg += __shfl_xor(l_reg, 32);
            l_reg += sinkp;
            if (hi == 0) wsf[r32] = l_reg;
            LDS_WAIT(); asm volatile("" ::: "memory");
            LAS unsigned short* stg = (LAS unsigned short*)(lds + A2_OST) + wid * 2048;
#pragma unroll
            for (int r = 0; r < 16; ++r) { const int orow = crow(r, hi); const float rl = __builtin_amdgcn_rcpf(wsf[orow]);
#pragma unroll
                for (int d0 = 0; d0 < 2; ++d0) stg[orow * 64 + d0 * 32 + r32] = (unsigned short)(f2bf(o[d0][r] * rl)); }
            LDS_WAIT(); asm volatile("" ::: "memory");
            const size_t qtok = QTOK_OF(pc);
#pragma unroll
            for (int i = 0; i < 4; ++i) { const int row = i * 8 + (lane >> 3), ch = lane & 7;
                const v4u ov = *(const LAS v4u*)(stg + row * 64 + ch * 8);
                const v4u gvv = gpre[i];
                v4u res;
#pragma unroll
                for (int e = 0; e < 4; ++e) { const float a0_ = __uint_as_float(ov[e] << 16) * __uint_as_float(gvv[e] << 16), a1_ = __uint_as_float(ov[e] & 0xffff0000u) * __uint_as_float(gvv[e] & 0xffff0000u); res[e] = cvtpk(a0_, a1_); }
                *(GAS v4u*)(O + (qtok + row) * DM + h * 64 + ch * 8) = res; }
            ops += 4;
            o[0] = f32x16{}; o[1] = f32x16{}; l_reg = 0.f;
            if (qk_on) {
                const size_t qt2 = QTOK_OF(c);
#pragma unroll
                for (int i = 0; i < 4; ++i) gpre[i] = *(const GAS v4u*)(Gt + (qt2 + i * 8 + (lane >> 3)) * DM + h * 64 + (lane & 7) * 8);
                ops += 4; }
        }
        if (!qk_on) break;
        if (c3 < c_hi) { if (NEW_OF(c3, t3)) { TILE_DMA_A(c3, t3); ops += 2; } STEP_NEXT(c3, t3); }
        if (ti == T0_OF(c) && c + 1 < c_hi) { asm volatile("s_waitcnt lgkmcnt(0)" ::: "memory"); Q_DMA_A(c + 1); ops += 4; }
        {
            float sacc = 0.f;
#pragma unroll
            for (int r = 0; r < 16; ++r) { p0[r] = __builtin_amdgcn_exp2f(p0[r]); p1[r] = __builtin_amdgcn_exp2f(p1[r]); sacc += p0[r] + p1[r]; }
            l_reg += sacc;
#pragma unroll
            for (int s = 0; s < 2; ++s)
#pragma unroll
                for (int i = 0; i < 4; ++i) { pw[s][i] = cvtpk(p0[8 * s + 2 * i], p0[8 * s + 2 * i + 1]); pw[2 + s][i] = cvtpk(p1[8 * s + 2 * i], p1[8 * s + 2 * i + 1]); }
        }
        const bool short_chunk = T0_OF(c) != 0;
        wait_bar_n<0>(short_chunk ? 0 : ops + ops_prev);
        ops_prev = ops;
        pc = c; pv_pos = POS_OF(c, ti); p_last = ti == 2;
        STEP_NEXT(c, ti);
    }
    asm volatile("s_waitcnt vmcnt(0) lgkmcnt(0)\n\ts_barrier" ::: "memory");
#undef T0_OF
#undef POS_OF
#undef NEW_OF
#undef QTOK_OF
#undef TILE_DMA_A
#undef Q_DMA_A
#undef STEP_NEXT
}
}

__global__ void __launch_bounds__(NWAVES * 64, 2) mk_fwd(Args args) {
    extern __shared__ __attribute__((aligned(16))) unsigned char lds[];
    Frame F; F.tacc = 0;
    F.lds = (LAS unsigned char*)lds;
    F.MISC = (volatile LAS unsigned*)(F.lds + MISC_OFF);
    F.tid = threadIdx.x; F.lane = F.tid & 63; F.wave = __builtin_amdgcn_readfirstlane(F.tid >> 6);
    F.G = gridDim.x; { const int bx = blockIdx.x; F.vcu = (F.G % 8 == 0) ? (bx % 8) * (F.G / 8) + bx / 8 : bx; }
    unsigned char* ws = args.ws;
    F.ctl = (gu32*)(ws + WS_CTL);
    for (int u = F.tid; u < (LDS_BYTES - LDSCTL_OFF) / 4; u += NWAVES * 64) ((LAS unsigned*)(F.lds + LDSCTL_OFF))[u] = 0u;
    __syncthreads();
    XcdBarrier bar = xcd_barrier_post((unsigned*)(F.ctl + CW_BAR), F.MISC + 8);
    bf16* XN = (bf16*)(ws + WS_XN);
    float* slab = (float*)(ws + WS_SLAB);
    float* out = args.out;

#ifndef DUP_PHASE
#define DUP_PHASE -1
#endif
#define REPS_ON(k) int nrep_##k = 2; asm volatile("" : "+s"(nrep_##k)); for (int rep_ = 0; rep_ < nrep_##k; ++rep_)
#define REPS_OFF(k)
#define REPS_SEL(k) REPS_SEL2(k, DUP_PHASE)
#define REPS(k) REPS_##k
#if DUP_PHASE == 0
#define REPS_0 REPS_ON(0)
#else
#define REPS_0
#endif
#if DUP_PHASE == 1
#define REPS_1 REPS_ON(1)
#else
#define REPS_1
#endif
#if DUP_PHASE == 2
#define REPS_2 REPS_ON(2)
#else
#define REPS_2
#endif
#if DUP_PHASE == 3
#define REPS_3 REPS_ON(3)
#else
#define REPS_3
#endif
#if DUP_PHASE == 4
#define REPS_4 REPS_ON(4)
#else
#define REPS_4
#endif
#if DUP_PHASE == 5
#define REPS_5 REPS_ON(5)
#else
#define REPS_5
#endif
#if DUP_PHASE == 6
#define REPS_6 REPS_ON(6)
#else
#define REPS_6
#endif
    KSEG_BEGIN(10) REPS(0) { p0_prologue(F, args);
    xcd_barrier(bar); } KSEG_END(10)
    KSEG_BEGIN(11) REPS(1) {
        pg8::Gemm g{XN, (const bf16*)(ws + WS_WINA), M, NIN_A, DM}; pg8::StaticOrder S; S.init(M, NIN_A, F.G, (int)blockIdx.x);
        pg8::EpiIn E{0, (bf16*)(ws + WS_QA), (bf16*)(ws + WS_KA), (bf16*)(ws + WS_VA), (bf16*)(ws + WS_GA), 128, args.in[9], args.in[10], nullptr,
                     out + O_KAP, out + O_VAP, out + O_KAS, out + O_VAS, 128, 2, C2, nullptr};
        pg8::gemm_phase<pg8::EpiIn, pg8::StaticOrder, true, true>(F.lds + RING_OFF, g, S, E, PROBE_SEG == 31 ? &F.tacc : nullptr);
        { const int busy = (M / 256) * (NIN_A / 256) - 2 * F.G;
          if ((int)blockIdx.x >= busy && F.wave < 4) { side_weights(F, args, ((int)blockIdx.x - busy) * 4 + F.wave, (F.G - busy) * 4);
              side_cache_b_conv(F, args, ((int)blockIdx.x - busy) * 4 + F.wave, (F.G - busy) * 4, 0, NB * 256); } }
    xcd_barrier(bar); } KSEG_END(11)
    KSEG_BEGIN(12) REPS(2) { attn::attn_phase_a(F, args);
    xcd_barrier(bar); } KSEG_END(12)
    KSEG_BEGIN(13) REPS(3) {
        pg8::Gemm g{XN, (const bf16*)(ws + WS_WOUTA), SEQ, DM, DM}; pg8::StaticOrder S; S.init(SEQ, DM, F.G, (int)blockIdx.x);
        pg8::EpiOut E{0, args.in[0], args.in[1], (bf16*)(ws + WS_QA), nullptr, slab};
        KSEG_BEGIN(20) pg8::gemm_phase<pg8::EpiOut, pg8::StaticOrder, true, true>(F.lds + RING_OFF, g, S, E); KSEG_END(20)
        KSEG_BEGIN(21)
        tail_outproj<0>(F.lds + RING_OFF, XN, (const bf16*)(ws + WS_WOUTA), (int)blockIdx.x, args.in[1], (bf16*)(ws + WS_QA), slab, nullptr);
        KSEG_END(21)
    xcd_barrier(bar); } KSEG_END(13)
    KSEG_BEGIN(14) REPS(4) {
        pg8::Gemm g{(const bf16*)(ws + WS_QA), (const bf16*)(ws + WS_WINB), M, NIN_B, DM}; pg8::StaticOrder S; S.init(M, NIN_B, F.G, (int)blockIdx.x);
        pg8::EpiIn E{1, (bf16*)(ws + WS_QB), (bf16*)(ws + WS_KB), (bf16*)(ws + WS_VB), (bf16*)(ws + WS_GB), 1024, args.in[15], args.in[16], slab,
                     out + O_KBP, out + O_VBP, out + O_KBS, out + O_VBS, 512, 16, C2, (LAS float*)(F.lds + RING_BYTES + 1024)};
        pg8::gemm_phase<pg8::EpiIn, pg8::StaticOrder, true, true>(F.lds + RING_OFF, g, S, E, PROBE_SEG == 30 ? &F.tacc : nullptr);
        { const int busy = (M / 256) * (NIN_B / 256) - 4 * F.G;
          if ((int)blockIdx.x >= busy && F.wave < 2) side_cache_b_conv(F, args, ((int)blockIdx.x - busy) * 2 + F.wave, (F.G - busy) * 2, NB * 256, NB * 512); }
    xcd_barrier(bar); } KSEG_END(14)
    KSEG_BEGIN(15) REPS(5) { attn::attn_phase<1>(F, args);
    xcd_barrier(bar); } KSEG_END(15)
    KSEG_BEGIN(16) REPS(6) {
        pg8::Gemm g{XN, (const bf16*)(ws + WS_WOUTB), SEQ, DM, DM}; pg8::StaticOrder S; S.init(SEQ, DM, F.G, (int)blockIdx.x);
        pg8::EpiOut E{1, nullptr, nullptr, (bf16*)(ws + WS_QA), out + O_Y, nullptr};
        pg8::gemm_phase<pg8::EpiOut, pg8::StaticOrder, true, true>(F.lds + RING_OFF, g, S, E);
        tail_outproj<1>(F.lds + RING_OFF, XN, (const bf16*)(ws + WS_WOUTB), (int)blockIdx.x, nullptr, (bf16*)(ws + WS_QA), nullptr, out + O_Y);
    }
    KSEG_END(16)
#if PROBE_SEG
    if (blockIdx.x == 0) {
        const unsigned long long t0 = __builtin_amdgcn_s_memrealtime(), dt = 8ull * (unsigned long long)__builtin_amdgcn_readfirstlane((unsigned)F.tacc);
        while (__builtin_amdgcn_s_memrealtime() - t0 < dt) __builtin_amdgcn_s_sleep(32);
    }
#endif
}
extern "C" void kernel_launch(void* const* d_in, const int* in_sizes, int n_in, void* d_out, int out_size, void* d_ws, size_t ws_size, hipStream_t stream) {
    static int grid = 0;
    if (grid == 0) {
        if (n_in != 19 || out_size != (int)O_END || ws_size < WS_END) { fprintf(stderr, "kernel_launch: unexpected shapes (n_in %d, out %d, ws %zu)\n", n_in, out_size, ws_size); grid = -1; return; }
        int dev = 0, cus = 0, per_cu = 0;
        if (hipGetDevice(&dev) != hipSuccess || hipDeviceGetAttribute(&cus, hipDeviceAttributeMultiprocessorCount, dev) != hipSuccess) { grid = -1; return; }
        if (hipFuncSetAttribute((const void*)mk_fwd, hipFuncAttributeMaxDynamicSharedMemorySize, LDS_BYTES) != hipSuccess) { fprintf(stderr, "kernel_launch: hipFuncSetAttribute failed\n"); grid = -1; return; }
        if (hipOccupancyMaxActiveBlocksPerMultiprocessor(&per_cu, (const void*)mk_fwd, NWAVES * 64, LDS_BYTES) != hipSuccess || per_cu < 1) { fprintf(stderr, "kernel_launch: occupancy query says %d blocks per CU\n", per_cu); }
        (void)hipGetLastError();
        grid = cus;
        if (grid != 256) { fprintf(stderr, "kernel_launch: built for 256 CUs, found %d\n", cus); grid = -1; return; }
    }
    if (grid < 0) return;
    (void)hipMemsetAsync((char*)d_ws + WS_CTL, 0, CTL_ZERO_BYTES, stream);
    Args a{};
    for (int i = 0; i < 19; ++i) a.in[i] = (const float*)d_in[i];
    a.out = (float*)d_out; a.ws = (unsigned char*)d_ws;
    hipLaunchKernelGGL(mk_fwd, dim3(grid), dim3(NWAVES * 64), LDS_BYTES, stream, a);
}
```

```cpp
#include <hip/hip_runtime.h>
#include <cstdio>
#include <cstdint>
#include <cmath>
namespace pg8 {
#define PG8_LAS __attribute__((address_space(3)))
typedef unsigned short bf16_t;
typedef short bf16x8 __attribute__((ext_vector_type(8)));
typedef float f32x4 __attribute__((ext_vector_type(4)));
typedef unsigned u32x4 __attribute__((ext_vector_type(4)));
constexpr int BM = 256, BK = 64, HALF = 128, HTB = HALF * BK * 2  , STAGE_BYTES = 8 * HTB, NXCD = 8, WGM = 4;

__host__ __device__ __forceinline__ int lds_byte(int r, int c) { const int st = (r >> 4) * 2 + (c >> 5), rr = r & 15, cc = c & 31, ob = rr * 64 + cc * 2; return st * 1024 + (ob ^ (((ob >> 9) & 1) << 5)); }
__host__ __device__ __forceinline__ void stage_rc(int b, int& R, int& C) { const int st = b / 1024, sb = b % 1024, swz = sb ^ (((sb >> 9) & 1) << 5); R = (st >> 1) * 16 + swz / 64; C = (st & 1) * 32 + (swz % 64) / 2; }
__host__ __device__ __forceinline__ int perm32(int rho) { const int n = rho >> 4, i = rho & 15; return 8 * (i >> 2) + 4 * n + (i & 3); }

struct Unit { int pm, pn; };
struct Gemm { const bf16_t* A; const bf16_t* Bt; int M, N, K; };

struct StaticOrder {
    int nM, nN, nwg, G, c, wgm;
    __host__ __device__ void init(int M, int N, int G_, int c_, int wgm_ = WGM) { nM = M / BM; nN = N / BM; nwg = nM * nN; G = G_; c = c_; wgm = wgm_; }
    __host__ __device__ bool next(int i, Unit& u) const {
        const long L = (long)i * G + c; if (L >= nwg) return false;
        int wgid = (int)L; { const int q = nwg / NXCD, r = nwg % NXCD, xcd = wgid % NXCD, off = wgid / NXCD; wgid = (xcd < r ? xcd * (q + 1) : r * (q + 1) + (xcd - r) * q) + off; }
        const int nig = wgm * nN, gid = wgid / nig, fm = gid * wgm, gsz = (nM - fm) < wgm ? (nM - fm) : wgm;
        u.pm = fm + ((wgid % nig) % gsz); u.pn = (wgid % nig) / gsz; return true;
    }
    __device__ __forceinline__ void a_ready(const Unit&) const {}
    __device__ __forceinline__ void done(const Unit&) const {}
};
__device__ __forceinline__ unsigned cvt_pk_bf16(float lo, float hi) { unsigned r; asm volatile("v_cvt_pk_bf16_f32 %0, %1, %2" : "=v"(r) : "v"(lo), "v"(hi)); return r; }
__device__ __forceinline__ void st16_wt(void* p, u32x4 v) { asm volatile("global_store_dwordx4 %0, %1, off sc1\n\ts_nop 1" :: "v"(p), "v"(v) : "memory"); }
constexpr int SEQ_ = 16384;
constexpr float NORM_EPS = 1e-6f;
struct EpiIn {
    static constexpr bool PERM = true, AFTER_DRAIN = false;
    int layer;
    bf16_t *Q, *Kb, *Vb, *G; int kvw;
    const float *qg, *kg;
    const float* slab;
    float *okp, *ovp, *oks, *ovs; int keep, nkv;
    float c2;
    PG8_LAS float* rstd_lds;
    template <int TYPE>
    __device__ __forceinline__ void tile(const f32x4 (&acc)[2][2][4][2], int row0, int rl0, int dcol, int fq, bf16_t* dst, int ld, const float* gp, float sc, float* o_p, float* o_s, int head) const {
        f32x4 gv[2][2];
        if (TYPE < 2) {
#pragma unroll
            for (int bj = 0; bj < 2; ++bj)
#pragma unroll
                for (int n = 0; n < 2; ++n) gv[bj][n] = *(const f32x4*)(gp + 32 * bj + dcol + 4 * n) * sc; }
#pragma unroll
        for (int ai = 0; ai < 2; ++ai)
#pragma unroll
            for (int m = 0; m < 4; ++m) {
                const int row = row0 + ai * HALF + m * 16;
                const float rs = slab ? rstd_lds[ai * HALF + rl0 + m * 16] : 1.f;
                f32x4 v[2][2];
#pragma unroll
                for (int bj = 0; bj < 2; ++bj)
#pragma unroll
                    for (int n = 0; n < 2; ++n) v[bj][n] = acc[ai][bj][m][n] * rs;
                if (TYPE < 2) {
                    float ss = 0.f;
#pragma unroll
                    for (int bj = 0; bj < 2; ++bj)
#pragma unroll
                        for (int n = 0; n < 2; ++n) { const f32x4 x = v[bj][n]; ss += (x[0] * x[0] + x[1] * x[1]) + (x[2] * x[2] + x[3] * x[3]); }
                    ss += __shfl_xor(ss, 16); ss += __shfl_xor(ss, 32);
                    const float r = rsqrtf(ss * (1.f / 64.f) + NORM_EPS);
#pragma unroll
                    for (int bj = 0; bj < 2; ++bj)
#pragma unroll
                        for (int n = 0; n < 2; ++n) v[bj][n] = v[bj][n] * r * gv[bj][n];
                } else if (TYPE == 3) {
#pragma unroll
                    for (int bj = 0; bj < 2; ++bj)
#pragma unroll
                        for (int n = 0; n < 2; ++n)
#pragma unroll
                            for (int e = 0; e < 4; ++e) { const float x = v[bj][n][e]; v[bj][n][e] = x * __builtin_amdgcn_rcpf(1.f + __builtin_amdgcn_exp2f(-1.4426950408889634f * x)); }
                }
                if ((TYPE == 1 || TYPE == 2) && row >= SEQ_ - keep) {
                    float* op;
                    if (row < SEQ_) op = o_p + ((size_t)(row - (SEQ_ - keep)) * nkv + head) * 64 + dcol;
                    else { const int r_ = row - SEQ_; op = o_s + (((size_t)(r_ >> 6) * keep + (keep - 64) + (r_ & 63)) * nkv + head) * 64 + dcol; }
#pragma unroll
                    for (int bj = 0; bj < 2; ++bj) { *(f32x4*)(op + 32 * bj) = v[bj][0]; *(f32x4*)(op + 32 * bj + 4) = v[bj][1]; }
                }
#pragma unroll
                for (int bj = 0; bj < 2; ++bj) { u32x4 w; w.x = cvt_pk_bf16(v[bj][0][0], v[bj][0][1]); w.y = cvt_pk_bf16(v[bj][0][2], v[bj][0][3]); w.z = cvt_pk_bf16(v[bj][1][0], v[bj][1][1]); w.w = cvt_pk_bf16(v[bj][1][2], v[bj][1][3]);
                    st16_wt(dst + (size_t)row * ld + 32 * bj, w); }
            }
    }
    __device__ __forceinline__ void operator()(const f32x4 (&acc)[2][2][4][2], const Unit& u, int wr, int wc, int fr, int fq) const {
        int type, head;
        if (layer == 0) { if (u.pn < 4) { type = 0; head = 4 * u.pn + wc; } else if (u.pn == 4) { type = wc < 2 ? 1 : 2; head = wc & 1; } else { type = 3; head = 4 * (u.pn - 5) + wc; } }
        else { type = u.pn >> 2; head = 4 * (u.pn & 3) + wc; }
        const int row0 = u.pm * BM + wr * 64 + fr, rl0 = wr * 64 + fr, dcol = 8 * fq, co = head * 64 + dcol;
        if (slab) {
            const int t = threadIdx.x;
            if (t < BM) { const f32x4* sp = (const f32x4*)(slab + (size_t)(u.pm * BM + t) * 16); const f32x4 a = sp[0], b = sp[1], c = sp[2], d = sp[3];
                const f32x4 s = (a + b) + (c + d); rstd_lds[t] = rsqrtf(((s[0] + s[1]) + (s[2] + s[3])) * (1.f / 1024.f) + NORM_EPS); }
            asm volatile("s_waitcnt lgkmcnt(0)\n\ts_barrier" ::: "memory");
        }
        if (type == 0) tile<0>(acc, row0, rl0, dcol, fq, Q + co, 1024, qg, c2, nullptr, nullptr, head);
        else if (type == 1) tile<1>(acc, row0, rl0, dcol, fq, Kb + co, kvw, kg, 1.f, okp, oks, head);
        else if (type == 2) tile<2>(acc, row0, rl0, dcol, fq, Vb + co, kvw, nullptr, 1.f, ovp, ovs, head);
        else tile<3>(acc, row0, rl0, dcol, fq, G + co, 1024, nullptr, 1.f, nullptr, nullptr, head);
    }
};
struct EpiOut {
    static constexpr bool PERM = true, AFTER_DRAIN = false;
    int layer;
    const float *base_p, *base_s;
    bf16_t* yb;
    float* out;
    float* slab;
    __device__ __forceinline__ void operator()(const f32x4 (&acc)[2][2][4][2], const Unit& u, int wr, int wc, int fr, int fq) const {
        const int row0 = u.pm * BM + wr * 64 + fr, col0 = u.pn * BM + wc * 32 + 8 * fq;
        if (layer == 0) {
#pragma unroll
            for (int ai = 0; ai < 2; ++ai) {
                f32x4 b[4][2][2];
#pragma unroll
                for (int m = 0; m < 4; ++m) { const int row = row0 + ai * HALF + m * 16;
                    const float* bp = (row < SEQ_ ? base_p + (size_t)row * 1024 : base_s + (size_t)(row - SEQ_) * 1024) + col0;
#pragma unroll
                    for (int bj = 0; bj < 2; ++bj) { b[m][bj][0] = __builtin_nontemporal_load((const f32x4*)(bp + bj * HALF)); b[m][bj][1] = __builtin_nontemporal_load((const f32x4*)(bp + bj * HALF + 4)); } }
#pragma unroll
                for (int m = 0; m < 4; ++m) { const int row = row0 + ai * HALF + m * 16; float ss = 0.f;
#pragma unroll
                    for (int bj = 0; bj < 2; ++bj) { const f32x4 y0 = acc[ai][bj][m][0] + b[m][bj][0], y1 = acc[ai][bj][m][1] + b[m][bj][1];
                        ss += ((y0[0] * y0[0] + y0[1] * y0[1]) + (y0[2] * y0[2] + y0[3] * y0[3])) + ((y1[0] * y1[0] + y1[1] * y1[1]) + (y1[2] * y1[2] + y1[3] * y1[3]));
                        u32x4 w; w.x = cvt_pk_bf16(y0[0], y0[1]); w.y = cvt_pk_bf16(y0[2], y0[3]); w.z = cvt_pk_bf16(y1[0], y1[1]); w.w = cvt_pk_bf16(y1[2], y1[3]);
                        *(u32x4*)(yb + (size_t)row * 1024 + col0 + bj * HALF) = w; }
                    ss += __shfl_xor(ss, 16); ss += __shfl_xor(ss, 32); if (fq == 0) slab[(size_t)row * 16 + 4 * u.pn + wc] = ss; }
            }
        } else {
#pragma unroll
            for (int ai = 0; ai < 2; ++ai) {
                u32x4 b[4][2];
#pragma unroll
                for (int m = 0; m < 4; ++m) { const int row = row0 + ai * HALF + m * 16;
#pragma unroll
                    for (int bj = 0; bj < 2; ++bj) b[m][bj] = *(const u32x4*)(yb + (size_t)row * 1024 + col0 + bj * HALF); }
#pragma unroll
                for (int m = 0; m < 4; ++m) { const int row = row0 + ai * HALF + m * 16; float* op = out + (size_t)row * 1024 + col0;
#pragma unroll
                    for (int bj = 0; bj < 2; ++bj) { const u32x4 w = b[m][bj];
                        const f32x4 r0 = {__uint_as_float(w.x << 16), __uint_as_float(w.x & 0xffff0000u), __uint_as_float(w.y << 16), __uint_as_float(w.y & 0xffff0000u)};
                        const f32x4 r1 = {__uint_as_float(w.z << 16), __uint_as_float(w.z & 0xffff0000u), __uint_as_float(w.w << 16), __uint_as_float(w.w & 0xffff0000u)};
                        *(f32x4*)(op + bj * HALF) = acc[ai][bj][m][0] + r0; *(f32x4*)(op + bj * HALF + 4) = acc[ai][bj][m][1] + r1; } }
            }
        }
    }
};
template <class Epi, class Sched, bool ALIGN_EPI = false, bool SP2 = false>
__device__ __forceinline__ void gemm_phase(PG8_LAS unsigned char* lds, const Gemm g, const Sched& S, const Epi& E, unsigned long long* tepi = nullptr) {
    int tid_ = threadIdx.x; asm volatile("" : "+v"(tid_));
    const int tid = tid_, wid = __builtin_amdgcn_readfirstlane(tid >> 6), lane = tid & 63, wr = wid >> 2, wc = wid & 3, fr = lane & 15, fq = lane >> 4;
    const int K = g.K, nt = K / BK;
    unsigned voffA[2], voffB[2];
#pragma unroll
    for (int i = 0; i < 2; ++i) { int R, C; stage_rc(tid * 16 + i * 8192, R, C); const int Rb = Epi::PERM ? ((R & ~31) + perm32(R & 31)) : R;
        voffA[i] = (unsigned)(R * K + C) * 2u; voffB[i] = (unsigned)(Rb * K + C) * 2u; }
    const size_t kstep = (size_t)(BK * 2);
    const size_t hstep = (size_t)HALF * K * 2;
    const size_t tstep = 2 * hstep;
    const unsigned ldsw = (unsigned)wid * 1024u;
    const int aoff = lds_byte(wr * 64 + fr, fq * 8), boff = lds_byte(wc * 32 + fr, fq * 8);
#define PG8_SA(b, h) (((b) * 2 + (h)) * HTB)
#define PG8_SB(b, h) ((4 + (b) * 2 + (h)) * HTB)
#define PG8_STAGE(bufoff, gbase, voff) do { _Pragma("unroll") for (int _i = 0; _i < 2; ++_i) \
        __builtin_amdgcn_global_load_lds((const unsigned*)((const char*)(gbase) + (voff)[_i]), (PG8_LAS unsigned*)(lds + (bufoff) + ldsw + _i * 8192), 16, 0, 0); } while (0)
#define PG8_LDA(dst, b, h) do { _Pragma("unroll") for (int m = 0; m < 4; ++m) _Pragma("unroll") for (int k = 0; k < 2; ++k) dst[m][k] = *(const PG8_LAS bf16x8*)(lds + PG8_SA(b, h) + aoff + m * 2048 + k * 1024); } while (0)
#define PG8_LDB(dst, b, h) do { _Pragma("unroll") for (int n = 0; n < 2; ++n) _Pragma("unroll") for (int k = 0; k < 2; ++k) dst[n][k] = *(const PG8_LAS bf16x8*)(lds + PG8_SB(b, h) + boff + n * 2048 + k * 1024); } while (0)
#define PG8_MMA(ai, bj, At, Bt) do { __builtin_amdgcn_s_setprio(1); _Pragma("unroll") for (int m = 0; m < 4; ++m) _Pragma("unroll") for (int n = 0; n < 2; ++n) _Pragma("unroll") for (int k = 0; k < 2; ++k) \
        acc[ai][bj][m][n] = __builtin_amdgcn_mfma_f32_16x16x32_bf16(Bt[n][k], At[m][k], acc[ai][bj][m][n], 0, 0, 0); __builtin_amdgcn_s_setprio(0); } while (0)
#define PG8_WAIT_V(n) asm volatile("s_waitcnt vmcnt(" #n ")" ::: "memory")
#define PG8_WAIT_L(n) asm volatile("s_waitcnt lgkmcnt(" #n ")" ::: "memory")
#define PG8_BAR __builtin_amdgcn_s_barrier()
#define PG8_SCHED __builtin_amdgcn_sched_barrier(0)
    Unit cur, nxt; int ui = 0;
    if (!S.next(0, cur)) return;
    f32x4 acc[2][2][4][2];
#pragma unroll
    for (int a = 0; a < 2; ++a)
#pragma unroll
        for (int b = 0; b < 2; ++b)
#pragma unroll
            for (int m = 0; m < 4; ++m)
#pragma unroll
                for (int n = 0; n < 2; ++n) acc[a][b][m][n] = (f32x4){0.f, 0.f, 0.f, 0.f};
    bf16x8 At[4][2], B0[2][2], B1[2][2];
    const char* cA = (const char*)g.A + (size_t)cur.pm * tstep; const char* cB = (const char*)g.Bt + (size_t)cur.pn * tstep;
    S.a_ready(cur);
    if constexpr (SP2) {
        PG8_STAGE(PG8_SB(0, 0), cB, voffB); PG8_STAGE(PG8_SB(0, 1), cB + hstep, voffB); PG8_STAGE(PG8_SA(0, 0), cA, voffA); PG8_STAGE(PG8_SA(0, 1), cA + hstep, voffA);
        if (wr == 1) PG8_BAR;
        PG8_WAIT_V(2); PG8_BAR;
        PG8_STAGE(PG8_SB(1, 0), cB + kstep, voffB); PG8_STAGE(PG8_SA(1, 0), cA + kstep, voffA); PG8_STAGE(PG8_SB(1, 1), cB + hstep + kstep, voffB);
        PG8_WAIT_V(6); PG8_BAR;
    } else {
        PG8_STAGE(PG8_SB(0, 0), cB, voffB); PG8_STAGE(PG8_SA(0, 0), cA, voffA); PG8_STAGE(PG8_SB(0, 1), cB + hstep, voffB); PG8_STAGE(PG8_SA(0, 1), cA + hstep, voffA);
        if (wr == 1) PG8_BAR;
        PG8_WAIT_V(4); PG8_BAR;
        PG8_STAGE(PG8_SB(1, 0), cB + kstep, voffB); PG8_STAGE(PG8_SA(1, 0), cA + kstep, voffA); PG8_STAGE(PG8_SB(1, 1), cB + hstep + kstep, voffB);
        PG8_WAIT_V(6); PG8_BAR;
    }
    for (;;) {
        const bool has_next = S.next(ui + 1, nxt);
        const char* nA = has_next ? (const char*)g.A + (size_t)nxt.pm * tstep : cA; const char* nB = has_next ? (const char*)g.Bt + (size_t)nxt.pn * tstep : cB;
        for (int t = 0; t < nt; t += 2) {
            const bool last = (t == nt - 2);
            const char* a1 = cA + (size_t)(t + 1) * kstep;
            const char* a2 = last ? nA : cA + (size_t)(t + 2) * kstep; const char* b2 = last ? nB : cB + (size_t)(t + 2) * kstep;
            const char* a3 = a2 + kstep; const char* b3 = b2 + kstep;
            if (last && has_next) S.a_ready(nxt);
            if constexpr (SP2) {
            PG8_LDB(B0, 0, 0); PG8_LDB(B1, 0, 1); PG8_SCHED; PG8_LDA(At, 0, 0); PG8_STAGE(PG8_SA(1, 1), a1 + hstep, voffA);
            PG8_WAIT_V(8); PG8_WAIT_L(0); PG8_BAR; PG8_MMA(0, 0, At, B0); PG8_MMA(0, 1, At, B1); PG8_BAR; PG8_SCHED;
            PG8_LDA(At, 0, 1); PG8_STAGE(PG8_SB(0, 0), b2, voffB); PG8_STAGE(PG8_SB(0, 1), b2 + hstep, voffB); PG8_STAGE(PG8_SA(0, 0), a2, voffA);
            PG8_WAIT_V(8); PG8_WAIT_L(0); PG8_BAR; PG8_MMA(1, 0, At, B0); PG8_MMA(1, 1, At, B1); PG8_BAR; PG8_SCHED;
            PG8_LDB(B0, 1, 0); PG8_LDB(B1, 1, 1); PG8_SCHED; PG8_LDA(At, 1, 0); PG8_STAGE(PG8_SA(0, 1), a2 + hstep, voffA);
            PG8_WAIT_V(8); PG8_WAIT_L(0); PG8_BAR; PG8_MMA(0, 0, At, B0); PG8_MMA(0, 1, At, B1); PG8_BAR; PG8_SCHED;
            PG8_LDA(At, 1, 1); PG8_STAGE(PG8_SB(1, 0), b3, voffB); PG8_STAGE(PG8_SB(1, 1), b3 + hstep, voffB); PG8_STAGE(PG8_SA(1, 0), a3, voffA);
            PG8_WAIT_V(8); PG8_WAIT_L(0); PG8_BAR; PG8_MMA(1, 0, At, B0); PG8_MMA(1, 1, At, B1); PG8_BAR; PG8_SCHED;
            } else {
            PG8_LDB(B0, 0, 0); PG8_SCHED; PG8_LDA(At, 0, 0); PG8_STAGE(PG8_SA(1, 1), a1 + hstep, voffA);
            PG8_WAIT_L(8); PG8_BAR; PG8_WAIT_L(0); PG8_MMA(0, 0, At, B0); PG8_BAR; PG8_SCHED;
            PG8_LDB(B1, 0, 1); PG8_STAGE(PG8_SB(0, 0), b2, voffB);
            PG8_BAR; PG8_WAIT_L(0); PG8_MMA(0, 1, At, B1); PG8_BAR;
            PG8_LDA(At, 0, 1); PG8_STAGE(PG8_SA(0, 0), a2, voffA);
            PG8_BAR; PG8_WAIT_L(0); PG8_MMA(1, 0, At, B0); PG8_BAR; PG8_SCHED;
            PG8_STAGE(PG8_SB(0, 1), b2 + hstep, voffB);
            PG8_WAIT_V(6); PG8_BAR; PG8_MMA(1, 1, At, B1); PG8_BAR;
            PG8_LDB(B0, 1, 0); PG8_SCHED; PG8_LDA(At, 1, 0); PG8_STAGE(PG8_SA(0, 1), a2 + hstep, voffA);
            PG8_WAIT_L(8); PG8_BAR; PG8_WAIT_L(0); PG8_MMA(0, 0, At, B0); PG8_BAR; PG8_SCHED;
            PG8_LDB(B1, 1, 1); PG8_STAGE(PG8_SB(1, 0), b3, voffB);
            PG8_BAR; PG8_WAIT_L(0); PG8_MMA(0, 1, At, B1); PG8_BAR;
            PG8_LDA(At, 1, 1); PG8_STAGE(PG8_SA(1, 0), a3, voffA);
            PG8_BAR; PG8_WAIT_L(0); PG8_MMA(1, 0, At, B0); PG8_BAR; PG8_SCHED;
            PG8_STAGE(PG8_SB(1, 1), b3 + hstep, voffB);
            PG8_WAIT_V(6); PG8_BAR; PG8_MMA(1, 1, At, B1); PG8_BAR;
            }
        }
        if constexpr (ALIGN_EPI) { if (wr == 0) PG8_BAR; }
        if constexpr (!Epi::AFTER_DRAIN) { unsigned long long te0_ = 0; if (tepi) te0_ = __builtin_amdgcn_s_memrealtime(); E(acc, cur, wr, wc, fr, fq); S.done(cur); if (tepi) *tepi += __builtin_amdgcn_s_memrealtime() - te0_; }
        if (!has_next) break;
#pragma unroll
        for (int a = 0; a < 2; ++a)
#pragma unroll
            for (int b = 0; b < 2; ++b)
#pragma unroll
                for (int m = 0; m < 4; ++m)
#pragma unroll
                    for (int n = 0; n < 2; ++n) acc[a][b][m][n] = (f32x4){0.f, 0.f, 0.f, 0.f};
        cur = nxt; cA = nA; cB = nB; ++ui;
        if constexpr (ALIGN_EPI) { if (wr == 1) PG8_BAR; }
    }
    PG8_WAIT_V(0);
    if constexpr (!ALIGN_EPI) { if (wr == 0) PG8_BAR; }
    PG8_BAR;
    if constexpr (Epi::AFTER_DRAIN) { E.fused(acc, cur, wr, wc, fr, fq, lds, wid, lane); S.done(cur); }
#undef PG8_SA
#undef PG8_SB
#undef PG8_STAGE
#undef PG8_LDA
#undef PG8_LDB
#undef PG8_MMA
#undef PG8_WAIT_V
#undef PG8_WAIT_L
#undef PG8_BAR
#undef PG8_SCHED
}
}
#define GAS __attribute__((address_space(1)))
#define LAS __attribute__((address_space(3)))
typedef unsigned short bf16;
typedef unsigned v4u __attribute__((ext_vector_type(4)));
typedef float f32x4 __attribute__((ext_vector_type(4)));
typedef short bf16x8 __attribute__((ext_vector_type(8)));
typedef GAS unsigned gu32;
typedef GAS unsigned long long gu64;
#define RLX_AGENT __ATOMIC_RELAXED, __HIP_MEMORY_SCOPE_AGENT
#define LDS_WAIT() asm volatile("s_waitcnt lgkmcnt(0)" ::: "memory")
#define VM_WAIT() asm volatile("s_waitcnt vmcnt(0)" ::: "memory")
__device__ __forceinline__ unsigned long long rt() { return __builtin_amdgcn_s_memrealtime(); }
__device__ __forceinline__ unsigned f2bf(float f) { unsigned u = __builtin_bit_cast(unsigned, f); return (u + 0x7fffu + ((u >> 16) & 1u)) >> 16; }
__device__ __forceinline__ unsigned pk2(float lo, float hi) { return f2bf(lo) | (f2bf(hi) << 16); }

#define XB_TMO      128
#define XB_XCNT(j)  (256  + 64 * (j))
#define XB_XSUB(j)  (1280 + 64 * (j))
#define XB_XGEN(j)  (2304 + 64 * (j))
#define XB_TOP      3328
#define XB_TOPGEN   3392
#define XCD_BAR_WORDS 3456
#define XB_SPIN_CAP (1u << 18)

__device__ __forceinline__ unsigned xb_ld(unsigned* p)              { return __hip_atomic_load(p, __ATOMIC_RELAXED, __HIP_MEMORY_SCOPE_AGENT); }
__device__ __forceinline__ unsigned xb_add(unsigned* p, unsigned v) { return __hip_atomic_fetch_add(p, v, __ATOMIC_RELAXED, __HIP_MEMORY_SCOPE_AGENT); }
__device__ __forceinline__ unsigned xb_xcc_id() { return (unsigned)__builtin_amdgcn_s_getreg((3 << 11) | 20) & 0xFu; }
#define XB_SPIN(cond, bar) do { unsigned _sp = 0; while (cond) { __builtin_amdgcn_s_sleep(1); \
    if ((++_sp & 255u) == 0u) { if (xb_ld(&(bar)[XB_TMO])) break; if (_sp > XB_SPIN_CAP) { atomicAdd(&(bar)[XB_TMO], 1u); break; } } } } while (0)

struct XcdBarrier {
    unsigned* bar; unsigned x;
    volatile LAS unsigned* st;
};

__device__ __forceinline__ XcdBarrier xcd_barrier_post(unsigned* bar, volatile LAS unsigned* st) {
    XcdBarrier b; b.bar = bar; b.x = xb_xcc_id(); b.st = st;
    if (threadIdx.x == 0) (void)xb_add(&bar[XB_XCNT(b.x)], 1u);
    return b;
}
__device__ __forceinline__ void xcd_barrier_complete(unsigned* bar, unsigned x, unsigned& nloc, unsigned& nx) {
    const unsigned G = gridDim.x * gridDim.y * gridDim.z;
    unsigned sum, cnt, mine, sp = 0u;
    for (;;) {
        sum = 0u; cnt = 0u; mine = 0u;
#pragma unroll
        for (unsigned j = 0; j < 16; ++j) { const unsigned c = xb_ld(&bar[XB_XCNT(j)]); sum += c; cnt += (c > 0u) ? 1u : 0u; mine = (j == x) ? c : mine; }
        if (sum == G) break;
        __builtin_amdgcn_s_sleep(1);
        if ((++sp & 255u) == 0u) { if (xb_ld(&bar[XB_TMO])) break; if (sp > XB_SPIN_CAP) { atomicAdd(&bar[XB_TMO], 1u); break; } }
    }
    nloc = mine > 0u ? mine : 1u; nx = cnt > 0u ? cnt : 1u;
}

__device__ __forceinline__ void xcd_barrier(const XcdBarrier& b) {
    asm volatile("s_waitcnt vmcnt(0)" ::: "memory");
    __syncthreads();
    if (threadIdx.x == 0) {
        unsigned* bar = b.bar;
        __builtin_amdgcn_s_waitcnt(0);
        unsigned nloc = b.st[0], nx = b.st[1];
        if (nloc == 0u) { xcd_barrier_complete(bar, b.x, nloc, nx); b.st[0] = nloc; b.st[1] = nx; }
        const unsigned old = xb_add(&bar[XB_XSUB(b.x)], 1u);
        const unsigned gen = old / nloc;
        if (old + 1u == (gen + 1u) * nloc) {
            __builtin_amdgcn_fence(__ATOMIC_RELEASE, "agent");
            asm volatile("s_waitcnt vmcnt(0)" ::: "memory");
            const unsigned og = xb_add(&bar[XB_TOP], 1u);
            const unsigned tg = og / nx;
            if (og + 1u == (tg + 1u) * nx) xb_add(&bar[XB_TOPGEN], 1u);
            else XB_SPIN(xb_ld(&bar[XB_TOPGEN]) == tg, bar);
            __builtin_amdgcn_fence(__ATOMIC_ACQUIRE, "agent");
            xb_add(&bar[XB_XGEN(b.x)], 1u);
            asm volatile("s_waitcnt vmcnt(0)" ::: "memory");
        } else {
            XB_SPIN(xb_ld(&bar[XB_XGEN(b.x)]) == gen, bar);
            __builtin_amdgcn_fence(__ATOMIC_ACQUIRE, "agent");
            asm volatile("s_waitcnt vmcnt(0)" ::: "memory");
        }
    }
    __syncthreads();
}
constexpr int NWAVES = 8;
#ifndef WGM_P1
#define WGM_P1 8
#endif
#ifndef WGM_P4
#define WGM_P4 4
#endif
constexpr int DM = 1024, SEQ = 16384, NB = 16, MS = NB * 64, M = SEQ + MS;
constexpr int NIN_A = 2304, NIN_B = 4096;
constexpr float EPS = 1e-6f, LOG2E = 1.4426950408889634f, C2 = 0.125f * 1.4426950408889634f;
constexpr size_t O_Y = 0, O_KAP = 17825792, O_VAP = 17842176, O_KBP = 17858560, O_VBP = 18382848, O_KAS = 18907136, O_VAS = 19169280, O_KBS = 19431424, O_VBS = 27820032, O_END = 36208640;
constexpr size_t KiB = 1024, MiB = 1u << 20;
constexpr size_t WS_CTL = 0, CTL_ZERO_BYTES = 256 * KiB;
constexpr size_t WS_WINA = 256 * KiB;
constexpr size_t WS_WOUTA = WS_WINA + (size_t)NIN_A * DM * 2;
constexpr size_t WS_WINB = WS_WOUTA + (size_t)DM * DM * 2;
constexpr size_t WS_WOUTB = WS_WINB + (size_t)NIN_B * DM * 2;
constexpr size_t WS_SLAB = WS_WOUTB + (size_t)DM * DM * 2;
constexpr size_t ACT = (size_t)M * DM * 2;
constexpr size_t WS_XN = 18 * MiB;
constexpr size_t WS_QA = WS_XN + ACT;
constexpr size_t WS_GA = WS_QA + ACT, WS_KA = WS_GA + ACT, WS_VA = WS_KA + (size_t)M * 128 * 2;
constexpr size_t WS_QB = WS_GA;
constexpr size_t WS_KB = WS_QB + ACT, WS_VB = WS_KB + ACT, WS_GB = WS_VB + ACT;
constexpr size_t WS_CKA = WS_GB + ACT, WS_CVA = WS_CKA + (size_t)NB * 128 * 128 * 2, WS_CKB = WS_CVA + (size_t)NB * 128 * 128 * 2, WS_CVB = WS_CKB + (size_t)NB * 512 * 1024 * 2;
constexpr size_t WS_END = WS_CVB + (size_t)NB * 512 * 1024 * 2;
static_assert(WS_SLAB + (size_t)M * 16 * 4 <= WS_XN && WS_VA + (size_t)M * 128 * 2 <= WS_CKA && WS_QB >= WS_QA + ACT && WS_END <= 256 * MiB, "d_ws map");
constexpr int CW_KMAX_A = 64, CW_KMAX_B = 128;
constexpr int CW_BAR = 4096;
constexpr int RING_OFF = 0, RING_BYTES = 131072;
constexpr int PHASE_BYTES = 159744;
constexpr int LDSCTL_OFF = PHASE_BYTES, MISC_OFF = LDSCTL_OFF + 320;
constexpr int LDS_BYTES = 163840;
constexpr int AT_NS = 4;
constexpr int AT_SLOT = 0, AT_SLOTB = 16384  , AT_TAB = AT_NS * AT_SLOTB, AT_TABB = 49152, AT_WSF = AT_TAB + AT_TABB, AT_OST = AT_WSF + NWAVES * 256, AT_END = AT_OST + NWAVES * 4096;
static_assert(AT_END <= PHASE_BYTES && MISC_OFF + 128 <= LDS_BYTES, "attention LDS map");

#ifndef PROBE_SEG
#define PROBE_SEG 0
#endif
#ifndef PROBE_LAYER
#define PROBE_LAYER 1
#endif
#if PROBE_SEG
#define KSEG_BEGIN(s) unsigned long long ks_t0_##s = 0; if (PROBE_SEG == (s)) ks_t0_##s = __builtin_amdgcn_s_memrealtime();
#define KSEG_END(s) if (PROBE_SEG == (s)) F.tacc += __builtin_amdgcn_s_memrealtime() - ks_t0_##s;
#define PSEG_BEGIN(s) unsigned long long ps_t0_##s = 0; if (PROBE_SEG == (s) && LAYER == PROBE_LAYER) ps_t0_##s = __builtin_amdgcn_s_memrealtime();
#define PSEG_END(s) if (PROBE_SEG == (s) && LAYER == PROBE_LAYER) F.tacc += __builtin_amdgcn_s_memrealtime() - ps_t0_##s;
#else
#define PSEG_BEGIN(s)
#define PSEG_END(s)
#define KSEG_BEGIN(s)
#define KSEG_END(s)
#endif
struct Frame {
    unsigned long long tacc;
    LAS unsigned char* lds;
    volatile LAS unsigned* MISC;
    gu32* ctl;
    int tid, lane, wave;
    int vcu, G;
};
struct Args { const float* in[19]; float* out; unsigned char* ws; };

__device__ __forceinline__ float wave_sum(float v) {
#pragma unroll
    for (int o = 1; o < 64; o <<= 1) v += __shfl_xor(v, o);
    return v;
}
__device__ __forceinline__ float wave_max(float v) {
#pragma unroll
    for (int o = 1; o < 64; o <<= 1) v = fmaxf(v, __shfl_xor(v, o));
    return v;
}
__device__ __forceinline__ int phys_col(int c) { return (c & ~255) | (((c >> 5) & 1) << 7) | (((c >> 6) & 3) << 5) | (c & 31); }

__device__ __forceinline__ void p0_transpose_item(const float* W, int K, int N, bf16* WT, bool permute, const float* gain, LAS float* scr, int item, int lane) {
    const int nblk = N / 32, kb = item / nblk, nb = item % nblk, k0 = 64 * kb, n0 = 32 * nb;
    const float* src = W + (size_t)(k0 + (lane >> 5)) * N + n0 + (lane & 31);
    float w[32];
#pragma unroll
    for (int i = 0; i < 32; ++i) w[i] = __builtin_nontemporal_load(src + (size_t)(2 * i) * N);
    if (gain) {
#pragma unroll
        for (int i = 0; i < 32; ++i) w[i] *= gain[k0 + 2 * i + (lane >> 5)]; }
#pragma unroll
    for (int i = 0; i < 32; ++i) scr[(2 * i + (lane >> 5)) * 33 + (lane & 31)] = w[i];
    LDS_WAIT(); asm volatile("" ::: "memory");
    const int c = lane & 7;
    const int r0 = permute ? phys_col(n0) : n0;
#pragma unroll
    for (int j = 0; j < 4; ++j) { const int n = (lane >> 3) + 8 * j; const LAS float* s = scr + (8 * c) * 33 + n;
        v4u o; o.x = pk2(s[0 * 33], s[1 * 33]); o.y = pk2(s[2 * 33], s[3 * 33]); o.z = pk2(s[4 * 33], s[5 * 33]); o.w = pk2(s[6 * 33], s[7 * 33]);
        *(GAS v4u*)(WT + (size_t)(r0 + n) * K + k0 + 8 * c) = o; }
    LDS_WAIT(); asm volatile("" ::: "memory");
}
struct Row4 { f32x4 v[4]; };
__device__ __forceinline__ void row_load(Row4& r, const float* p, int lane) {
#pragma unroll
    for (int j = 0; j < 4; ++j) r.v[j] = __builtin_nontemporal_load((const GAS f32x4*)p + lane + 64 * j); }
__device__ __forceinline__ void row_store_bf16(const Row4& r, bf16* o, int lane) {
#pragma unroll
    for (int j = 0; j < 4; ++j) ((GAS unsigned long long*)o)[lane + 64 * j] = (unsigned long long)pk2(r.v[j].x, r.v[j].y) | ((unsigned long long)pk2(r.v[j].z, r.v[j].w) << 32); }
__device__ __forceinline__ void row_store_f32(const Row4& r, float* o, int lane) {
#pragma unroll
    for (int j = 0; j < 4; ++j) __builtin_nontemporal_store(r.v[j], (GAS f32x4*)o + lane + 64 * j); }
__device__ __forceinline__ const float* x_row(const Args& a, int m) { return m < SEQ ? a.in[0] + (size_t)m * DM : a.in[1] + (size_t)(m - SEQ) * DM; }
__device__ __forceinline__ void rms_finish(Row4& r, const Row4& g, bf16* o, int lane) {
    float s = 0.f;
#pragma unroll
    for (int j = 0; j < 4; ++j) s += (r.v[j].x * r.v[j].x + r.v[j].y * r.v[j].y) + (r.v[j].z * r.v[j].z + r.v[j].w * r.v[j].w);
    const float rs = rsqrtf(wave_sum(s) * (1.f / DM) + EPS);
#pragma unroll
    for (int j = 0; j < 4; ++j) r.v[j] = r.v[j] * rs * g.v[j];
    row_store_bf16(r, o, lane);
}
__device__ __forceinline__ float row_maxnorm2(const Row4& r) {
    float qm = 0.f;
#pragma unroll
    for (int j = 0; j < 4; ++j) { float q = (r.v[j].x * r.v[j].x + r.v[j].y * r.v[j].y) + (r.v[j].z * r.v[j].z + r.v[j].w * r.v[j].w);
#pragma unroll
        for (int d = 1; d < 16; d <<= 1) q += __shfl_xor(q, d);
        qm = fmaxf(qm, q); }
    return qm;
}
__device__ __forceinline__ void cache_rows_a(const float* srck, const float* srcv, bf16* dbk, bf16* dbv, float* dok, float* dov, int row, gu32* kmax, int lane) {
    constexpr int L = 128, W = 128;
    const int b = row / L, j = row % L;
    const size_t so = (size_t)row * W, oo = ((size_t)b * L + (j - 64)) * W;
    const float k0 = srck[so + 2 * lane], k1 = srck[so + 2 * lane + 1], v0 = srcv[so + 2 * lane], v1 = srcv[so + 2 * lane + 1];
    ((GAS unsigned*)(dbk + so))[lane] = pk2(k0, k1); ((GAS unsigned*)(dbv + so))[lane] = pk2(v0, v1);
    if (j >= 64) { dok[oo + 2 * lane] = k0; dok[oo + 2 * lane + 1] = k1; dov[oo + 2 * lane] = v0; dov[oo + 2 * lane + 1] = v1; }
    float q = k0 * k0 + k1 * k1;
#pragma unroll
    for (int d = 1; d < 32; d <<= 1) q += __shfl_xor(q, d);
    q = fmaxf(q, __shfl_xor(q, 32));
    if (lane == 0) __hip_atomic_fetch_max(kmax, __float_as_uint(q), __ATOMIC_RELAXED, __HIP_MEMORY_SCOPE_AGENT);
}
__device__ __forceinline__ void p0_prologue(Frame& F, const Args& a) {
    LAS float* scr = (LAS float*)(F.lds + RING_OFF + F.wave * 16384);
    const int gw = F.vcu * NWAVES + F.wave, NGW = F.G * NWAVES, lane = F.lane;
    unsigned char* ws = a.ws;
    bf16* XN = (bf16*)(ws + WS_XN);
    {
        Row4 g, a0, a1, b0, b1; row_load(g, a.in[7], lane);
        const int S = NGW;
        int m = gw;
#define XLOAD(R0, R1, mm) do { if ((mm) < M) row_load(R0, x_row(a, (mm)), lane); if ((mm) + S < M) row_load(R1, x_row(a, (mm) + S), lane); } while (0)
#define XFIN(R0, R1, mm) do { if ((mm) < M) rms_finish(R0, g, XN + (size_t)(mm) * DM, lane); if ((mm) + S < M) rms_finish(R1, g, XN + (size_t)((mm) + S) * DM, lane); } while (0)
        XLOAD(a0, a1, m);
        for (; m < M; m += 4 * S) {
            XLOAD(b0, b1, m + 2 * S);
            XFIN(a0, a1, m);
            XLOAD(a0, a1, m + 4 * S);
            XFIN(b0, b1, m + 2 * S);
        }
#undef XLOAD
#undef XFIN
    }
    constexpr int I_INA = (DM / 64) * (NIN_A / 32);
    for (int it = gw; it < I_INA; it += NGW) p0_transpose_item(a.in[8], DM, NIN_A, (bf16*)(ws + WS_WINA), true, nullptr, scr, it, lane);
    for (int r = gw; r < NB * 128; r += NGW)
        cache_rows_a(a.in[2], a.in[3], (bf16*)(ws + WS_CKA), (bf16*)(ws + WS_CVA), a.out + O_KAS, a.out + O_VAS, r, F.ctl + CW_KMAX_A, lane);
}
__device__ __forceinline__ void side_weights(Frame& F, const Args& a, int w, int nw) {
    LAS float* scr = (LAS float*)(F.lds + RING_OFF + F.wave * 16384);
    unsigned char* ws = a.ws;
    constexpr int I_O = (DM / 64) * (DM / 32), I_INB = (DM / 64) * (NIN_B / 32);
    for (int it = w; it < I_O + I_INB + I_O; it += nw) {
        int r = it;
        if (r < I_O) { p0_transpose_item(a.in[12], DM, DM, (bf16*)(ws + WS_WOUTA), false, nullptr, scr, r, F.lane); continue; } r -= I_O;
        if (r < I_INB) { p0_transpose_item(a.in[14], DM, NIN_B, (bf16*)(ws + WS_WINB), true, a.in[13], scr, r, F.lane); continue; } r -= I_INB;
        p0_transpose_item(a.in[18], DM, DM, (bf16*)(ws + WS_WOUTB), false, nullptr, scr, r, F.lane);
    }
}
__device__ __forceinline__ void side_cache_b_conv(Frame& F, const Args& a, int w, int nw, int r_lo, int r_hi) {
    unsigned char* ws = a.ws; const int lane = F.lane;
    const float* srck = a.in[4]; const float* srcv = a.in[5];
    bf16* dbk = (bf16*)(ws + WS_CKB); bf16* dbv = (bf16*)(ws + WS_CVB); float* dok = a.out + O_KBS; float* dov = a.out + O_VBS;
    const int NR = r_hi;
    Row4 ka, va, kb, vb; float qm = 0.f;
#define CB_LOAD(K_, V_, r) do { row_load(K_, srck + (size_t)(r) * DM, lane); row_load(V_, srcv + (size_t)(r) * DM, lane); } while (0)
#define CB_FIN(K_, V_, r) do { const size_t so_ = (size_t)(r) * DM; row_store_bf16(K_, dbk + so_, lane); row_store_bf16(V_, dbv + so_, lane); \
        if (((r) & 511) >= 64) { const size_t oo_ = so_ - 64 * DM; row_store_f32(K_, dok + oo_, lane); row_store_f32(V_, dov + oo_, lane); }     \
        qm = fmaxf(qm, row_maxnorm2(K_)); } while (0)
    int r = r_lo + w;
    if (r < NR) CB_LOAD(ka, va, r);
    for (; r < NR; r += 2 * nw) {
        const int r1 = r + nw, r2 = r + 2 * nw;
        if (r1 < NR) CB_LOAD(kb, vb, r1);
        CB_FIN(ka, va, r);
        if (r2 < NR) CB_LOAD(ka, va, r2);
        if (r1 < NR) CB_FIN(kb, vb, r1);
    }
#undef CB_LOAD
#undef CB_FIN
    qm = wave_max(qm);
    if (lane == 0) __hip_atomic_fetch_max(F.ctl + CW_KMAX_B, __float_as_uint(qm), __ATOMIC_RELAXED, __HIP_MEMORY_SCOPE_AGENT);
}
__device__ __forceinline__ void side_cache_b_copy(Frame& F, const Args& a, int w, int nw, int r_lo, int r_hi) {
    const int lane = F.lane;
    const float* srck = a.in[4]; const float* srcv = a.in[5]; float* dok = a.out + O_KBS; float* dov = a.out + O_VBS;
    const int NR = r_hi;
    Row4 ka, va, kb, vb;
#define CP_SRC(r) ((size_t)((r) / 448) * 512 + 64 + (r) % 448)
#define CP_DST(r) ((size_t)((r) / 448) * 512 + (r) % 448)
#define CP_LOAD(K_, V_, r) do { const size_t so_ = CP_SRC(r) * DM; row_load(K_, srck + so_, lane); row_load(V_, srcv + so_, lane); } while (0)
#define CP_FIN(K_, V_, r) do { const size_t oo_ = CP_DST(r) * DM; row_store_f32(K_, dok + oo_, lane); row_store_f32(V_, dov + oo_, lane); } while (0)
    int r = r_lo + w;
    if (r < NR) CP_LOAD(ka, va, r);
    for (; r < NR; r += 2 * nw) {
        const int r1 = r + nw, r2 = r + 2 * nw;
        if (r1 < NR) CP_LOAD(kb, vb, r1);
        CP_FIN(ka, va, r);
        if (r2 < NR) CP_LOAD(ka, va, r2);
        if (r1 < NR) CP_FIN(kb, vb, r1);
    }
#undef CP_SRC
#undef CP_DST
#undef CP_LOAD
#undef CP_FIN
}
template <int LAYER> __device__ __forceinline__ void tail_outproj(LAS unsigned char* lds, const bf16* A, const bf16* Bt, int c, const float* xs, bf16* yb, float* slab, float* out) {
    int tid_ = threadIdx.x; asm volatile("" : "+v"(tid_));
    const int tid = tid_, lane = tid & 63, wid = __builtin_amdgcn_readfirstlane(tid >> 6), fr = lane & 15, fq = lane >> 4;
    const int rb = c >> 4, cb = c & 15, row0 = SEQ + 64 * rb, col0 = 64 * cb;
    const bf16* ap = A + (size_t)(row0 + fr) * DM + 128 * wid + 8 * fq;
    const bf16* bp = Bt + (size_t)(col0 + fr) * DM + 128 * wid + 8 * fq;
    bf16x8 af[4][4], bfr[4][4];
#pragma unroll
    for (int m = 0; m < 4; ++m)
#pragma unroll
        for (int ks = 0; ks < 4; ++ks) { af[m][ks] = *(const GAS bf16x8*)(ap + (size_t)(16 * m) * DM + 32 * ks); bfr[m][ks] = *(const GAS bf16x8*)(bp + (size_t)(16 * m) * DM + 32 * ks); }
    f32x4 acc[4][4];
#pragma unroll
    for (int m = 0; m < 4; ++m)
#pragma unroll
        for (int n = 0; n < 4; ++n) { acc[m][n] = (f32x4){0.f, 0.f, 0.f, 0.f};
#pragma unroll
            for (int ks = 0; ks < 4; ++ks) acc[m][n] = __builtin_amdgcn_mfma_f32_16x16x32_bf16(bfr[n][ks], af[m][ks], acc[m][n], 0, 0, 0); }
    LAS float* part = (LAS float*)lds + wid * 4096;
#pragma unroll
    for (int m = 0; m < 4; ++m)
#pragma unroll
        for (int n = 0; n < 4; ++n) *(LAS f32x4*)(part + (16 * m + fr) * 64 + 16 * n + 4 * fq) = acc[m][n];
    __syncthreads();
    const int r = tid >> 3, c8 = (tid & 7) * 8;
    f32x4 s0 = (f32x4){0.f, 0.f, 0.f, 0.f}, s1 = s0;
#pragma unroll
    for (int w = 0; w < 8; ++w) { const LAS float* p = (const LAS float*)lds + w * 4096 + r * 64 + c8; s0 += *(const LAS f32x4*)p; s1 += *(const LAS f32x4*)(p + 4); }
    const int row = row0 + r;
    if (LAYER == 1) {
        const v4u w = *(const GAS v4u*)(yb + (size_t)row * DM + col0 + c8);
        const f32x4 r0 = {__uint_as_float(w.x << 16), __uint_as_float(w.x & 0xffff0000u), __uint_as_float(w.y << 16), __uint_as_float(w.y & 0xffff0000u)};
        const f32x4 r1 = {__uint_as_float(w.z << 16), __uint_as_float(w.z & 0xffff0000u), __uint_as_float(w.w << 16), __uint_as_float(w.w & 0xffff0000u)};
        float* op = out + (size_t)row * DM + col0 + c8;
        *(GAS f32x4*)op = s0 + r0; *(GAS f32x4*)(op + 4) = s1 + r1;
        __syncthreads();
        return;
    }
    const float* xp = xs + (size_t)(row - SEQ) * DM + col0 + c8;
    const f32x4 y0 = s0 + *(const GAS f32x4*)xp, y1 = s1 + *(const GAS f32x4*)(xp + 4);
    v4u wv; wv.x = pk2(y0[0], y0[1]); wv.y = pk2(y0[2], y0[3]); wv.z = pk2(y1[0], y1[1]); wv.w = pk2(y1[2], y1[3]);
    *(GAS v4u*)(yb + (size_t)row * DM + col0 + c8) = wv;
    float ss = ((y0[0] * y0[0] + y0[1] * y0[1]) + (y0[2] * y0[2] + y0[3] * y0[3])) + ((y1[0] * y1[0] + y1[1] * y1[1]) + (y1[2] * y1[2] + y1[3] * y1[3]));
    ss += __shfl_xor(ss, 1); ss += __shfl_xor(ss, 2); ss += __shfl_xor(ss, 4);
    if ((tid & 7) == 0) slab[(size_t)row * 16 + cb] = ss;
    __syncthreads();
}

namespace attn {
using bf16x8 = __attribute__((ext_vector_type(8))) short;
using s16x4 = __attribute__((ext_vector_type(4))) short;
using f32x16 = __attribute__((ext_vector_type(16))) float;
using u32x4 = pg8::u32x4;
typedef short v4i16_t __attribute__((ext_vector_type(4)));
typedef __attribute__((address_space(3))) const char* lds_cptr;
__device__ __forceinline__ int crow(int r, int hi) { return (r & 3) + 8 * (r >> 2) + 4 * hi; }
__device__ __forceinline__ s16x4 vtr(lds_cptr p) { return __builtin_bit_cast(s16x4, __builtin_amdgcn_ds_read_tr16_b64_v4i16((__attribute__((address_space(3))) v4i16_t*)p)); }
typedef float f32x2_t __attribute__((ext_vector_type(2))); typedef __bf16 bf16x2_t __attribute__((ext_vector_type(2)));
__device__ __forceinline__ unsigned cvtpk(float lo, float hi) { f32x2_t v = {lo, hi}; bf16x2_t b = __builtin_convertvector(v, bf16x2_t); return __builtin_bit_cast(unsigned, b); }
__device__ __forceinline__ int t5_bucket(int rel) {
    const int n = rel < 0 ? -rel : rel;
    int b = n;
    if (n >= 8) b = 8 + (n >= 12) + (n >= 16) + (n >= 23) + (n >= 32) + (n >= 46) + (n >= 64) + (n >= 91);
    return b + (rel > 0 ? 16 : 0);
}
__device__ __forceinline__ void glds16(const void* gsrc, unsigned lds_dst) { unsigned keep;
    asm volatile("s_mov_b32 %0, m0\n\ts_mov_b32 m0, %2\n\ts_nop 0\n\tglobal_load_lds_dwordx4 %1, off\n\ts_mov_b32 m0, %0" : "=&s"(keep) : "v"(gsrc), "s"(lds_dst) : "memory"); }
__device__ __forceinline__ float bf2f(unsigned short h) { return __uint_as_float((unsigned)h << 16); }

template <int LAYER>
__device__ __forceinline__ void attn_phase(Frame& F, const Args& a) {
    constexpr int P = LAYER == 0 ? 2 : 8;
    constexpr int KVW = LAYER == 0 ? 128 : 1024;
    constexpr int L = P * 64;
    constexpr int RT0 = LAYER == 0 ? 0 : 6;
    unsigned char* ws = a.ws;
    const bf16* Q = (const bf16*)(ws + (LAYER == 0 ? WS_QA : WS_QB));
    const bf16* Kg = (const bf16*)(ws + (LAYER == 0 ? WS_KA : WS_KB));
    const bf16* Vg = (const bf16*)(ws + (LAYER == 0 ? WS_VA : WS_VB));
    const bf16* Gt = (const bf16*)(ws + (LAYER == 0 ? WS_GA : WS_GB));
    const bf16* CK = (const bf16*)(ws + (LAYER == 0 ? WS_CKA : WS_CKB));
    const bf16* CV = (const bf16*)(ws + (LAYER == 0 ? WS_CVA : WS_CVB));
    bf16* O = (bf16*)(ws + WS_XN);
    const float* qg = a.in[LAYER == 0 ? 9 : 15]; const float* kg = a.in[LAYER == 0 ? 10 : 16];
    const float* table = a.in[LAYER == 0 ? 6 : 17];
    int tid_ = threadIdx.x; asm volatile("" : "+v"(tid_));
    const int tid = tid_, lane = tid & 63, wid = __builtin_amdgcn_readfirstlane(tid >> 6), r32 = lane & 31, hi = lane >> 5;
    const int h = F.vcu >> 4, sub = F.vcu & 15;
    const int kvh = LAYER == 0 ? (h >> 3) : h;
    LAS unsigned char* lds = F.lds + RING_OFF;
    const int cw = wid >> 1, half = wid & 1;
    const unsigned lds0 = (unsigned)(size_t)lds;
#define UNIT_PARAMS(ui_, X) const bool X##sample = (ui_) == 4; const int X##u0 = 4 * (4 * sub + (ui_)); const int X##nt = X##sample ? P + 1 : P + 4; \
        const int X##tb = X##sample ? 0 : (X##u0 >= P ? 0 : P - X##u0); const bool X##won = !X##sample || cw == 0; \
        const size_t X##qtok = X##sample ? (size_t)SEQ + 64 * sub + 32 * half : (size_t)64 * (X##u0 + cw) + 32 * half;
#define TILE_DMA_U(X, t, slot_) do { const bf16 *kb_, *vb_; \
            if (!X##sample) { const size_t r0_ = (size_t)64 * (X##u0 - P + (t)) * KVW; kb_ = Kg + r0_; vb_ = Vg + r0_; } \
            else if ((t) < P) { const size_t r0_ = ((size_t)sub * L + 64 * (t)) * KVW; kb_ = CK + r0_; vb_ = CV + r0_; } \
            else { const size_t r0_ = ((size_t)SEQ + 64 * sub) * KVW; kb_ = Kg + r0_; vb_ = Vg + r0_; } \
            const unsigned s_ = (unsigned)__builtin_amdgcn_readfirstlane(lds0 + AT_SLOT + ((slot_) & 3) * AT_SLOTB + wid * 1024); \
            glds16(kb_ + koff, s_); glds16(vb_ + voff, s_ + 8192); } while (0)
#define Q_DMA_U(X) do { if (X##won) { _Pragma("unroll") for (int i_ = 0; i_ < 4; ++i_) glds16(Q + (X##qtok + 8 * i_ + (lane >> 3)) * DM + h * 64 + (lane & 7) * 8, (unsigned)__builtin_amdgcn_readfirstlane(lds0 + AT_OST + wid * 4096 + i_ * 1024)); } } while (0)
#define WAIT_BAR(N) asm volatile("s_waitcnt vmcnt(" #N ") lgkmcnt(0)\n\ts_barrier" ::: "memory")
    const size_t koff = (size_t)lane * KVW + kvh * 64 + wid * 8, voff = (size_t)(16 * (wid & 3) + (lane >> 2)) * KVW + kvh * 64 + (wid >> 2) * 32 + (lane & 3) * 8;
    int sb = 0;
    {
        UNIT_PARAMS(0, f_)
        Q_DMA_U(f_); TILE_DMA_U(f_, f_tb, 0); TILE_DMA_U(f_, f_tb + 1, 1);
    }
    PSEG_BEGIN(1) PSEG_BEGIN(5)
    constexpr int NBR = LAYER == 0 ? 32 : 257;
    LAS float* brow = (LAS float*)(lds + AT_WSF);
    for (int i = tid; i < NBR; i += NWAVES * 64) brow[i] = LAYER == 0 ? table[i * 16 + h] : table[h * 257 + i];
    const float gqa = fabsf(qg[lane]), gka = fabsf(kg[lane]);
    const unsigned kcb = __hip_atomic_load(F.ctl + (LAYER == 0 ? CW_KMAX_A : CW_KMAX_B), __ATOMIC_RELAXED, __HIP_MEMORY_SCOPE_AGENT);
    const float sinkv = LAYER == 0 ? a.in[11][h] : 0.f;
    __syncthreads();
    float bm = -1e30f;
    for (int i = lane; i < NBR; i += 64) bm = fmaxf(bm, brow[i]);
    bm = wave_max(bm);
    const float gqm = wave_max(gqa), gkm = wave_max(gka), kc = sqrtf(__uint_as_float(kcb));
    const float bound = gqm * fmaxf(8.f * gkm, kc) * 1.01f + bm;
    const float cconst = LAYER == 0 ? 0.f : (brow[256 % NBR] - bound) * LOG2E;
    const float sinkp = LAYER == 0 ? __builtin_amdgcn_exp2f((sinkv - bound) * LOG2E) : 0.f;
    {
        LAS float* tab = (LAS float*)(lds + AT_TAB);
        for (int i = tid; i < 3 * 2 * 8 * 64 * 4; i += NWAVES * 64) {
            const int e = i & 3, ln = (i >> 2) & 63, q4 = (i >> 8) & 7, half = (i >> 11) & 1, rtv = i >> 12;
            const int R = 4 * q4 + e, key = 32 * (R >> 4) + crow(R & 15, ln >> 5), qi = 32 * half + (ln & 31), j = 64 * (RT0 + rtv) + key;
            float bv;
            if (LAYER == 0) bv = brow[t5_bucket(j - (P * 64 + qi))];
            else { int idx = P * 64 + qi - j; idx = idx < -128 ? -128 : (idx > 128 ? 128 : idx); bv = brow[(idx + 128) % NBR]; }
            tab[i] = (bv - bound) * LOG2E;
        }
    }
    __syncthreads();
    f32x16 cc16;
#pragma unroll
    for (int r = 0; r < 16; ++r) cc16[r] = cconst;
    asm volatile("" : "+v"(cc16));
    PSEG_END(5)
    const lds_cptr lds3 = (lds_cptr)lds;
    const lds_cptr kp0 = lds3 + AT_SLOT + hi * 1024 + r32 * 16;
    const lds_cptr vp0 = lds3 + AT_SLOT + 8192 + ((lane >> 4) & 1) * 32 + (lane & 3) * 8 + (4 * hi + ((lane & 15) >> 2)) * 64;
    const LAS f32x4* tabl = (const LAS f32x4*)(lds + AT_TAB) + lane;
    LAS float* wsf = (LAS float*)(lds + AT_WSF) + wid * 64;
    for (int ui = 0; ui < 5; ++ui) {
        PSEG_BEGIN(2)
        UNIT_PARAMS(ui, c_)
        const bool sample = c_sample, wave_on = c_won, has_next = ui < 4; const int nt = c_nt, t_begin = c_tb; const size_t qtok = c_qtok;
        UNIT_PARAMS(ui + 1, n_)
        f32x16 o[2]; o[0] = f32x16{}; o[1] = f32x16{};
        float l_reg = 0.f;
        if (ui == 0) WAIT_BAR(2); else WAIT_BAR(4);
        PSEG_END(2) PSEG_BEGIN(3)
        bf16x8 qr[4];
#pragma unroll
        for (int d0 = 0; d0 < 4; ++d0) qr[d0] = *(const __attribute__((address_space(3))) bf16x8*)(lds3 + AT_OST + wid * 4096 + r32 * 128 + (2 * d0 + hi) * 16);
        u32x4 pw[4];
#pragma unroll
        for (int s = 0; s < 4; ++s) pw[s] = (u32x4){0u, 0u, 0u, 0u};
        v4u gpre[4];
#pragma unroll
        for (int i = 0; i < 4; ++i) gpre[i] = (v4u){0u, 0u, 0u, 0u};
#define STEP_HEAD(t) const int sl = (t) - t_begin + sb;                    \
            if ((t) + 2 < nt) TILE_DMA_U(c_, (t) + 2, sl + 2);             \
            if ((t) == nt - 1) { \
                if (wave_on) { _Pragma("unroll") for (int i = 0; i < 4; ++i) gpre[i] = *(const GAS v4u*)(Gt + (qtok + i * 8 + (lane >> 3)) * DM + h * 64 + (lane & 7) * 8); } \
                asm volatile("" ::: "memory"); \
                if (has_next) { Q_DMA_U(n_); TILE_DMA_U(n_, n_tb, sl + 1); } }     \
            if ((t) == nt && has_next) TILE_DMA_U(n_, n_tb + 1, sl + 1);
#define STEP_TAIL(t) if ((t) + 2 < nt) WAIT_BAR(2); else if ((t) + 2 == nt || !has_next) WAIT_BAR(0); else WAIT_BAR(63);
        const int a_lo = wave_on ? (cw > t_begin ? cw : t_begin) : nt + 1, a_hi = wave_on ? (cw + P + 1 < nt ? cw + P + 1 : nt) : nt;
        int t = t_begin;
        for (; t < a_lo && t <= nt; ++t) { STEP_HEAD(t) STEP_TAIL(t) }
        for (; t <= a_hi; ++t) {
            STEP_HEAD(t)
            const int rt = t - cw;
            {
                const bool last = rt == P + 1 || t == nt, first = rt == 0 || t == t_begin;
                const int rtb = last ? rt - 1 : rt;
                const int ko = ((last ? sl - 1 : sl) & 3) * AT_SLOTB, vo = ((first ? sl : sl - 1) & 3) * AT_SLOTB;
                const lds_cptr kp = kp0 + ko, vp = vp0 + vo;
                bf16x8 kf[8];
#pragma unroll
                for (int d0 = 0; d0 < 4; ++d0) { kf[2 * d0] = *(const __attribute__((address_space(3))) bf16x8*)(kp + d0 * 2048); kf[2 * d0 + 1] = *(const __attribute__((address_space(3))) bf16x8*)(kp + d0 * 2048 + 512); }
                f32x16 p0, p1;
                __builtin_amdgcn_s_setprio(1);
                if (rtb >= RT0) { const LAS f32x4* tp = tabl + ((rtb - RT0) * 2 + half) * 8 * 64;
                    const f32x16 t0 = __builtin_shufflevector(__builtin_shufflevector(tp[0], tp[64], 0, 1, 2, 3, 4, 5, 6, 7), __builtin_shufflevector(tp[128], tp[192], 0, 1, 2, 3, 4, 5, 6, 7), 0, 1, 2, 3, 4, 5, 6, 7, 8, 9, 10, 11, 12, 13, 14, 15);
                    const f32x16 t1 = __builtin_shufflevector(__builtin_shufflevector(tp[256], tp[320], 0, 1, 2, 3, 4, 5, 6, 7), __builtin_shufflevector(tp[384], tp[448], 0, 1, 2, 3, 4, 5, 6, 7), 0, 1, 2, 3, 4, 5, 6, 7, 8, 9, 10, 11, 12, 13, 14, 15);
                    p0 = __builtin_amdgcn_mfma_f32_32x32x16_bf16(kf[0], qr[0], t0, 0, 0, 0); p1 = __builtin_amdgcn_mfma_f32_32x32x16_bf16(kf[1], qr[0], t1, 0, 0, 0); }
                else { p0 = __builtin_amdgcn_mfma_f32_32x32x16_bf16(kf[0], qr[0], cc16, 0, 0, 0); p1 = __builtin_amdgcn_mfma_f32_32x32x16_bf16(kf[1], qr[0], cc16, 0, 0, 0); }
#pragma unroll
                for (int d0 = 1; d0 < 4; ++d0) { p0 = __builtin_amdgcn_mfma_f32_32x32x16_bf16(kf[2 * d0], qr[d0], p0, 0, 0, 0); p1 = __builtin_amdgcn_mfma_f32_32x32x16_bf16(kf[2 * d0 + 1], qr[d0], p1, 0, 0, 0); }
                bf16x8 vf[8];
#pragma unroll
                for (int i = 0; i < 8; ++i) { const s16x4 lo = vtr(vp + (i >> 2) * 4096 + (i & 3) * 1024), hh = vtr(vp + (i >> 2) * 4096 + (i & 3) * 1024 + 512); vf[i] = (bf16x8){lo[0], lo[1], lo[2], lo[3], hh[0], hh[1], hh[2], hh[3]}; }
#pragma unroll
                for (int ks = 0; ks < 4; ++ks) { o[0] = __builtin_amdgcn_mfma_f32_32x32x16_bf16(__builtin_bit_cast(bf16x8, pw[ks]), vf[ks], o[0], 0, 0, 0); o[1] = __builtin_amdgcn_mfma_f32_32x32x16_bf16(__builtin_bit_cast(bf16x8, pw[ks]), vf[4 + ks], o[1], 0, 0, 0); }
                __builtin_amdgcn_s_setprio(0);
                float sacc = 0.f;
#pragma unroll
                for (int r = 0; r < 16; ++r) { p0[r] = __builtin_amdgcn_exp2f(p0[r]); p1[r] = __builtin_amdgcn_exp2f(p1[r]); sacc += p0[r] + p1[r]; }
                l_reg += last ? 0.f : sacc;
#pragma unroll
                for (int s = 0; s < 2; ++s)
#pragma unroll
                    for (int i = 0; i < 4; ++i) { pw[s][i] = cvtpk(p0[8 * s + 2 * i], p0[8 * s + 2 * i + 1]); pw[2 + s][i] = cvtpk(p1[8 * s + 2 * i], p1[8 * s + 2 * i + 1]); }
            }
            STEP_TAIL(t)
        }
        for (; t <= nt; ++t) { STEP_HEAD(t) STEP_TAIL(t) }
#undef STEP_HEAD
#undef STEP_TAIL
        PSEG_END(3) PSEG_BEGIN(4)
#undef TILE_DMA
#undef WAIT_BAR
        if (wave_on) {
            l_reg += __shfl_xor(l_reg, 32);
            l_reg += sinkp;
            if (hi == 0) wsf[r32] = l_reg;
            LDS_WAIT(); asm volatile("" ::: "memory");
            LAS unsigned short* stg = (LAS unsigned short*)(lds + AT_SLOT + (((nt - 2 - t_begin + sb) + (wid >> 2)) & 3) * AT_SLOTB + (wid & 3) * 4096);
#pragma unroll
            for (int r = 0; r < 16; ++r) { const int orow = crow(r, hi); const float rl = __builtin_amdgcn_rcpf(wsf[orow]);
#pragma unroll
                for (int d0 = 0; d0 < 2; ++d0) stg[orow * 64 + d0 * 32 + r32] = (unsigned short)(f2bf(o[d0][r] * rl)); }
            LDS_WAIT(); asm volatile("" ::: "memory");
#pragma unroll
            for (int i = 0; i < 4; ++i) { const int row = i * 8 + (lane >> 3), ch = lane & 7;
                const v4u ov = *(const LAS v4u*)(stg + row * 64 + ch * 8);
                const size_t go = (qtok + row) * DM + h * 64 + ch * 8;
                const v4u gvv = gpre[i];
                v4u res;
#pragma unroll
                for (int e = 0; e < 4; ++e) { const float a0 = __uint_as_float(ov[e] << 16) * __uint_as_float(gvv[e] << 16), a1 = __uint_as_float(ov[e] & 0xffff0000u) * __uint_as_float(gvv[e] & 0xffff0000u); res[e] = cvtpk(a0, a1); }
                *(GAS v4u*)(O + go) = res; }
        }
        sb += nt - t_begin;
        PSEG_END(4)
    }
    __syncthreads();
    PSEG_END(1)
}
template <int NV> __device__ __forceinline__ void wait_bar_n(int n) {
#define WB_(N) case N: asm volatile("s_waitcnt vmcnt(" #N ") lgkmcnt(0)\n\ts_barrier" ::: "memory"); break;
    switch (n) { WB_(0) WB_(2) WB_(4) WB_(6) WB_(8) WB_(10) WB_(12) WB_(14) WB_(16) WB_(18) WB_(20) WB_(22) WB_(24) WB_(26) WB_(28) default: asm volatile("s_waitcnt vmcnt(0) lgkmcnt(0)\n\ts_barrier" ::: "memory"); break; }
#undef WB_
}
__device__ __forceinline__ void attn_phase_a(Frame& F, const Args& a) {
    constexpr int P = 2, KVW = 128, NCH = 272, NSL = 5, SLOTB = 16384;
    constexpr int A2_RING = 0, A2_TT = NSL * SLOTB, A2_WSF = A2_TT + 8192, A2_Q = A2_WSF + 3072, A2_OST = A2_Q + NWAVES * 4096, A2_END = A2_OST + NWAVES * 4096;
    static_assert(A2_Q % 1024 == 0 && A2_END <= PHASE_BYTES, "layer A attention LDS map");
    unsigned char* ws = a.ws;
    const bf16* Q = (const bf16*)(ws + WS_QA); const bf16* Kg = (const bf16*)(ws + WS_KA); const bf16* Vg = (const bf16*)(ws + WS_VA); const bf16* Gt = (const bf16*)(ws + WS_GA);
    const bf16* CK = (const bf16*)(ws + WS_CKA); const bf16* CV = (const bf16*)(ws + WS_CVA);
    bf16* O = (bf16*)(ws + WS_XN);
    const float* qg = a.in[9]; const float* kg = a.in[10]; const float* table = a.in[6];
    int tid_ = threadIdx.x; asm volatile("" : "+v"(tid_));
    const int tid = tid_, lane = tid & 63, wid = __builtin_amdgcn_readfirstlane(tid >> 6), r32 = lane & 31, hi = lane >> 5;
    const int combo = F.vcu >> 6, g = combo >> 1, half = combo & 1, cidx = F.vcu & 63;
    const int c_lo = (cidx * NCH) >> 6, c_hi = ((cidx + 1) * NCH) >> 6;
    const int h = 8 * g + wid;
    LAS unsigned char* lds = F.lds + RING_OFF;
    const unsigned lds0 = (unsigned)(size_t)lds;
    const lds_cptr lds3 = (lds_cptr)lds;
    const int cp_hi = c_hi < 256 ? c_hi : 256;
    const int a0 = c_lo >= 2 ? c_lo - 2 : 0;
    const int npt = c_lo < 256 ? (cp_hi - 1) - a0 + 1 : 0;
    const int cs_lo = c_lo > 256 ? c_lo : 256;
#define T0_OF(c) (((c) < 2) ? 2 - (c) : 0)
#define POS_OF(c, ti) ((c) < 256 ? ((c) - 2 + (ti)) - a0 : npt + 3 * ((c) - cs_lo) + (ti))
#define NEW_OF(c, ti) ((c) >= 256 || (c) == c_lo || (ti) == 2)
#define QTOK_OF(c) ((c) < 256 ? (size_t)64 * (c) + 32 * half : (size_t)SEQ + 64 * ((c) - 256) + 32 * half)
    const size_t koff = (size_t)lane * KVW + g * 64 + wid * 8, voff = (size_t)(16 * (wid & 3) + (lane >> 2)) * KVW + g * 64 + (wid >> 2) * 32 + (lane & 3) * 8;
#define TILE_DMA_A(c, ti) do { const bf16 *kb_, *vb_; \
        if ((c) < 256) { const size_t r0_ = (size_t)64 * ((c) - 2 + (ti)) * KVW; kb_ = Kg + r0_; vb_ = Vg + r0_; } \
        else if ((ti) < 2) { const size_t r0_ = ((size_t)((c) - 256) * 128 + 64 * (ti)) * KVW; kb_ = CK + r0_; vb_ = CV + r0_; } \
        else { const size_t r0_ = ((size_t)SEQ + 64 * ((c) - 256)) * KVW; kb_ = Kg + r0_; vb_ = Vg + r0_; } \
        const unsigned s_ = (unsigned)__builtin_amdgcn_readfirstlane(lds0 + A2_RING + (POS_OF(c, ti) % NSL) * SLOTB + wid * 1024); \
        glds16(kb_ + koff, s_); glds16(vb_ + voff, s_ + 8192); } while (0)
#define Q_DMA_A(c) do { const size_t qt_ = QTOK_OF(c); _Pragma("unroll") for (int i_ = 0; i_ < 4; ++i_) glds16(Q + (qt_ + 8 * i_ + (lane >> 3)) * DM + h * 64 + (lane & 7) * 8, (unsigned)__builtin_amdgcn_readfirstlane(lds0 + A2_Q + wid * 4096 + i_ * 1024)); } while (0)
#define STEP_NEXT(c, ti) do { if ((ti) < 2) ++(ti); else { ++(c); (ti) = T0_OF(c); } } while (0)
    int c3 = c_lo, t3 = T0_OF(c_lo);
    Q_DMA_A(c_lo);
#pragma unroll 1
    for (int k = 0; k < 3; ++k) { if (c3 < c_hi) { if (NEW_OF(c3, t3)) TILE_DMA_A(c3, t3); STEP_NEXT(c3, t3); } }
    const float gqm = wave_max(fabsf(qg[lane])), gkm = wave_max(fabsf(kg[lane]));
    const float kc = sqrtf(__uint_as_float(__hip_atomic_load(F.ctl + CW_KMAX_A, __ATOMIC_RELAXED, __HIP_MEMORY_SCOPE_AGENT)));
    const float bm = wave_max(lane < 32 ? table[lane * 16 + h] : -1e30f);
    const float bound = gqm * fmaxf(8.f * gkm, kc) * 1.01f + bm;
    const float sinkp = __builtin_amdgcn_exp2f((a.in[11][h] - bound) * LOG2E);
    LAS float* TTw = (LAS float*)(lds + A2_TT) + wid * 256;
    for (int i = lane; i < 255; i += 64) TTw[i] = (table[t5_bucket(i - 191) * 16 + h] - bound) * LOG2E;
    const LAS float* tql = TTw + (63 - 32 * half - r32 + 4 * hi);
    const lds_cptr kp0 = lds3 + A2_RING + hi * 1024 + r32 * 16;
    const lds_cptr vp0 = lds3 + A2_RING + 8192 + ((lane >> 4) & 1) * 32 + (lane & 3) * 8 + (4 * hi + ((lane & 15) >> 2)) * 64;
    LAS float* wsf = (LAS float*)(lds + A2_WSF) + wid * 64;
    asm volatile("s_waitcnt vmcnt(0) lgkmcnt(0)\n\ts_barrier" ::: "memory");
    f32x16 o[2]; o[0] = f32x16{}; o[1] = f32x16{};
    float l_reg = 0.f;
    u32x4 pw[4];
#pragma unroll
    for (int s = 0; s < 4; ++s) pw[s] = (u32x4){0u, 0u, 0u, 0u};
    bf16x8 qr[4];
    v4u gpre[4];
    { const size_t qt0 = QTOK_OF(c_lo);
#pragma unroll
      for (int i = 0; i < 4; ++i) gpre[i] = *(const GAS v4u*)(Gt + (qt0 + i * 8 + (lane >> 3)) * DM + h * 64 + (lane & 7) * 8); }
    int c = c_lo, ti = T0_OF(c_lo);
    int pc = -1, pv_pos = 0;
    bool p_last = false;
    int ops_prev = 4;
    for (;;) {
        const bool qk_on = c < c_hi;
        int ops = 0;
        if (qk_on && ti == T0_OF(c)) {
#pragma unroll
            for (int d0 = 0; d0 < 4; ++d0) qr[d0] = *(const __attribute__((address_space(3))) bf16x8*)(lds3 + A2_Q + wid * 4096 + r32 * 128 + (2 * d0 + hi) * 16);
        }
        f32x16 p0, p1;
        {
            const int pos = qk_on ? POS_OF(c, ti) : pv_pos;
            const int tq = qk_on ? ti : 2;
            const lds_cptr kp = kp0 + (pos % NSL) * SLOTB, vp = vp0 + ((pc >= 0 ? pv_pos : pos) % NSL) * SLOTB;
            bf16x8 kf[8];
#pragma unroll
            for (int d0 = 0; d0 < 4; ++d0) { kf[2 * d0] = *(const __attribute__((address_space(3))) bf16x8*)(kp + d0 * 2048); kf[2 * d0 + 1] = *(const __attribute__((address_space(3))) bf16x8*)(kp + d0 * 2048 + 512); }
            const LAS float* tq_ = tql + 64 * tq;
#pragma unroll
            for (int r = 0; r < 16; ++r) { p0[r] = tq_[(r & 3) + 8 * (r >> 2)]; p1[r] = tq_[32 + (r & 3) + 8 * (r >> 2)]; }
            __builtin_amdgcn_s_setprio(1);
#pragma unroll
            for (int d0 = 0; d0 < 4; ++d0) { p0 = __builtin_amdgcn_mfma_f32_32x32x16_bf16(kf[2 * d0], qr[d0], p0, 0, 0, 0); p1 = __builtin_amdgcn_mfma_f32_32x32x16_bf16(kf[2 * d0 + 1], qr[d0], p1, 0, 0, 0); }
            bf16x8 vf[8];
#pragma unroll
            for (int i = 0; i < 8; ++i) { const s16x4 lo = vtr(vp + (i >> 2) * 4096 + (i & 3) * 1024), hh = vtr(vp + (i >> 2) * 4096 + (i & 3) * 1024 + 512); vf[i] = (bf16x8){lo[0], lo[1], lo[2], lo[3], hh[0], hh[1], hh[2], hh[3]}; }
#pragma unroll
            for (int ks = 0; ks < 4; ++ks) { o[0] = __builtin_amdgcn_mfma_f32_32x32x16_bf16(__builtin_bit_cast(bf16x8, pw[ks]), vf[ks], o[0], 0, 0, 0); o[1] = __builtin_amdgcn_mfma_f32_32x32x16_bf16(__builtin_bit_cast(bf16x8, pw[ks]), vf[4 + ks], o[1], 0, 0, 0); }
            __builtin_amdgcn_s_setprio(0);
        }
        if (p_last) {
            l_reg += __shfl_xor(l_reg, 32);
            l_reg += sinkp;
            if (hi == 0) wsf[r32] = l_reg;
            LDS_WAIT(); asm volatile("" ::: "memory");
            LAS unsigned short* stg = (LAS unsigned short*)(lds + A2_OST) + wid * 2048;
#pragma unroll
            for (int r = 0; r < 16; ++r) { const int orow = crow(r, hi); const float rl = __builtin_amdgcn_rcpf(wsf[orow]);
#pragma unroll
                for (int d0 = 0; d0 < 2; ++d0) stg[orow * 64 + d0 * 32 + r32] = (unsigned short)(f2bf(o[d0][r] * rl)); }
            LDS_WAIT(); asm volatile("" ::: "memory");
            const size_t qtok = QTOK_OF(pc);
#pragma unroll
            for (int i = 0; i < 4; ++i) { const int row = i * 8 + (lane >> 3), ch = lane & 7;
                const v4u ov = *(const LAS v4u*)(stg + row * 64 + ch * 8);
                const v4u gvv = gpre[i];
                v4u res;
#pragma unroll
                for (int e = 0; e < 4; ++e) { const float a0_ = __uint_as_float(ov[e] << 16) * __uint_as_float(gvv[e] << 16), a1_ = __uint_as_float(ov[e] & 0xffff0000u) * __uint_as_float(gvv[e] & 0xffff0000u); res[e] = cvtpk(a0_, a1_); }
                *(GAS v4u*)(O + (qtok + row) * DM + h * 64 + ch * 8) = res; }
            ops += 4;
            o[0] = f32x16{}; o[1] = f32x16{}; l_reg = 0.f;
            if (qk_on) {
                const size_t qt2 = QTOK_OF(c);
#pragma unroll
                for (int i = 0; i < 4; ++i) gpre[i] = *(const GAS v4u*)(Gt + (qt2 + i * 8 + (lane >> 3)) * DM + h * 64 + (lane & 7) * 8);
                ops += 4; }
        }
        if (!qk_on) break;
        if (c3 < c_hi) { if (NEW_OF(c3, t3)) { TILE_DMA_A(c3, t3); ops += 2; } STEP_NEXT(c3, t3); }
        if (ti == T0_OF(c) && c + 1 < c_hi) { asm volatile("s_waitcnt lgkmcnt(0)" ::: "memory"); Q_DMA_A(c + 1); ops += 4; }
        {
            float sacc = 0.f;
#pragma unroll
            for (int r = 0; r < 16; ++r) { p0[r] = __builtin_amdgcn_exp2f(p0[r]); p1[r] = __builtin_amdgcn_exp2f(p1[r]); sacc += p0[r] + p1[r]; }
            l_reg += sacc;
#pragma unroll
            for (int s = 0; s < 2; ++s)
#pragma unroll
                for (int i = 0; i < 4; ++i) { pw[s][i] = cvtpk(p0[8 * s + 2 * i], p0[8 * s + 2 * i + 1]); pw[2 + s][i] = cvtpk(p1[8 * s + 2 * i], p1[8 * s + 2 * i + 1]); }
        }
        const bool short_chunk = T0_OF(c) != 0;
        wait_bar_n<0>(short_chunk ? 0 : ops + ops_prev);
        ops_prev = ops;
        pc = c; pv_pos = POS_OF(c, ti); p_last = ti == 2;
        STEP_NEXT(c, ti);
    }
    asm volatile("s_waitcnt vmcnt(0) lgkmcnt(0)\n\ts_barrier" ::: "memory");
#undef T0_OF
#undef POS_OF
#undef NEW_OF
#undef QTOK_OF
#undef TILE_DMA_A
#undef Q_DMA_A
#undef STEP_NEXT
}
}

__global__ void __launch_bounds__(NWAVES * 64, 2) mk_fwd(Args args) {
    extern __shared__ __attribute__((aligned(16))) unsigned char lds[];
    Frame F; F.tacc = 0;
    F.lds = (LAS unsigned char*)lds;
    F.MISC = (volatile LAS unsigned*)(F.lds + MISC_OFF);
    F.tid = threadIdx.x; F.lane = F.tid & 63; F.wave = __builtin_amdgcn_readfirstlane(F.tid >> 6);
    F.G = gridDim.x; { const int bx = blockIdx.x; F.vcu = (F.G % 8 == 0) ? (bx % 8) * (F.G / 8) + bx / 8 : bx; }
    unsigned char* ws = args.ws;
    F.ctl = (gu32*)(ws + WS_CTL);
    for (int u = F.tid; u < (LDS_BYTES - LDSCTL_OFF) / 4; u += NWAVES * 64) ((LAS unsigned*)(F.lds + LDSCTL_OFF))[u] = 0u;
    __syncthreads();
    XcdBarrier bar = xcd_barrier_post((unsigned*)(F.ctl + CW_BAR), F.MISC + 8);
    bf16* XN = (bf16*)(ws + WS_XN);
    float* slab = (float*)(ws + WS_SLAB);
    float* out = args.out;

#ifndef DUP_PHASE
#define DUP_PHASE -1
#endif
#define REPS_ON(k) int nrep_##k = 2; asm volatile("" : "+s"(nrep_##k)); for (int rep_ = 0; rep_ < nrep_##k; ++rep_)
#define REPS_OFF(k)
#define REPS_SEL(k) REPS_SEL2(k, DUP_PHASE)
#define REPS(k) REPS_##k
#if DUP_PHASE == 0
#define REPS_0 REPS_ON(0)
#else
#define REPS_0
#endif
#if DUP_PHASE == 1
#define REPS_1 REPS_ON(1)
#else
#define REPS_1
#endif
#if DUP_PHASE == 2
#define REPS_2 REPS_ON(2)
#else
#define REPS_2
#endif
#if DUP_PHASE == 3
#define REPS_3 REPS_ON(3)
#else
#define REPS_3
#endif
#if DUP_PHASE == 4
#define REPS_4 REPS_ON(4)
#else
#define REPS_4
#endif
#if DUP_PHASE == 5
#define REPS_5 REPS_ON(5)
#else
#define REPS_5
#endif
#if DUP_PHASE == 6
#define REPS_6 REPS_ON(6)
#else
#define REPS_6
#endif
    KSEG_BEGIN(10) REPS(0) { p0_prologue(F, args);
    xcd_barrier(bar); } KSEG_END(10)
    KSEG_BEGIN(11) REPS(1) {
        pg8::Gemm g{XN, (const bf16*)(ws + WS_WINA), M, NIN_A, DM}; pg8::StaticOrder S; S.init(M, NIN_A, F.G, (int)blockIdx.x, WGM_P1);
        pg8::EpiIn E{0, (bf16*)(ws + WS_QA), (bf16*)(ws + WS_KA), (bf16*)(ws + WS_VA), (bf16*)(ws + WS_GA), 128, args.in[9], args.in[10], nullptr,
                     out + O_KAP, out + O_VAP, out + O_KAS, out + O_VAS, 128, 2, C2, nullptr};
        pg8::gemm_phase<pg8::EpiIn, pg8::StaticOrder, true, true>(F.lds + RING_OFF, g, S, E, PROBE_SEG == 31 ? &F.tacc : nullptr);
        { const int busy = (M / 256) * (NIN_A / 256) - 2 * F.G;
          if ((int)blockIdx.x >= busy && F.wave < 4) { side_weights(F, args, ((int)blockIdx.x - busy) * 4 + F.wave, (F.G - busy) * 4);
              side_cache_b_conv(F, args, ((int)blockIdx.x - busy) * 4 + F.wave, (F.G - busy) * 4, 0, NB * 256); } }
    xcd_barrier(bar); } KSEG_END(11)
    KSEG_BEGIN(12) REPS(2) { attn::attn_phase_a(F, args);
    xcd_barrier(bar); } KSEG_END(12)
    KSEG_BEGIN(13) REPS(3) {
        pg8::Gemm g{XN, (const bf16*)(ws + WS_WOUTA), SEQ, DM, DM}; pg8::StaticOrder S; S.init(SEQ, DM, F.G, (int)blockIdx.x);
        pg8::EpiOut E{0, args.in[0], args.in[1], (bf16*)(ws + WS_QA), nullptr, slab};
        KSEG_BEGIN(20) pg8::gemm_phase<pg8::EpiOut, pg8::StaticOrder, true, true>(F.lds + RING_OFF, g, S, E); KSEG_END(20)
        KSEG_BEGIN(21)
        tail_outproj<0>(F.lds + RING_OFF, XN, (const bf16*)(ws + WS_WOUTA), (int)blockIdx.x, args.in[1], (bf16*)(ws + WS_QA), slab, nullptr);
        KSEG_END(21)
    xcd_barrier(bar); } KSEG_END(13)
    KSEG_BEGIN(14) REPS(4) {
        pg8::Gemm g{(const bf16*)(ws + WS_QA), (const bf16*)(ws + WS_WINB), M, NIN_B, DM}; pg8::StaticOrder S; S.init(M, NIN_B, F.G, (int)blockIdx.x, WGM_P4);
        pg8::EpiIn E{1, (bf16*)(ws + WS_QB), (bf16*)(ws + WS_KB), (bf16*)(ws + WS_VB), (bf16*)(ws + WS_GB), 1024, args.in[15], args.in[16], slab,
                     out + O_KBP, out + O_VBP, out + O_KBS, out + O_VBS, 512, 16, C2, (LAS float*)(F.lds + RING_BYTES + 1024)};
        pg8::gemm_phase<pg8::EpiIn, pg8::StaticOrder, true, true>(F.lds + RING_OFF, g, S, E, PROBE_SEG == 30 ? &F.tacc : nullptr);
        { const int busy = (M / 256) * (NIN_B / 256) - 4 * F.G;
          if ((int)blockIdx.x >= busy && F.wave < 2) side_cache_b_conv(F, args, ((int)blockIdx.x - busy) * 2 + F.wave, (F.G - busy) * 2, NB * 256, NB * 512); }
    xcd_barrier(bar); } KSEG_END(14)
    KSEG_BEGIN(15) REPS(5) { attn::attn_phase<1>(F, args);
    xcd_barrier(bar); } KSEG_END(15)
    KSEG_BEGIN(16) REPS(6) {
        pg8::Gemm g{XN, (const bf16*)(ws + WS_WOUTB), SEQ, DM, DM}; pg8::StaticOrder S; S.init(SEQ, DM, F.G, (int)blockIdx.x);
        pg8::EpiOut E{1, nullptr, nullptr, (bf16*)(ws + WS_QA), out + O_Y, nullptr};
        pg8::gemm_phase<pg8::EpiOut, pg8::StaticOrder, true, true>(F.lds + RING_OFF, g, S, E);
        tail_outproj<1>(F.lds + RING_OFF, XN, (const bf16*)(ws + WS_WOUTB), (int)blockIdx.x, nullptr, (bf16*)(ws + WS_QA), nullptr, out + O_Y);
    }
    KSEG_END(16)
#if PROBE_SEG
    if (blockIdx.x == 0) {
        const unsigned long long t0 = __builtin_amdgcn_s_memrealtime(), dt = 8ull * (unsigned long long)__builtin_amdgcn_readfirstlane((unsigned)F.tacc);
        while (__builtin_amdgcn_s_memrealtime() - t0 < dt) __builtin_amdgcn_s_sleep(32);
    }
#endif
}
extern "C" void kernel_launch(void* const* d_in, const int* in_sizes, int n_in, void* d_out, int out_size, void* d_ws, size_t ws_size, hipStream_t stream) {
    static int grid = 0;
    if (grid == 0) {
        if (n_in != 19 || out_size != (int)O_END || ws_size < WS_END) { fprintf(stderr, "kernel_launch: unexpected shapes (n_in %d, out %d, ws %zu)\n", n_in, out_size, ws_size); grid = -1; return; }
        int dev = 0, cus = 0, per_cu = 0;
        if (hipGetDevice(&dev) != hipSuccess || hipDeviceGetAttribute(&cus, hipDeviceAttributeMultiprocessorCount, dev) != hipSuccess) { grid = -1; return; }
        if (hipFuncSetAttribute((const void*)mk_fwd, hipFuncAttributeMaxDynamicSharedMemorySize, LDS_BYTES) != hipSuccess) { fprintf(stderr, "kernel_launch: hipFuncSetAttribute failed\n"); grid = -1; return; }
        if (hipOccupancyMaxActiveBlocksPerMultiprocessor(&per_cu, (const void*)mk_fwd, NWAVES * 64, LDS_BYTES) != hipSuccess || per_cu < 1) { fprintf(stderr, "kernel_launch: occupancy query says %d blocks per CU\n", per_cu); }
        (void)hipGetLastError();
        grid = cus;
        if (grid != 256) { fprintf(stderr, "kernel_launch: built for 256 CUs, found %d\n", cus); grid = -1; return; }
    }
    if (grid < 0) return;
    (void)hipMemsetAsync((char*)d_ws + WS_CTL, 0, CTL_ZERO_BYTES, stream);
    Args a{};
    for (int i = 0; i < 19; ++i) a.in[i] = (const float*)d_in[i];
    a.out = (float*)d_out; a.ws = (unsigned char*)d_ws;
    hipLaunchKernelGGL(mk_fwd, dim3(grid), dim3(NWAVES * 64), LDS_BYTES, stream, a);
}
```

```cpp
#include <hip/hip_runtime.h>
#include <cstdio>
#include <cstdint>
#include <cmath>
namespace pg8 {
#define PG8_LAS __attribute__((address_space(3)))
typedef unsigned short bf16_t;
typedef short bf16x8 __attribute__((ext_vector_type(8)));
typedef float f32x4 __attribute__((ext_vector_type(4)));
typedef unsigned u32x4 __attribute__((ext_vector_type(4)));
constexpr int BM = 256, BK = 64, HALF = 128, HTB = HALF * BK * 2  , STAGE_BYTES = 8 * HTB, NXCD = 8, WGM = 4;

__host__ __device__ __forceinline__ int lds_byte(int r, int c) { const int st = (r >> 4) * 2 + (c >> 5), rr = r & 15, cc = c & 31, ob = rr * 64 + cc * 2; return st * 1024 + (ob ^ (((ob >> 9) & 1) << 5)); }
__host__ __device__ __forceinline__ void stage_rc(int b, int& R, int& C) { const int st = b / 1024, sb = b % 1024, swz = sb ^ (((sb >> 9) & 1) << 5); R = (st >> 1) * 16 + swz / 64; C = (st & 1) * 32 + (swz % 64) / 2; }
__host__ __device__ __forceinline__ int perm32(int rho) { const int n = rho >> 4, i = rho & 15; return 8 * (i >> 2) + 4 * n + (i & 3); }

struct Unit { int pm, pn; };
struct Gemm { const bf16_t* A; const bf16_t* Bt; int M, N, K; };

struct StaticOrder {
    int nM, nN, nwg, G, c, wgm;
    __host__ __device__ void init(int M, int N, int G_, int c_, int wgm_ = WGM) { nM = M / BM; nN = N / BM; nwg = nM * nN; G = G_; c = c_; wgm = wgm_; }
    __host__ __device__ bool next(int i, Unit& u) const {
        const long L = (long)i * G + c; if (L >= nwg) return false;
        int wgid = (int)L; { const int q = nwg / NXCD, r = nwg % NXCD, xcd = wgid % NXCD, off = wgid / NXCD; wgid = (xcd < r ? xcd * (q + 1) : r * (q + 1) + (xcd - r) * q) + off; }
        const int nig = wgm * nN, gid = wgid / nig, fm = gid * wgm, gsz = (nM - fm) < wgm ? (nM - fm) : wgm;
        u.pm = fm + ((wgid % nig) % gsz); u.pn = (wgid % nig) / gsz; return true;
    }
    __device__ __forceinline__ void a_ready(const Unit&) const {}
    __device__ __forceinline__ void done(const Unit&) const {}
};
__device__ __forceinline__ unsigned cvt_pk_bf16(float lo, float hi) { unsigned r; asm volatile("v_cvt_pk_bf16_f32 %0, %1, %2" : "=v"(r) : "v"(lo), "v"(hi)); return r; }
__device__ __forceinline__ void st16_wt(void* p, u32x4 v) { asm volatile("global_store_dwordx4 %0, %1, off sc1\n\ts_nop 1" :: "v"(p), "v"(v) : "memory"); }
constexpr int SEQ_ = 16384;
constexpr float NORM_EPS = 1e-6f;
struct EpiIn {
    static constexpr bool PERM = true, AFTER_DRAIN = false;
    int layer;
    bf16_t *Q, *Kb, *Vb, *G; int kvw;
    const float *qg, *kg;
    const float* slab;
    float *okp, *ovp, *oks, *ovs; int keep, nkv;
    float c2;
    PG8_LAS float* rstd_lds;
    template <int TYPE>
    __device__ __forceinline__ void tile(const f32x4 (&acc)[2][2][4][2], int row0, int rl0, int dcol, int fq, bf16_t* dst, int ld, const float* gp, float sc, float* o_p, float* o_s, int head) const {
        f32x4 gv[2][2];
        if (TYPE < 2) {
#pragma unroll
            for (int bj = 0; bj < 2; ++bj)
#pragma unroll
                for (int n = 0; n < 2; ++n) gv[bj][n] = *(const f32x4*)(gp + 32 * bj + dcol + 4 * n) * sc; }
#pragma unroll
        for (int ai = 0; ai < 2; ++ai)
#pragma unroll
            for (int m = 0; m < 4; ++m) {
                const int row = row0 + ai * HALF + m * 16;
                const float rs = slab ? rstd_lds[ai * HALF + rl0 + m * 16] : 1.f;
                f32x4 v[2][2];
#pragma unroll
                for (int bj = 0; bj < 2; ++bj)
#pragma unroll
                    for (int n = 0; n < 2; ++n) v[bj][n] = acc[ai][bj][m][n] * rs;
                if (TYPE < 2) {
                    float ss = 0.f;
#pragma unroll
                    for (int bj = 0; bj < 2; ++bj)
#pragma unroll
                        for (int n = 0; n < 2; ++n) { const f32x4 x = v[bj][n]; ss += (x[0] * x[0] + x[1] * x[1]) + (x[2] * x[2] + x[3] * x[3]); }
                    ss += __shfl_xor(ss, 16); ss += __shfl_xor(ss, 32);
                    const float r = rsqrtf(ss * (1.f / 64.f) + NORM_EPS);
#pragma unroll
                    for (int bj = 0; bj < 2; ++bj)
#pragma unroll
                        for (int n = 0; n < 2; ++n) v[bj][n] = v[bj][n] * r * gv[bj][n];
                } else if (TYPE == 3) {
#pragma unroll
                    for (int bj = 0; bj < 2; ++bj)
#pragma unroll
                        for (int n = 0; n < 2; ++n)
#pragma unroll
                            for (int e = 0; e < 4; ++e) { const float x = v[bj][n][e]; v[bj][n][e] = x * __builtin_amdgcn_rcpf(1.f + __builtin_amdgcn_exp2f(-1.4426950408889634f * x)); }
                }
                if ((TYPE == 1 || TYPE == 2) && row >= SEQ_ - keep) {
                    float* op;
                    if (row < SEQ_) op = o_p + ((size_t)(row - (SEQ_ - keep)) * nkv + head) * 64 + dcol;
                    else { const int r_ = row - SEQ_; op = o_s + (((size_t)(r_ >> 6) * keep + (keep - 64) + (r_ & 63)) * nkv + head) * 64 + dcol; }
#pragma unroll
                    for (int bj = 0; bj < 2; ++bj) { *(f32x4*)(op + 32 * bj) = v[bj][0]; *(f32x4*)(op + 32 * bj + 4) = v[bj][1]; }
                }
#pragma unroll
                for (int bj = 0; bj < 2; ++bj) { u32x4 w; w.x = cvt_pk_bf16(v[bj][0][0], v[bj][0][1]); w.y = cvt_pk_bf16(v[bj][0][2], v[bj][0][3]); w.z = cvt_pk_bf16(v[bj][1][0], v[bj][1][1]); w.w = cvt_pk_bf16(v[bj][1][2], v[bj][1][3]);
                    st16_wt(dst + (size_t)row * ld + 32 * bj, w); }
            }
    }
    __device__ __forceinline__ void operator()(const f32x4 (&acc)[2][2][4][2], const Unit& u, int wr, int wc, int fr, int fq) const {
        int type, head;
        if (layer == 0) { if (u.pn < 4) { type = 0; head = 4 * u.pn + wc; } else if (u.pn == 4) { type = wc < 2 ? 1 : 2; head = wc & 1; } else { type = 3; head = 4 * (u.pn - 5) + wc; } }
        else { type = u.pn >> 2; head = 4 * (u.pn & 3) + wc; }
        const int row0 = u.pm * BM + wr * 64 + fr, rl0 = wr * 64 + fr, dcol = 8 * fq, co = head * 64 + dcol;
        if (slab) {
            const int t = threadIdx.x;
            if (t < BM) { const f32x4* sp = (const f32x4*)(slab + (size_t)(u.pm * BM + t) * 16); const f32x4 a = sp[0], b = sp[1], c = sp[2], d = sp[3];
                const f32x4 s = (a + b) + (c + d); rstd_lds[t] = rsqrtf(((s[0] + s[1]) + (s[2] + s[3])) * (1.f / 1024.f) + NORM_EPS); }
            asm volatile("s_waitcnt lgkmcnt(0)\n\ts_barrier" ::: "memory");
        }
        if (type == 0) tile<0>(acc, row0, rl0, dcol, fq, Q + co, 1024, qg, c2, nullptr, nullptr, head);
        else if (type == 1) tile<1>(acc, row0, rl0, dcol, fq, Kb + co, kvw, kg, 1.f, okp, oks, head);
        else if (type == 2) tile<2>(acc, row0, rl0, dcol, fq, Vb + co, kvw, nullptr, 1.f, ovp, ovs, head);
        else tile<3>(acc, row0, rl0, dcol, fq, G + co, 1024, nullptr, 1.f, nullptr, nullptr, head);
    }
};
struct EpiOut {
    static constexpr bool PERM = true, AFTER_DRAIN = false;
    int layer;
    const float *base_p, *base_s;
    bf16_t* yb;
    float* out;
    float* slab;
    __device__ __forceinline__ void operator()(const f32x4 (&acc)[2][2][4][2], const Unit& u, int wr, int wc, int fr, int fq) const {
        const int row0 = u.pm * BM + wr * 64 + fr, col0 = u.pn * BM + wc * 32 + 8 * fq;
        if (layer == 0) {
#pragma unroll
            for (int ai = 0; ai < 2; ++ai) {
                f32x4 b[4][2][2];
#pragma unroll
                for (int m = 0; m < 4; ++m) { const int row = row0 + ai * HALF + m * 16;
                    const float* bp = (row < SEQ_ ? base_p + (size_t)row * 1024 : base_s + (size_t)(row - SEQ_) * 1024) + col0;
#pragma unroll
                    for (int bj = 0; bj < 2; ++bj) { b[m][bj][0] = __builtin_nontemporal_load((const f32x4*)(bp + bj * HALF)); b[m][bj][1] = __builtin_nontemporal_load((const f32x4*)(bp + bj * HALF + 4)); } }
#pragma unroll
                for (int m = 0; m < 4; ++m) { const int row = row0 + ai * HALF + m * 16; float ss = 0.f;
#pragma unroll
                    for (int bj = 0; bj < 2; ++bj) { const f32x4 y0 = acc[ai][bj][m][0] + b[m][bj][0], y1 = acc[ai][bj][m][1] + b[m][bj][1];
                        ss += ((y0[0] * y0[0] + y0[1] * y0[1]) + (y0[2] * y0[2] + y0[3] * y0[3])) + ((y1[0] * y1[0] + y1[1] * y1[1]) + (y1[2] * y1[2] + y1[3] * y1[3]));
                        u32x4 w; w.x = cvt_pk_bf16(y0[0], y0[1]); w.y = cvt_pk_bf16(y0[2], y0[3]); w.z = cvt_pk_bf16(y1[0], y1[1]); w.w = cvt_pk_bf16(y1[2], y1[3]);
                        *(u32x4*)(yb + (size_t)row * 1024 + col0 + bj * HALF) = w; }
                    ss += __shfl_xor(ss, 16); ss += __shfl_xor(ss, 32); if (fq == 0) slab[(size_t)row * 16 + 4 * u.pn + wc] = ss; }
            }
        } else {
#pragma unroll
            for (int ai = 0; ai < 2; ++ai) {
                u32x4 b[4][2];
#pragma unroll
                for (int m = 0; m < 4; ++m) { const int row = row0 + ai * HALF + m * 16;
#pragma unroll
                    for (int bj = 0; bj < 2; ++bj) b[m][bj] = *(const u32x4*)(yb + (size_t)row * 1024 + col0 + bj * HALF); }
#pragma unroll
                for (int m = 0; m < 4; ++m) { const int row = row0 + ai * HALF + m * 16; float* op = out + (size_t)row * 1024 + col0;
#pragma unroll
                    for (int bj = 0; bj < 2; ++bj) { const u32x4 w = b[m][bj];
                        const f32x4 r0 = {__uint_as_float(w.x << 16), __uint_as_float(w.x & 0xffff0000u), __uint_as_float(w.y << 16), __uint_as_float(w.y & 0xffff0000u)};
                        const f32x4 r1 = {__uint_as_float(w.z << 16), __uint_as_float(w.z & 0xffff0000u), __uint_as_float(w.w << 16), __uint_as_float(w.w & 0xffff0000u)};
                        *(f32x4*)(op + bj * HALF) = acc[ai][bj][m][0] + r0; *(f32x4*)(op + bj * HALF + 4) = acc[ai][bj][m][1] + r1; } }
            }
        }
    }
};
template <class Epi, class Sched, bool ALIGN_EPI = false, bool SP2 = false>
__device__ __forceinline__ void gemm_phase(PG8_LAS unsigned char* lds, const Gemm g, const Sched& S, const Epi& E, unsigned long long* tepi = nullptr) {
    int tid_ = threadIdx.x; asm volatile("" : "+v"(tid_));
    const int tid = tid_, wid = __builtin_amdgcn_readfirstlane(tid >> 6), lane = tid & 63, wr = wid >> 2, wc = wid & 3, fr = lane & 15, fq = lane >> 4;
    const int K = g.K, nt = K / BK;
    unsigned voffA[2], voffB[2];
#pragma unroll
    for (int i = 0; i < 2; ++i) { int R, C; stage_rc(tid * 16 + i * 8192, R, C); const int Rb = Epi::PERM ? ((R & ~31) + perm32(R & 31)) : R;
        voffA[i] = (unsigned)(R * K + C) * 2u; voffB[i] = (unsigned)(Rb * K + C) * 2u; }
    const size_t kstep = (size_t)(BK * 2);
    const size_t hstep = (size_t)HALF * K * 2;
    const size_t tstep = 2 * hstep;
    const unsigned ldsw = (unsigned)wid * 1024u;
    const int aoff = lds_byte(wr * 64 + fr, fq * 8), boff = lds_byte(wc * 32 + fr, fq * 8);
#define PG8_SA(b, h) (((b) * 2 + (h)) * HTB)
#define PG8_SB(b, h) ((4 + (b) * 2 + (h)) * HTB)
#define PG8_STAGE(bufoff, gbase, voff) do { _Pragma("unroll") for (int _i = 0; _i < 2; ++_i) \
        __builtin_amdgcn_global_load_lds((const unsigned*)((const char*)(gbase) + (voff)[_i]), (PG8_LAS unsigned*)(lds + (bufoff) + ldsw + _i * 8192), 16, 0, 0); } while (0)
#define PG8_LDA(dst, b, h) do { _Pragma("unroll") for (int m = 0; m < 4; ++m) _Pragma("unroll") for (int k = 0; k < 2; ++k) dst[m][k] = *(const PG8_LAS bf16x8*)(lds + PG8_SA(b, h) + aoff + m * 2048 + k * 1024); } while (0)
#define PG8_LDB(dst, b, h) do { _Pragma("unroll") for (int n = 0; n < 2; ++n) _Pragma("unroll") for (int k = 0; k < 2; ++k) dst[n][k] = *(const PG8_LAS bf16x8*)(lds + PG8_SB(b, h) + boff + n * 2048 + k * 1024); } while (0)
#define PG8_MMA(ai, bj, At, Bt) do { __builtin_amdgcn_s_setprio(1); _Pragma("unroll") for (int m = 0; m < 4; ++m) _Pragma("unroll") for (int n = 0; n < 2; ++n) _Pragma("unroll") for (int k = 0; k < 2; ++k) \
        acc[ai][bj][m][n] = __builtin_amdgcn_mfma_f32_16x16x32_bf16(Bt[n][k], At[m][k], acc[ai][bj][m][n], 0, 0, 0); __builtin_amdgcn_s_setprio(0); } while (0)
#define PG8_WAIT_V(n) asm volatile("s_waitcnt vmcnt(" #n ")" ::: "memory")
#define PG8_WAIT_L(n) asm volatile("s_waitcnt lgkmcnt(" #n ")" ::: "memory")
#define PG8_BAR __builtin_amdgcn_s_barrier()
#define PG8_SCHED __builtin_amdgcn_sched_barrier(0)
    Unit cur, nxt; int ui = 0;
    if (!S.next(0, cur)) return;
    f32x4 acc[2][2][4][2];
#pragma unroll
    for (int a = 0; a < 2; ++a)
#pragma unroll
        for (int b = 0; b < 2; ++b)
#pragma unroll
            for (int m = 0; m < 4; ++m)
#pragma unroll
                for (int n = 0; n < 2; ++n) acc[a][b][m][n] = (f32x4){0.f, 0.f, 0.f, 0.f};
    bf16x8 At[4][2], B0[2][2], B1[2][2];
    const char* cA = (const char*)g.A + (size_t)cur.pm * tstep; const char* cB = (const char*)g.Bt + (size_t)cur.pn * tstep;
    S.a_ready(cur);
    if constexpr (SP2) {
        PG8_STAGE(PG8_SB(0, 0), cB, voffB); PG8_STAGE(PG8_SB(0, 1), cB + hstep, voffB); PG8_STAGE(PG8_SA(0, 0), cA, voffA); PG8_STAGE(PG8_SA(0, 1), cA + hstep, voffA);
        if (wr == 1) PG8_BAR;
        PG8_WAIT_V(2); PG8_BAR;
        PG8_STAGE(PG8_SB(1, 0), cB + kstep, voffB); PG8_STAGE(PG8_SA(1, 0), cA + kstep, voffA); PG8_STAGE(PG8_SB(1, 1), cB + hstep + kstep, voffB);
        PG8_WAIT_V(6); PG8_BAR;
    } else {
        PG8_STAGE(PG8_SB(0, 0), cB, voffB); PG8_STAGE(PG8_SA(0, 0), cA, voffA); PG8_STAGE(PG8_SB(0, 1), cB + hstep, voffB); PG8_STAGE(PG8_SA(0, 1), cA + hstep, voffA);
        if (wr == 1) PG8_BAR;
        PG8_WAIT_V(4); PG8_BAR;
        PG8_STAGE(PG8_SB(1, 0), cB + kstep, voffB); PG8_STAGE(PG8_SA(1, 0), cA + kstep, voffA); PG8_STAGE(PG8_SB(1, 1), cB + hstep + kstep, voffB);
        PG8_WAIT_V(6); PG8_BAR;
    }
    for (;;) {
        const bool has_next = S.next(ui + 1, nxt);
        const char* nA = has_next ? (const char*)g.A + (size_t)nxt.pm * tstep : cA; const char* nB = has_next ? (const char*)g.Bt + (size_t)nxt.pn * tstep : cB;
        for (int t = 0; t < nt; t += 2) {
            const bool last = (t == nt - 2);
            const char* a1 = cA + (size_t)(t + 1) * kstep;
            const char* a2 = last ? nA : cA + (size_t)(t + 2) * kstep; const char* b2 = last ? nB : cB + (size_t)(t + 2) * kstep;
            const char* a3 = a2 + kstep; const char* b3 = b2 + kstep;
            if (last && has_next) S.a_ready(nxt);
            if constexpr (SP2) {
            PG8_LDB(B0, 0, 0); PG8_LDB(B1, 0, 1); PG8_SCHED; PG8_LDA(At, 0, 0); PG8_STAGE(PG8_SA(1, 1), a1 + hstep, voffA);
            PG8_WAIT_V(8); PG8_WAIT_L(0); PG8_BAR; PG8_MMA(0, 0, At, B0); PG8_MMA(0, 1, At, B1); PG8_BAR; PG8_SCHED;
            PG8_LDA(At, 0, 1); PG8_STAGE(PG8_SB(0, 0), b2, voffB); PG8_STAGE(PG8_SB(0, 1), b2 + hstep, voffB); PG8_STAGE(PG8_SA(0, 0), a2, voffA);
            PG8_WAIT_V(8); PG8_WAIT_L(0); PG8_BAR; PG8_MMA(1, 0, At, B0); PG8_MMA(1, 1, At, B1); PG8_BAR; PG8_SCHED;
            PG8_LDB(B0, 1, 0); PG8_LDB(B1, 1, 1); PG8_SCHED; PG8_LDA(At, 1, 0); PG8_STAGE(PG8_SA(0, 1), a2 + hstep, voffA);
            PG8_WAIT_V(8); PG8_WAIT_L(0); PG8_BAR; PG8_MMA(0, 0, At, B0); PG8_MMA(0, 1, At, B1); PG8_BAR; PG8_SCHED;
            PG8_LDA(At, 1, 1); PG8_STAGE(PG8_SB(1, 0), b3, voffB); PG8_STAGE(PG8_SB(1, 1), b3 + hstep, voffB); PG8_STAGE(PG8_SA(1, 0), a3, voffA);
            PG8_WAIT_V(8); PG8_WAIT_L(0); PG8_BAR; PG8_MMA(1, 0, At, B0); PG8_MMA(1, 1, At, B1); PG8_BAR; PG8_SCHED;
            } else {
            PG8_LDB(B0, 0, 0); PG8_SCHED; PG8_LDA(At, 0, 0); PG8_STAGE(PG8_SA(1, 1), a1 + hstep, voffA);
            PG8_WAIT_L(8); PG8_BAR; PG8_WAIT_L(0); PG8_MMA(0, 0, At, B0); PG8_BAR; PG8_SCHED;
            PG8_LDB(B1, 0, 1); PG8_STAGE(PG8_SB(0, 0), b2, voffB);
            PG8_BAR; PG8_WAIT_L(0); PG8_MMA(0, 1, At, B1); PG8_BAR;
            PG8_LDA(At, 0, 1); PG8_STAGE(PG8_SA(0, 0), a2, voffA);
            PG8_BAR; PG8_WAIT_L(0); PG8_MMA(1, 0, At, B0); PG8_BAR; PG8_SCHED;
            PG8_STAGE(PG8_SB(0, 1), b2 + hstep, voffB);
            PG8_WAIT_V(6); PG8_BAR; PG8_MMA(1, 1, At, B1); PG8_BAR;
            PG8_LDB(B0, 1, 0); PG8_SCHED; PG8_LDA(At, 1, 0); PG8_STAGE(PG8_SA(0, 1), a2 + hstep, voffA);
            PG8_WAIT_L(8); PG8_BAR; PG8_WAIT_L(0); PG8_MMA(0, 0, At, B0); PG8_BAR; PG8_SCHED;
            PG8_LDB(B1, 1, 1); PG8_STAGE(PG8_SB(1, 0), b3, voffB);
            PG8_BAR; PG8_WAIT_L(0); PG8_MMA(0, 1, At, B1); PG8_BAR;
            PG8_LDA(At, 1, 1); PG8_STAGE(PG8_SA(1, 0), a3, voffA);
            PG8_BAR; PG8_WAIT_L(0); PG8_MMA(1, 0, At, B0); PG8_BAR; PG8_SCHED;
            PG8_STAGE(PG8_SB(1, 1), b3 + hstep, voffB);
            PG8_WAIT_V(6); PG8_BAR; PG8_MMA(1, 1, At, B1); PG8_BAR;
            }
        }
        if constexpr (ALIGN_EPI) { if (wr == 0) PG8_BAR; }
        if constexpr (!Epi::AFTER_DRAIN) { unsigned long long te0_ = 0; if (tepi) te0_ = __builtin_amdgcn_s_memrealtime(); E(acc, cur, wr, wc, fr, fq); S.done(cur); if (tepi) *tepi += __builtin_amdgcn_s_memrealtime() - te0_; }
        if (!has_next) break;
#pragma unroll
        for (int a = 0; a < 2; ++a)
#pragma unroll
            for (int b = 0; b < 2; ++b)
#pragma unroll
                for (int m = 0; m < 4; ++m)
#pragma unroll
                    for (int n = 0; n < 2; ++n) acc[a][b][m][n] = (f32x4){0.f, 0.f, 0.f, 0.f};
        cur = nxt; cA = nA; cB = nB; ++ui;
        if constexpr (ALIGN_EPI) { if (wr == 1) PG8_BAR; }
    }
    PG8_WAIT_V(0);
    if constexpr (!ALIGN_EPI) { if (wr == 0) PG8_BAR; }
    PG8_BAR;
    if constexpr (Epi::AFTER_DRAIN) { E.fused(acc, cur, wr, wc, fr, fq, lds, wid, lane); S.done(cur); }
#undef PG8_SA
#undef PG8_SB
#undef PG8_STAGE
#undef PG8_LDA
#undef PG8_LDB
#undef PG8_MMA
#undef PG8_WAIT_V
#undef PG8_WAIT_L
#undef PG8_BAR
#undef PG8_SCHED
}
}
#define GAS __attribute__((address_space(1)))
#define LAS __attribute__((address_space(3)))
typedef unsigned short bf16;
typedef unsigned v4u __attribute__((ext_vector_type(4)));
typedef float f32x4 __attribute__((ext_vector_type(4)));
typedef short bf16x8 __attribute__((ext_vector_type(8)));
typedef GAS unsigned gu32;
typedef GAS unsigned long long gu64;
#define RLX_AGENT __ATOMIC_RELAXED, __HIP_MEMORY_SCOPE_AGENT
#define LDS_WAIT() asm volatile("s_waitcnt lgkmcnt(0)" ::: "memory")
#define VM_WAIT() asm volatile("s_waitcnt vmcnt(0)" ::: "memory")
__device__ __forceinline__ unsigned long long rt() { return __builtin_amdgcn_s_memrealtime(); }
__device__ __forceinline__ unsigned f2bf(float f) { unsigned u = __builtin_bit_cast(unsigned, f); return (u + 0x7fffu + ((u >> 16) & 1u)) >> 16; }
__device__ __forceinline__ unsigned pk2(float lo, float hi) { return f2bf(lo) | (f2bf(hi) << 16); }

#define XB_TMO      128
#define XB_XCNT(j)  (256  + 64 * (j))
#define XB_XSUB(j)  (1280 + 64 * (j))
#define XB_XGEN(j)  (2304 + 64 * (j))
#define XB_TOP      3328
#define XB_TOPGEN   3392
#define XCD_BAR_WORDS 3456
#define XB_SPIN_CAP (1u << 18)

__device__ __forceinline__ unsigned xb_ld(unsigned* p)              { return __hip_atomic_load(p, __ATOMIC_RELAXED, __HIP_MEMORY_SCOPE_AGENT); }
__device__ __forceinline__ unsigned xb_add(unsigned* p, unsigned v) { return __hip_atomic_fetch_add(p, v, __ATOMIC_RELAXED, __HIP_MEMORY_SCOPE_AGENT); }
__device__ __forceinline__ unsigned xb_xcc_id() { return (unsigned)__builtin_amdgcn_s_getreg((3 << 11) | 20) & 0xFu; }
#define XB_SPIN(cond, bar) do { unsigned _sp = 0; while (cond) { __builtin_amdgcn_s_sleep(1); \
    if ((++_sp & 255u) == 0u) { if (xb_ld(&(bar)[XB_TMO])) break; if (_sp > XB_SPIN_CAP) { atomicAdd(&(bar)[XB_TMO], 1u); break; } } } } while (0)

struct XcdBarrier {
    unsigned* bar; unsigned x;
    volatile LAS unsigned* st;
};

__device__ __forceinline__ XcdBarrier xcd_barrier_post(unsigned* bar, volatile LAS unsigned* st) {
    XcdBarrier b; b.bar = bar; b.x = xb_xcc_id(); b.st = st;
    if (threadIdx.x == 0) (void)xb_add(&bar[XB_XCNT(b.x)], 1u);
    return b;
}
__device__ __forceinline__ void xcd_barrier_complete(unsigned* bar, unsigned x, unsigned& nloc, unsigned& nx) {
    const unsigned G = gridDim.x * gridDim.y * gridDim.z;
    unsigned sum, cnt, mine, sp = 0u;
    for (;;) {
        sum = 0u; cnt = 0u; mine = 0u;
#pragma unroll
        for (unsigned j = 0; j < 16; ++j) { const unsigned c = xb_ld(&bar[XB_XCNT(j)]); sum += c; cnt += (c > 0u) ? 1u : 0u; mine = (j == x) ? c : mine; }
        if (sum == G) break;
        __builtin_amdgcn_s_sleep(1);
        if ((++sp & 255u) == 0u) { if (xb_ld(&bar[XB_TMO])) break; if (sp > XB_SPIN_CAP) { atomicAdd(&bar[XB_TMO], 1u); break; } }
    }
    nloc = mine > 0u ? mine : 1u; nx = cnt > 0u ? cnt : 1u;
}

__device__ __forceinline__ void xcd_barrier(const XcdBarrier& b) {
    asm volatile("s_waitcnt vmcnt(0)" ::: "memory");
    __syncthreads();
    if (threadIdx.x == 0) {
        unsigned* bar = b.bar;
        __builtin_amdgcn_s_waitcnt(0);
        unsigned nloc = b.st[0], nx = b.st[1];
        if (nloc == 0u) { xcd_barrier_complete(bar, b.x, nloc, nx); b.st[0] = nloc; b.st[1] = nx; }
        const unsigned old = xb_add(&bar[XB_XSUB(b.x)], 1u);
        const unsigned gen = old / nloc;
        if (old + 1u == (gen + 1u) * nloc) {
            __builtin_amdgcn_fence(__ATOMIC_RELEASE, "agent");
            asm volatile("s_waitcnt vmcnt(0)" ::: "memory");
            const unsigned og = xb_add(&bar[XB_TOP], 1u);
            const unsigned tg = og / nx;
            if (og + 1u == (tg + 1u) * nx) xb_add(&bar[XB_TOPGEN], 1u);
            else XB_SPIN(xb_ld(&bar[XB_TOPGEN]) == tg, bar);
            __builtin_amdgcn_fence(__ATOMIC_ACQUIRE, "agent");
            xb_add(&bar[XB_XGEN(b.x)], 1u);
            asm volatile("s_waitcnt vmcnt(0)" ::: "memory");
        } else {
            XB_SPIN(xb_ld(&bar[XB_XGEN(b.x)]) == gen, bar);
            __builtin_amdgcn_fence(__ATOMIC_ACQUIRE, "agent");
            asm volatile("s_waitcnt vmcnt(0)" ::: "memory");
        }
    }
    __syncthreads();
}
constexpr int NWAVES = 8;
#ifndef WGM_P1
#define WGM_P1 8
#endif
#ifndef WGM_P4
#define WGM_P4 4
#endif
constexpr int DM = 1024, SEQ = 16384, NB = 16, MS = NB * 64, M = SEQ + MS;
constexpr int NIN_A = 2304, NIN_B = 4096;
constexpr float EPS = 1e-6f, LOG2E = 1.4426950408889634f, C2 = 0.125f * 1.4426950408889634f;
constexpr size_t O_Y = 0, O_KAP = 17825792, O_VAP = 17842176, O_KBP = 17858560, O_VBP = 18382848, O_KAS = 18907136, O_VAS = 19169280, O_KBS = 19431424, O_VBS = 27820032, O_END = 36208640;
constexpr size_t KiB = 1024, MiB = 1u << 20;
constexpr size_t WS_CTL = 0, CTL_ZERO_BYTES = 256 * KiB;
constexpr size_t WS_WINA = 256 * KiB;
constexpr size_t WS_WOUTA = WS_WINA + (size_t)NIN_A * DM * 2;
constexpr size_t WS_WINB = WS_WOUTA + (size_t)DM * DM * 2;
constexpr size_t WS_WOUTB = WS_WINB + (size_t)NIN_B * DM * 2;
constexpr size_t WS_SLAB = WS_WOUTB + (size_t)DM * DM * 2;
constexpr size_t ACT = (size_t)M * DM * 2;
constexpr size_t WS_XN = 18 * MiB;
constexpr size_t WS_QA = WS_XN + ACT;
constexpr size_t WS_GA = WS_QA + ACT, WS_KA = WS_GA + ACT, WS_VA = WS_KA + (size_t)M * 128 * 2;
constexpr size_t WS_QB = WS_GA;
constexpr size_t WS_KB = WS_QB + ACT, WS_VB = WS_KB + ACT, WS_GB = WS_VB + ACT;
constexpr size_t WS_CKA = WS_GB + ACT, WS_CVA = WS_CKA + (size_t)NB * 128 * 128 * 2, WS_CKB = WS_CVA + (size_t)NB * 128 * 128 * 2, WS_CVB = WS_CKB + (size_t)NB * 512 * 1024 * 2;
constexpr size_t WS_END = WS_CVB + (size_t)NB * 512 * 1024 * 2;
static_assert(WS_SLAB + (size_t)M * 16 * 4 <= WS_XN && WS_VA + (size_t)M * 128 * 2 <= WS_CKA && WS_QB >= WS_QA + ACT && WS_END <= 256 * MiB, "d_ws map");
constexpr int CW_KMAX_A = 64, CW_KMAX_B = 128;
constexpr int CW_BAR = 4096;
constexpr int RING_OFF = 0, RING_BYTES = 131072;
constexpr int PHASE_BYTES = 159744;
constexpr int LDSCTL_OFF = PHASE_BYTES, MISC_OFF = LDSCTL_OFF + 320;
constexpr int LDS_BYTES = 163840;
constexpr int AT_NS = 4;
constexpr int AT_SLOT = 0, AT_SLOTB = 16384  , AT_TAB = AT_NS * AT_SLOTB, AT_TABB = 49152, AT_WSF = AT_TAB + AT_TABB, AT_OST = AT_WSF + NWAVES * 256, AT_END = AT_OST + NWAVES * 4096;
static_assert(AT_END <= PHASE_BYTES && MISC_OFF + 128 <= LDS_BYTES, "attention LDS map");

#ifndef PROBE_SEG
#define PROBE_SEG 0
#endif
#ifndef PROBE_LAYER
#define PROBE_LAYER 1
#endif
#if PROBE_SEG
#define KSEG_BEGIN(s) unsigned long long ks_t0_##s = 0; if (PROBE_SEG == (s)) ks_t0_##s = __builtin_amdgcn_s_memrealtime();
#define KSEG_END(s) if (PROBE_SEG == (s)) F.tacc += __builtin_amdgcn_s_memrealtime() - ks_t0_##s;
#define PSEG_BEGIN(s) unsigned long long ps_t0_##s = 0; if (PROBE_SEG == (s) && LAYER == PROBE_LAYER) ps_t0_##s = __builtin_amdgcn_s_memrealtime();
#define PSEG_END(s) if (PROBE_SEG == (s) && LAYER == PROBE_LAYER) F.tacc += __builtin_amdgcn_s_memrealtime() - ps_t0_##s;
#else
#define PSEG_BEGIN(s)
#define PSEG_END(s)
#define KSEG_BEGIN(s)
#define KSEG_END(s)
#endif
struct Frame {
    unsigned long long tacc;
    LAS unsigned char* lds;
    volatile LAS unsigned* MISC;
    gu32* ctl;
    int tid, lane, wave;
    int vcu, G;
};
struct Args { const float* in[19]; float* out; unsigned char* ws; };

__device__ __forceinline__ float wave_sum(float v) {
#pragma unroll
    for (int o = 1; o < 64; o <<= 1) v += __shfl_xor(v, o);
    return v;
}
__device__ __forceinline__ float wave_max(float v) {
#pragma unroll
    for (int o = 1; o < 64; o <<= 1) v = fmaxf(v, __shfl_xor(v, o));
    return v;
}
__device__ __forceinline__ int phys_col(int c) { return (c & ~255) | (((c >> 5) & 1) << 7) | (((c >> 6) & 3) << 5) | (c & 31); }

__device__ __forceinline__ void p0_transpose_item(const float* W, int K, int N, bf16* WT, bool permute, const float* gain, LAS float* scr, int item, int lane) {
    const int nblk = N / 32, kb = item / nblk, nb = item % nblk, k0 = 64 * kb, n0 = 32 * nb;
    const float* src = W + (size_t)(k0 + (lane >> 5)) * N + n0 + (lane & 31);
    float w[32];
#pragma unroll
    for (int i = 0; i < 32; ++i) w[i] = __builtin_nontemporal_load(src + (size_t)(2 * i) * N);
    if (gain) {
#pragma unroll
        for (int i = 0; i < 32; ++i) w[i] *= gain[k0 + 2 * i + (lane >> 5)]; }
#pragma unroll
    for (int i = 0; i < 32; ++i) scr[(2 * i + (lane >> 5)) * 33 + (lane & 31)] = w[i];
    LDS_WAIT(); asm volatile("" ::: "memory");
    const int c = lane & 7;
    const int r0 = permute ? phys_col(n0) : n0;
#pragma unroll
    for (int j = 0; j < 4; ++j) { const int n = (lane >> 3) + 8 * j; const LAS float* s = scr + (8 * c) * 33 + n;
        v4u o; o.x = pk2(s[0 * 33], s[1 * 33]); o.y = pk2(s[2 * 33], s[3 * 33]); o.z = pk2(s[4 * 33], s[5 * 33]); o.w = pk2(s[6 * 33], s[7 * 33]);
        *(GAS v4u*)(WT + (size_t)(r0 + n) * K + k0 + 8 * c) = o; }
    LDS_WAIT(); asm volatile("" ::: "memory");
}
struct Row4 { f32x4 v[4]; };
__device__ __forceinline__ void row_load(Row4& r, const float* p, int lane) {
#pragma unroll
    for (int j = 0; j < 4; ++j) r.v[j] = __builtin_nontemporal_load((const GAS f32x4*)p + lane + 64 * j); }
__device__ __forceinline__ void row_store_bf16(const Row4& r, bf16* o, int lane) {
#pragma unroll
    for (int j = 0; j < 4; ++j) ((GAS unsigned long long*)o)[lane + 64 * j] = (unsigned long long)pk2(r.v[j].x, r.v[j].y) | ((unsigned long long)pk2(r.v[j].z, r.v[j].w) << 32); }
__device__ __forceinline__ void row_store_f32(const Row4& r, float* o, int lane) {
#pragma unroll
    for (int j = 0; j < 4; ++j) __builtin_nontemporal_store(r.v[j], (GAS f32x4*)o + lane + 64 * j); }
__device__ __forceinline__ const float* x_row(const Args& a, int m) { return m < SEQ ? a.in[0] + (size_t)m * DM : a.in[1] + (size_t)(m - SEQ) * DM; }
__device__ __forceinline__ void rms_finish(Row4& r, const Row4& g, bf16* o, int lane) {
    float s = 0.f;
#pragma unroll
    for (int j = 0; j < 4; ++j) s += (r.v[j].x * r.v[j].x + r.v[j].y * r.v[j].y) + (r.v[j].z * r.v[j].z + r.v[j].w * r.v[j].w);
    const float rs = rsqrtf(wave_sum(s) * (1.f / DM) + EPS);
#pragma unroll
    for (int j = 0; j < 4; ++j) r.v[j] = r.v[j] * rs * g.v[j];
    row_store_bf16(r, o, lane);
}
__device__ __forceinline__ float row_maxnorm2(const Row4& r) {
    float qm = 0.f;
#pragma unroll
    for (int j = 0; j < 4; ++j) { float q = (r.v[j].x * r.v[j].x + r.v[j].y * r.v[j].y) + (r.v[j].z * r.v[j].z + r.v[j].w * r.v[j].w);
#pragma unroll
        for (int d = 1; d < 16; d <<= 1) q += __shfl_xor(q, d);
        qm = fmaxf(qm, q); }
    return qm;
}
__device__ __forceinline__ void cache_rows_a(const float* srck, const float* srcv, bf16* dbk, bf16* dbv, float* dok, float* dov, int row, gu32* kmax, int lane) {
    constexpr int L = 128, W = 128;
    const int b = row / L, j = row % L;
    const size_t so = (size_t)row * W, oo = ((size_t)b * L + (j - 64)) * W;
    const float k0 = srck[so + 2 * lane], k1 = srck[so + 2 * lane + 1], v0 = srcv[so + 2 * lane], v1 = srcv[so + 2 * lane + 1];
    ((GAS unsigned*)(dbk + so))[lane] = pk2(k0, k1); ((GAS unsigned*)(dbv + so))[lane] = pk2(v0, v1);
    if (j >= 64) { dok[oo + 2 * lane] = k0; dok[oo + 2 * lane + 1] = k1; dov[oo + 2 * lane] = v0; dov[oo + 2 * lane + 1] = v1; }
    float q = k0 * k0 + k1 * k1;
#pragma unroll
    for (int d = 1; d < 32; d <<= 1) q += __shfl_xor(q, d);
    q = fmaxf(q, __shfl_xor(q, 32));
    if (lane == 0) __hip_atomic_fetch_max(kmax, __float_as_uint(q), __ATOMIC_RELAXED, __HIP_MEMORY_SCOPE_AGENT);
}
__device__ __forceinline__ void p0_prologue(Frame& F, const Args& a) {
    LAS float* scr = (LAS float*)(F.lds + RING_OFF + F.wave * 16384);
    const int gw = F.vcu * NWAVES + F.wave, NGW = F.G * NWAVES, lane = F.lane;
    unsigned char* ws = a.ws;
    bf16* XN = (bf16*)(ws + WS_XN);
    {
        Row4 g, a0, a1, b0, b1; row_load(g, a.in[7], lane);
        const int S = NGW;
        int m = gw;
#define XLOAD(R0, R1, mm) do { if ((mm) < M) row_load(R0, x_row(a, (mm)), lane); if ((mm) + S < M) row_load(R1, x_row(a, (mm) + S), lane); } while (0)
#define XFIN(R0, R1, mm) do { if ((mm) < M) rms_finish(R0, g, XN + (size_t)(mm) * DM, lane); if ((mm) + S < M) rms_finish(R1, g, XN + (size_t)((mm) + S) * DM, lane); } while (0)
        XLOAD(a0, a1, m);
        for (; m < M; m += 4 * S) {
            XLOAD(b0, b1, m + 2 * S);
            XFIN(a0, a1, m);
            XLOAD(a0, a1, m + 4 * S);
            XFIN(b0, b1, m + 2 * S);
        }
#undef XLOAD
#undef XFIN
    }
    constexpr int I_INA = (DM / 64) * (NIN_A / 32);
    for (int it = gw; it < I_INA; it += NGW) p0_transpose_item(a.in[8], DM, NIN_A, (bf16*)(ws + WS_WINA), true, nullptr, scr, it, lane);
    for (int r = gw; r < NB * 128; r += NGW)
        cache_rows_a(a.in[2], a.in[3], (bf16*)(ws + WS_CKA), (bf16*)(ws + WS_CVA), a.out + O_KAS, a.out + O_VAS, r, F.ctl + CW_KMAX_A, lane);
}
__device__ __forceinline__ void side_weights(Frame& F, const Args& a, int w, int nw) {
    LAS float* scr = (LAS float*)(F.lds + RING_OFF + F.wave * 16384);
    unsigned char* ws = a.ws;
    constexpr int I_O = (DM / 64) * (DM / 32), I_INB = (DM / 64) * (NIN_B / 32);
    for (int it = w; it < I_O + I_INB + I_O; it += nw) {
        int r = it;
        if (r < I_O) { p0_transpose_item(a.in[12], DM, DM, (bf16*)(ws + WS_WOUTA), false, nullptr, scr, r, F.lane); continue; } r -= I_O;
        if (r < I_INB) { p0_transpose_item(a.in[14], DM, NIN_B, (bf16*)(ws + WS_WINB), true, a.in[13], scr, r, F.lane); continue; } r -= I_INB;
        p0_transpose_item(a.in[18], DM, DM, (bf16*)(ws + WS_WOUTB), false, nullptr, scr, r, F.lane);
    }
}
__device__ __forceinline__ void side_cache_b_conv(Frame& F, const Args& a, int w, int nw, int r_lo, int r_hi) {
    unsigned char* ws = a.ws; const int lane = F.lane;
    const float* srck = a.in[4]; const float* srcv = a.in[5];
    bf16* dbk = (bf16*)(ws + WS_CKB); bf16* dbv = (bf16*)(ws + WS_CVB); float* dok = a.out + O_KBS; float* dov = a.out + O_VBS;
    const int NR = r_hi;
    Row4 ka, va, kb, vb; float qm = 0.f;
#define CB_LOAD(K_, V_, r) do { row_load(K_, srck + (size_t)(r) * DM, lane); row_load(V_, srcv + (size_t)(r) * DM, lane); } while (0)
#define CB_FIN(K_, V_, r) do { const size_t so_ = (size_t)(r) * DM; row_store_bf16(K_, dbk + so_, lane); row_store_bf16(V_, dbv + so_, lane); \
        if (((r) & 511) >= 64) { const size_t oo_ = so_ - 64 * DM; row_store_f32(K_, dok + oo_, lane); row_store_f32(V_, dov + oo_, lane); }     \
        qm = fmaxf(qm, row_maxnorm2(K_)); } while (0)
    int r = r_lo + w;
    if (r < NR) CB_LOAD(ka, va, r);
    for (; r < NR; r += 2 * nw) {
        const int r1 = r + nw, r2 = r + 2 * nw;
        if (r1 < NR) CB_LOAD(kb, vb, r1);
        CB_FIN(ka, va, r);
        if (r2 < NR) CB_LOAD(ka, va, r2);
        if (r1 < NR) CB_FIN(kb, vb, r1);
    }
#undef CB_LOAD
#undef CB_FIN
    qm = wave_max(qm);
    if (lane == 0) __hip_atomic_fetch_max(F.ctl + CW_KMAX_B, __float_as_uint(qm), __ATOMIC_RELAXED, __HIP_MEMORY_SCOPE_AGENT);
}
__device__ __forceinline__ void side_cache_b_copy(Frame& F, const Args& a, int w, int nw, int r_lo, int r_hi) {
    const int lane = F.lane;
    const float* srck = a.in[4]; const float* srcv = a.in[5]; float* dok = a.out + O_KBS; float* dov = a.out + O_VBS;
    const int NR = r_hi;
    Row4 ka, va, kb, vb;
#define CP_SRC(r) ((size_t)((r) / 448) * 512 + 64 + (r) % 448)
#define CP_DST(r) ((size_t)((r) / 448) * 512 + (r) % 448)
#define CP_LOAD(K_, V_, r) do { const size_t so_ = CP_SRC(r) * DM; row_load(K_, srck + so_, lane); row_load(V_, srcv + so_, lane); } while (0)
#define CP_FIN(K_, V_, r) do { const size_t oo_ = CP_DST(r) * DM; row_store_f32(K_, dok + oo_, lane); row_store_f32(V_, dov + oo_, lane); } while (0)
    int r = r_lo + w;
    if (r < NR) CP_LOAD(ka, va, r);
    for (; r < NR; r += 2 * nw) {
        const int r1 = r + nw, r2 = r + 2 * nw;
        if (r1 < NR) CP_LOAD(kb, vb, r1);
        CP_FIN(ka, va, r);
        if (r2 < NR) CP_LOAD(ka, va, r2);
        if (r1 < NR) CP_FIN(kb, vb, r1);
    }
#undef CP_SRC
#undef CP_DST
#undef CP_LOAD
#undef CP_FIN
}
template <int LAYER> __device__ __forceinline__ void tail_outproj(LAS unsigned char* lds, const bf16* A, const bf16* Bt, int c, const float* xs, bf16* yb, float* slab, float* out) {
    int tid_ = threadIdx.x; asm volatile("" : "+v"(tid_));
    const int tid = tid_, lane = tid & 63, wid = __builtin_amdgcn_readfirstlane(tid >> 6), fr = lane & 15, fq = lane >> 4;
    const int rb = c >> 4, cb = c & 15, row0 = SEQ + 64 * rb, col0 = 64 * cb;
    const bf16* ap = A + (size_t)(row0 + fr) * DM + 128 * wid + 8 * fq;
    const bf16* bp = Bt + (size_t)(col0 + fr) * DM + 128 * wid + 8 * fq;
    bf16x8 af[4][4], bfr[4][4];
#pragma unroll
    for (int m = 0; m < 4; ++m)
#pragma unroll
        for (int ks = 0; ks < 4; ++ks) { af[m][ks] = *(const GAS bf16x8*)(ap + (size_t)(16 * m) * DM + 32 * ks); bfr[m][ks] = *(const GAS bf16x8*)(bp + (size_t)(16 * m) * DM + 32 * ks); }
    f32x4 acc[4][4];
#pragma unroll
    for (int m = 0; m < 4; ++m)
#pragma unroll
        for (int n = 0; n < 4; ++n) { acc[m][n] = (f32x4){0.f, 0.f, 0.f, 0.f};
#pragma unroll
            for (int ks = 0; ks < 4; ++ks) acc[m][n] = __builtin_amdgcn_mfma_f32_16x16x32_bf16(bfr[n][ks], af[m][ks], acc[m][n], 0, 0, 0); }
    constexpr int PS = 68;
    LAS float* part = (LAS float*)lds + wid * (64 * PS);
#pragma unroll
    for (int m = 0; m < 4; ++m)
#pragma unroll
        for (int n = 0; n < 4; ++n) *(LAS f32x4*)(part + (16 * m + fr) * PS + 16 * n + 4 * fq) = acc[m][n];
    __syncthreads();
    const int r = tid >> 3, c8 = (tid & 7) * 8;
    f32x4 s0 = (f32x4){0.f, 0.f, 0.f, 0.f}, s1 = s0;
#pragma unroll
    for (int w = 0; w < 8; ++w) { const LAS float* p = (const LAS float*)lds + w * (64 * PS) + r * PS + c8; s0 += *(const LAS f32x4*)p; s1 += *(const LAS f32x4*)(p + 4); }
    const int row = row0 + r;
    if (LAYER == 1) {
        const v4u w = *(const GAS v4u*)(yb + (size_t)row * DM + col0 + c8);
        const f32x4 r0 = {__uint_as_float(w.x << 16), __uint_as_float(w.x & 0xffff0000u), __uint_as_float(w.y << 16), __uint_as_float(w.y & 0xffff0000u)};
        const f32x4 r1 = {__uint_as_float(w.z << 16), __uint_as_float(w.z & 0xffff0000u), __uint_as_float(w.w << 16), __uint_as_float(w.w & 0xffff0000u)};
        float* op = out + (size_t)row * DM + col0 + c8;
        *(GAS f32x4*)op = s0 + r0; *(GAS f32x4*)(op + 4) = s1 + r1;
        __syncthreads();
        return;
    }
    const float* xp = xs + (size_t)(row - SEQ) * DM + col0 + c8;
    const f32x4 y0 = s0 + *(const GAS f32x4*)xp, y1 = s1 + *(const GAS f32x4*)(xp + 4);
    v4u wv; wv.x = pk2(y0[0], y0[1]); wv.y = pk2(y0[2], y0[3]); wv.z = pk2(y1[0], y1[1]); wv.w = pk2(y1[2], y1[3]);
    *(GAS v4u*)(yb + (size_t)row * DM + col0 + c8) = wv;
    float ss = ((y0[0] * y0[0] + y0[1] * y0[1]) + (y0[2] * y0[2] + y0[3] * y0[3])) + ((y1[0] * y1[0] + y1[1] * y1[1]) + (y1[2] * y1[2] + y1[3] * y1[3]));
    ss += __shfl_xor(ss, 1); ss += __shfl_xor(ss, 2); ss += __shfl_xor(ss, 4);
    if ((tid & 7) == 0) slab[(size_t)row * 16 + cb] = ss;
    __syncthreads();
}

namespace attn {
using bf16x8 = __attribute__((ext_vector_type(8))) short;
using s16x4 = __attribute__((ext_vector_type(4))) short;
using f32x16 = __attribute__((ext_vector_type(16))) float;
using u32x4 = pg8::u32x4;
typedef short v4i16_t __attribute__((ext_vector_type(4)));
typedef __attribute__((address_space(3))) const char* lds_cptr;
__device__ __forceinline__ int crow(int r, int hi) { return (r & 3) + 8 * (r >> 2) + 4 * hi; }
__device__ __forceinline__ s16x4 vtr(lds_cptr p) { return __builtin_bit_cast(s16x4, __builtin_amdgcn_ds_read_tr16_b64_v4i16((__attribute__((address_space(3))) v4i16_t*)p)); }
typedef float f32x2_t __attribute__((ext_vector_type(2))); typedef __bf16 bf16x2_t __attribute__((ext_vector_type(2)));
__device__ __forceinline__ unsigned cvtpk(float lo, float hi) { f32x2_t v = {lo, hi}; bf16x2_t b = __builtin_convertvector(v, bf16x2_t); return __builtin_bit_cast(unsigned, b); }
__device__ __forceinline__ int t5_bucket(int rel) {
    const int n = rel < 0 ? -rel : rel;
    int b = n;
    if (n >= 8) b = 8 + (n >= 12) + (n >= 16) + (n >= 23) + (n >= 32) + (n >= 46) + (n >= 64) + (n >= 91);
    return b + (rel > 0 ? 16 : 0);
}
__device__ __forceinline__ void glds16(const void* gsrc, unsigned lds_dst) { unsigned keep;
    asm volatile("s_mov_b32 %0, m0\n\ts_mov_b32 m0, %2\n\ts_nop 0\n\tglobal_load_lds_dwordx4 %1, off\n\ts_mov_b32 m0, %0" : "=&s"(keep) : "v"(gsrc), "s"(lds_dst) : "memory"); }
__device__ __forceinline__ float bf2f(unsigned short h) { return __uint_as_float((unsigned)h << 16); }

template <int LAYER>
__device__ __forceinline__ void attn_phase(Frame& F, const Args& a) {
    constexpr int P = LAYER == 0 ? 2 : 8;
    constexpr int KVW = LAYER == 0 ? 128 : 1024;
    constexpr int L = P * 64;
    constexpr int RT0 = LAYER == 0 ? 0 : 6;
    unsigned char* ws = a.ws;
    const bf16* Q = (const bf16*)(ws + (LAYER == 0 ? WS_QA : WS_QB));
    const bf16* Kg = (const bf16*)(ws + (LAYER == 0 ? WS_KA : WS_KB));
    const bf16* Vg = (const bf16*)(ws + (LAYER == 0 ? WS_VA : WS_VB));
    const bf16* Gt = (const bf16*)(ws + (LAYER == 0 ? WS_GA : WS_GB));
    const bf16* CK = (const bf16*)(ws + (LAYER == 0 ? WS_CKA : WS_CKB));
    const bf16* CV = (const bf16*)(ws + (LAYER == 0 ? WS_CVA : WS_CVB));
    bf16* O = (bf16*)(ws + WS_XN);
    const float* qg = a.in[LAYER == 0 ? 9 : 15]; const float* kg = a.in[LAYER == 0 ? 10 : 16];
    const float* table = a.in[LAYER == 0 ? 6 : 17];
    int tid_ = threadIdx.x; asm volatile("" : "+v"(tid_));
    const int tid = tid_, lane = tid & 63, wid = __builtin_amdgcn_readfirstlane(tid >> 6), r32 = lane & 31, hi = lane >> 5;
    const int h = F.vcu >> 4, sub = F.vcu & 15;
    const int kvh = LAYER == 0 ? (h >> 3) : h;
    LAS unsigned char* lds = F.lds + RING_OFF;
    const int cw = wid >> 1, half = wid & 1;
    const unsigned lds0 = (unsigned)(size_t)lds;
#define UNIT_PARAMS(ui_, X) const bool X##sample = (ui_) == 4; const int X##u0 = 4 * (4 * sub + (ui_)); const int X##nt = X##sample ? P + 1 : P + 4; \
        const int X##tb = X##sample ? 0 : (X##u0 >= P ? 0 : P - X##u0); const bool X##won = !X##sample || cw == 0; \
        const size_t X##qtok = X##sample ? (size_t)SEQ + 64 * sub + 32 * half : (size_t)64 * (X##u0 + cw) + 32 * half;
#define TILE_DMA_U(X, t, slot_) do { const bf16 *kb_, *vb_; \
            if (!X##sample) { const size_t r0_ = (size_t)64 * (X##u0 - P + (t)) * KVW; kb_ = Kg + r0_; vb_ = Vg + r0_; } \
            else if ((t) < P) { const size_t r0_ = ((size_t)sub * L + 64 * (t)) * KVW; kb_ = CK + r0_; vb_ = CV + r0_; } \
            else { const size_t r0_ = ((size_t)SEQ + 64 * sub) * KVW; kb_ = Kg + r0_; vb_ = Vg + r0_; } \
            const unsigned s_ = (unsigned)__builtin_amdgcn_readfirstlane(lds0 + AT_SLOT + ((slot_) & 3) * AT_SLOTB + wid * 1024); \
            glds16(kb_ + koff, s_); glds16(vb_ + voff, s_ + 8192); } while (0)
#define Q_DMA_U(X) do { if (X##won) { _Pragma("unroll") for (int i_ = 0; i_ < 4; ++i_) glds16(Q + (X##qtok + 8 * i_ + (lane >> 3)) * DM + h * 64 + (lane & 7) * 8, (unsigned)__builtin_amdgcn_readfirstlane(lds0 + AT_OST + wid * 4096 + i_ * 1024)); } } while (0)
#define WAIT_BAR(N) asm volatile("s_waitcnt vmcnt(" #N ") lgkmcnt(0)\n\ts_barrier" ::: "memory")
    const size_t koff = (size_t)lane * KVW + kvh * 64 + wid * 8, voff = (size_t)(16 * (wid & 3) + (lane >> 2)) * KVW + kvh * 64 + (wid >> 2) * 32 + (lane & 3) * 8;
    int sb = 0;
    {
        UNIT_PARAMS(0, f_)
        Q_DMA_U(f_); TILE_DMA_U(f_, f_tb, 0); TILE_DMA_U(f_, f_tb + 1, 1);
    }
    PSEG_BEGIN(1) PSEG_BEGIN(5)
    constexpr int NBR = LAYER == 0 ? 32 : 257;
    LAS float* brow = (LAS float*)(lds + AT_WSF);
    for (int i = tid; i < NBR; i += NWAVES * 64) brow[i] = LAYER == 0 ? table[i * 16 + h] : table[h * 257 + i];
    const float gqa = fabsf(qg[lane]), gka = fabsf(kg[lane]);
    const unsigned kcb = __hip_atomic_load(F.ctl + (LAYER == 0 ? CW_KMAX_A : CW_KMAX_B), __ATOMIC_RELAXED, __HIP_MEMORY_SCOPE_AGENT);
    const float sinkv = LAYER == 0 ? a.in[11][h] : 0.f;
    __syncthreads();
    float bm = -1e30f;
    for (int i = lane; i < NBR; i += 64) bm = fmaxf(bm, brow[i]);
    bm = wave_max(bm);
    const float gqm = wave_max(gqa), gkm = wave_max(gka), kc = sqrtf(__uint_as_float(kcb));
    const float bound = gqm * fmaxf(8.f * gkm, kc) * 1.01f + bm;
    const float cconst = LAYER == 0 ? 0.f : (brow[256 % NBR] - bound) * LOG2E;
    const float sinkp = LAYER == 0 ? __builtin_amdgcn_exp2f((sinkv - bound) * LOG2E) : 0.f;
    {
        LAS float* tab = (LAS float*)(lds + AT_TAB);
        for (int i = tid; i < 3 * 2 * 8 * 64 * 4; i += NWAVES * 64) {
            const int e = i & 3, ln = (i >> 2) & 63, q4 = (i >> 8) & 7, half = (i >> 11) & 1, rtv = i >> 12;
            const int R = 4 * q4 + e, key = 32 * (R >> 4) + crow(R & 15, ln >> 5), qi = 32 * half + (ln & 31), j = 64 * (RT0 + rtv) + key;
            float bv;
            if (LAYER == 0) bv = brow[t5_bucket(j - (P * 64 + qi))];
            else { int idx = P * 64 + qi - j; idx = idx < -128 ? -128 : (idx > 128 ? 128 : idx); bv = brow[(idx + 128) % NBR]; }
            tab[i] = (bv - bound) * LOG2E;
        }
    }
    __syncthreads();
    f32x16 cc16;
#pragma unroll
    for (int r = 0; r < 16; ++r) cc16[r] = cconst;
    asm volatile("" : "+v"(cc16));
    PSEG_END(5)
    const lds_cptr lds3 = (lds_cptr)lds;
    const lds_cptr kp0 = lds3 + AT_SLOT + hi * 1024 + r32 * 16;
    const lds_cptr vp0 = lds3 + AT_SLOT + 8192 + ((lane >> 4) & 1) * 32 + (lane & 3) * 8 + (4 * hi + ((lane & 15) >> 2)) * 64;
    const LAS f32x4* tabl = (const LAS f32x4*)(lds + AT_TAB) + lane;
    LAS float* wsf = (LAS float*)(lds + AT_WSF) + wid * 64;
    for (int ui = 0; ui < 5; ++ui) {
        PSEG_BEGIN(2)
        UNIT_PARAMS(ui, c_)
        const bool sample = c_sample, wave_on = c_won, has_next = ui < 4; const int nt = c_nt, t_begin = c_tb; const size_t qtok = c_qtok;
        UNIT_PARAMS(ui + 1, n_)
        f32x16 o[2]; o[0] = f32x16{}; o[1] = f32x16{};
        float l_reg = 0.f;
        if (ui == 0) WAIT_BAR(2); else WAIT_BAR(4);
        PSEG_END(2) PSEG_BEGIN(3)
        bf16x8 qr[4];
#pragma unroll
        for (int d0 = 0; d0 < 4; ++d0) qr[d0] = *(const __attribute__((address_space(3))) bf16x8*)(lds3 + AT_OST + wid * 4096 + r32 * 128 + (2 * d0 + hi) * 16);
        u32x4 pw[4];
#pragma unroll
        for (int s = 0; s < 4; ++s) pw[s] = (u32x4){0u, 0u, 0u, 0u};
        v4u gpre[4];
#pragma unroll
        for (int i = 0; i < 4; ++i) gpre[i] = (v4u){0u, 0u, 0u, 0u};
#define STEP_HEAD(t) const int sl = (t) - t_begin + sb;                    \
            if ((t) + 2 < nt) TILE_DMA_U(c_, (t) + 2, sl + 2);             \
            if ((t) == nt - 1) { \
                if (wave_on) { _Pragma("unroll") for (int i = 0; i < 4; ++i) gpre[i] = *(const GAS v4u*)(Gt + (qtok + i * 8 + (lane >> 3)) * DM + h * 64 + (lane & 7) * 8); } \
                asm volatile("" ::: "memory"); \
                if (has_next) { Q_DMA_U(n_); TILE_DMA_U(n_, n_tb, sl + 1); } }     \
            if ((t) == nt && has_next) TILE_DMA_U(n_, n_tb + 1, sl + 1);
#define STEP_TAIL(t) if ((t) + 2 < nt) WAIT_BAR(2); else if ((t) + 2 == nt || !has_next) WAIT_BAR(0); else WAIT_BAR(63);
        const int a_lo = wave_on ? (cw > t_begin ? cw : t_begin) : nt + 1, a_hi = wave_on ? (cw + P + 1 < nt ? cw + P + 1 : nt) : nt;
        int t = t_begin;
        for (; t < a_lo && t <= nt; ++t) { STEP_HEAD(t) STEP_TAIL(t) }
        for (; t <= a_hi; ++t) {
            STEP_HEAD(t)
            const int rt = t - cw;
            {
                const bool last = rt == P + 1 || t == nt, first = rt == 0 || t == t_begin;
                const int rtb = last ? rt - 1 : rt;
                const int ko = ((last ? sl - 1 : sl) & 3) * AT_SLOTB, vo = ((first ? sl : sl - 1) & 3) * AT_SLOTB;
                const lds_cptr kp = kp0 + ko, vp = vp0 + vo;
                bf16x8 kf[8];
#pragma unroll
                for (int d0 = 0; d0 < 4; ++d0) { kf[2 * d0] = *(const __attribute__((address_space(3))) bf16x8*)(kp + d0 * 2048); kf[2 * d0 + 1] = *(const __attribute__((address_space(3))) bf16x8*)(kp + d0 * 2048 + 512); }
                f32x16 p0, p1;
                __builtin_amdgcn_s_setprio(1);
                if (rtb >= RT0) { const LAS f32x4* tp = tabl + ((rtb - RT0) * 2 + half) * 8 * 64;
                    const f32x16 t0 = __builtin_shufflevector(__builtin_shufflevector(tp[0], tp[64], 0, 1, 2, 3, 4, 5, 6, 7), __builtin_shufflevector(tp[128], tp[192], 0, 1, 2, 3, 4, 5, 6, 7), 0, 1, 2, 3, 4, 5, 6, 7, 8, 9, 10, 11, 12, 13, 14, 15);
                    const f32x16 t1 = __builtin_shufflevector(__builtin_shufflevector(tp[256], tp[320], 0, 1, 2, 3, 4, 5, 6, 7), __builtin_shufflevector(tp[384], tp[448], 0, 1, 2, 3, 4, 5, 6, 7), 0, 1, 2, 3, 4, 5, 6, 7, 8, 9, 10, 11, 12, 13, 14, 15);
                    p0 = __builtin_amdgcn_mfma_f32_32x32x16_bf16(kf[0], qr[0], t0, 0, 0, 0); p1 = __builtin_amdgcn_mfma_f32_32x32x16_bf16(kf[1], qr[0], t1, 0, 0, 0); }
                else { p0 = __builtin_amdgcn_mfma_f32_32x32x16_bf16(kf[0], qr[0], cc16, 0, 0, 0); p1 = __builtin_amdgcn_mfma_f32_32x32x16_bf16(kf[1], qr[0], cc16, 0, 0, 0); }
#pragma unroll
                for (int d0 = 1; d0 < 4; ++d0) { p0 = __builtin_amdgcn_mfma_f32_32x32x16_bf16(kf[2 * d0], qr[d0], p0, 0, 0, 0); p1 = __builtin_amdgcn_mfma_f32_32x32x16_bf16(kf[2 * d0 + 1], qr[d0], p1, 0, 0, 0); }
                bf16x8 vf[8];
#pragma unroll
                for (int i = 0; i < 8; ++i) { const s16x4 lo = vtr(vp + (i >> 2) * 4096 + (i & 3) * 1024), hh = vtr(vp + (i >> 2) * 4096 + (i & 3) * 1024 + 512); vf[i] = (bf16x8){lo[0], lo[1], lo[2], lo[3], hh[0], hh[1], hh[2], hh[3]}; }
#pragma unroll
                for (int ks = 0; ks < 4; ++ks) { o[0] = __builtin_amdgcn_mfma_f32_32x32x16_bf16(__builtin_bit_cast(bf16x8, pw[ks]), vf[ks], o[0], 0, 0, 0); o[1] = __builtin_amdgcn_mfma_f32_32x32x16_bf16(__builtin_bit_cast(bf16x8, pw[ks]), vf[4 + ks], o[1], 0, 0, 0); }
                __builtin_amdgcn_s_setprio(0);
                float sacc = 0.f;
#pragma unroll
                for (int r = 0; r < 16; ++r) { p0[r] = __builtin_amdgcn_exp2f(p0[r]); p1[r] = __builtin_amdgcn_exp2f(p1[r]); sacc += p0[r] + p1[r]; }
                l_reg += last ? 0.f : sacc;
#pragma unroll
                for (int s = 0; s < 2; ++s)
#pragma unroll
                    for (int i = 0; i < 4; ++i) { pw[s][i] = cvtpk(p0[8 * s + 2 * i], p0[8 * s + 2 * i + 1]); pw[2 + s][i] = cvtpk(p1[8 * s + 2 * i], p1[8 * s + 2 * i + 1]); }
            }
            STEP_TAIL(t)
        }
        for (; t <= nt; ++t) { STEP_HEAD(t) STEP_TAIL(t) }
#undef STEP_HEAD
#undef STEP_TAIL
        PSEG_END(3) PSEG_BEGIN(4)
#undef TILE_DMA
#undef WAIT_BAR
        if (wave_on) {
            l_reg += __shfl_xor(l_reg, 32);
            l_reg += sinkp;
            if (hi == 0) wsf[r32] = l_reg;
            LDS_WAIT(); asm volatile("" ::: "memory");
            LAS unsigned short* stg = (LAS unsigned short*)(lds + AT_SLOT + (((nt - 2 - t_begin + sb) + (wid >> 2)) & 3) * AT_SLOTB + (wid & 3) * 4096);
#pragma unroll
            for (int r = 0; r < 16; ++r) { const int orow = crow(r, hi); const float rl = __builtin_amdgcn_rcpf(wsf[orow]);
#pragma unroll
                for (int d0 = 0; d0 < 2; ++d0) stg[orow * 64 + d0 * 32 + r32] = (unsigned short)(f2bf(o[d0][r] * rl)); }
            LDS_WAIT(); asm volatile("" ::: "memory");
#pragma unroll
            for (int i = 0; i < 4; ++i) { const int row = i * 8 + (lane >> 3), ch = lane & 7;
                const v4u ov = *(const LAS v4u*)(stg + row * 64 + ch * 8);
                const size_t go = (qtok + row) * DM + h * 64 + ch * 8;
                const v4u gvv = gpre[i];
                v4u res;
#pragma unroll
                for (int e = 0; e < 4; ++e) { const float a0 = __uint_as_float(ov[e] << 16) * __uint_as_float(gvv[e] << 16), a1 = __uint_as_float(ov[e] & 0xffff0000u) * __uint_as_float(gvv[e] & 0xffff0000u); res[e] = cvtpk(a0, a1); }
                *(GAS v4u*)(O + go) = res; }
        }
        sb += nt - t_begin;
        PSEG_END(4)
    }
    __syncthreads();
    PSEG_END(1)
}
template <int NV> __device__ __forceinline__ void wait_bar_n(int n) {
#define WB_(N) case N: asm volatile("s_waitcnt vmcnt(" #N ") lgkmcnt(0)\n\ts_barrier" ::: "memory"); break;
    switch (n) { WB_(0) WB_(2) WB_(4) WB_(6) WB_(8) WB_(10) WB_(12) WB_(14) WB_(16) WB_(18) WB_(20) WB_(22) WB_(24) WB_(26) WB_(28) default: asm volatile("s_waitcnt vmcnt(0) lgkmcnt(0)\n\ts_barrier" ::: "memory"); break; }
#undef WB_
}
__device__ __forceinline__ void attn_phase_a(Frame& F, const Args& a) {
    constexpr int P = 2, KVW = 128, NCH = 272, NSL = 5, SLOTB = 16384;
    constexpr int A2_RING = 0, A2_TT = NSL * SLOTB, A2_WSF = A2_TT + 8192, A2_Q = A2_WSF + 3072, A2_OST = A2_Q + NWAVES * 4096, A2_END = A2_OST + NWAVES * 4096;
    static_assert(A2_Q % 1024 == 0 && A2_END <= PHASE_BYTES, "layer A attention LDS map");
    unsigned char* ws = a.ws;
    const bf16* Q = (const bf16*)(ws + WS_QA); const bf16* Kg = (const bf16*)(ws + WS_KA); const bf16* Vg = (const bf16*)(ws + WS_VA); const bf16* Gt = (const bf16*)(ws + WS_GA);
    const bf16* CK = (const bf16*)(ws + WS_CKA); const bf16* CV = (const bf16*)(ws + WS_CVA);
    bf16* O = (bf16*)(ws + WS_XN);
    const float* qg = a.in[9]; const float* kg = a.in[10]; const float* table = a.in[6];
    int tid_ = threadIdx.x; asm volatile("" : "+v"(tid_));
    const int tid = tid_, lane = tid & 63, wid = __builtin_amdgcn_readfirstlane(tid >> 6), r32 = lane & 31, hi = lane >> 5;
    const int combo = F.vcu >> 6, g = combo >> 1, half = combo & 1, cidx = F.vcu & 63;
    const int c_lo = (cidx * NCH) >> 6, c_hi = ((cidx + 1) * NCH) >> 6;
    const int h = 8 * g + wid;
    LAS unsigned char* lds = F.lds + RING_OFF;
    const unsigned lds0 = (unsigned)(size_t)lds;
    const lds_cptr lds3 = (lds_cptr)lds;
    const int cp_hi = c_hi < 256 ? c_hi : 256;
    const int a0 = c_lo >= 2 ? c_lo - 2 : 0;
    const int npt = c_lo < 256 ? (cp_hi - 1) - a0 + 1 : 0;
    const int cs_lo = c_lo > 256 ? c_lo : 256;
#define T0_OF(c) (((c) < 2) ? 2 - (c) : 0)
#define POS_OF(c, ti) ((c) < 256 ? ((c) - 2 + (ti)) - a0 : npt + 3 * ((c) - cs_lo) + (ti))
#define NEW_OF(c, ti) ((c) >= 256 || (c) == c_lo || (ti) == 2)
#define QTOK_OF(c) ((c) < 256 ? (size_t)64 * (c) + 32 * half : (size_t)SEQ + 64 * ((c) - 256) + 32 * half)
    const size_t koff = (size_t)lane * KVW + g * 64 + wid * 8, voff = (size_t)(16 * (wid & 3) + (lane >> 2)) * KVW + g * 64 + (wid >> 2) * 32 + (lane & 3) * 8;
#define TILE_DMA_A(c, ti) do { const bf16 *kb_, *vb_; \
        if ((c) < 256) { const size_t r0_ = (size_t)64 * ((c) - 2 + (ti)) * KVW; kb_ = Kg + r0_; vb_ = Vg + r0_; } \
        else if ((ti) < 2) { const size_t r0_ = ((size_t)((c) - 256) * 128 + 64 * (ti)) * KVW; kb_ = CK + r0_; vb_ = CV + r0_; } \
        else { const size_t r0_ = ((size_t)SEQ + 64 * ((c) - 256)) * KVW; kb_ = Kg + r0_; vb_ = Vg + r0_; } \
        const unsigned s_ = (unsigned)__builtin_amdgcn_readfirstlane(lds0 + A2_RING + (POS_OF(c, ti) % NSL) * SLOTB + wid * 1024); \
        glds16(kb_ + koff, s_); glds16(vb_ + voff, s_ + 8192); } while (0)
#define Q_DMA_A(c) do { const size_t qt_ = QTOK_OF(c); _Pragma("unroll") for (int i_ = 0; i_ < 4; ++i_) glds16(Q + (qt_ + 8 * i_ + (lane >> 3)) * DM + h * 64 + (lane & 7) * 8, (unsigned)__builtin_amdgcn_readfirstlane(lds0 + A2_Q + wid * 4096 + i_ * 1024)); } while (0)
#define STEP_NEXT(c, ti) do { if ((ti) < 2) ++(ti); else { ++(c); (ti) = T0_OF(c); } } while (0)
    int c3 = c_lo, t3 = T0_OF(c_lo);
    Q_DMA_A(c_lo);
#pragma unroll 1
    for (int k = 0; k < 3; ++k) { if (c3 < c_hi) { if (NEW_OF(c3, t3)) TILE_DMA_A(c3, t3); STEP_NEXT(c3, t3); } }
    const float gqm = wave_max(fabsf(qg[lane])), gkm = wave_max(fabsf(kg[lane]));
    const float kc = sqrtf(__uint_as_float(__hip_atomic_load(F.ctl + CW_KMAX_A, __ATOMIC_RELAXED, __HIP_MEMORY_SCOPE_AGENT)));
    const float bm = wave_max(lane < 32 ? table[lane * 16 + h] : -1e30f);
    const float bound = gqm * fmaxf(8.f * gkm, kc) * 1.01f + bm;
    const float sinkp = __builtin_amdgcn_exp2f((a.in[11][h] - bound) * LOG2E);
    LAS float* TTw = (LAS float*)(lds + A2_TT) + wid * 256;
    for (int i = lane; i < 255; i += 64) TTw[i] = (table[t5_bucket(i - 191) * 16 + h] - bound) * LOG2E;
    const LAS float* tql = TTw + (63 - 32 * half - r32 + 4 * hi);
    const lds_cptr kp0 = lds3 + A2_RING + hi * 1024 + r32 * 16;
    const lds_cptr vp0 = lds3 + A2_RING + 8192 + ((lane >> 4) & 1) * 32 + (lane & 3) * 8 + (4 * hi + ((lane & 15) >> 2)) * 64;
    LAS float* wsf = (LAS float*)(lds + A2_WSF) + wid * 64;
    asm volatile("s_waitcnt vmcnt(0) lgkmcnt(0)\n\ts_barrier" ::: "memory");
    f32x16 o[2]; o[0] = f32x16{}; o[1] = f32x16{};
    float l_reg = 0.f;
    u32x4 pw[4];
#pragma unroll
    for (int s = 0; s < 4; ++s) pw[s] = (u32x4){0u, 0u, 0u, 0u};
    bf16x8 qr[4];
    v4u gpre[4];
    { const size_t qt0 = QTOK_OF(c_lo);
#pragma unroll
      for (int i = 0; i < 4; ++i) gpre[i] = *(const GAS v4u*)(Gt + (qt0 + i * 8 + (lane >> 3)) * DM + h * 64 + (lane & 7) * 8); }
    int c = c_lo, ti = T0_OF(c_lo);
    int pc = -1, pv_pos = 0;
    bool p_last = false;
    int ops_prev = 4;
    for (;;) {
        const bool qk_on = c < c_hi;
        int ops = 0;
        if (qk_on && ti == T0_OF(c)) {
#pragma unroll
            for (int d0 = 0; d0 < 4; ++d0) qr[d0] = *(const __attribute__((address_space(3))) bf16x8*)(lds3 + A2_Q + wid * 4096 + r32 * 128 + (2 * d0 + hi) * 16);
        }
        f32x16 p0, p1;
        {
            const int pos = qk_on ? POS_OF(c, ti) : pv_pos;
            const int tq = qk_on ? ti : 2;
            const lds_cptr kp = kp0 + (pos % NSL) * SLOTB, vp = vp0 + ((pc >= 0 ? pv_pos : pos) % NSL) * SLOTB;
            bf16x8 kf[8];
#pragma unroll
            for (int d0 = 0; d0 < 4; ++d0) { kf[2 * d0] = *(const __attribute__((address_space(3))) bf16x8*)(kp + d0 * 2048); kf[2 * d0 + 1] = *(const __attribute__((address_space(3))) bf16x8*)(kp + d0 * 2048 + 512); }
            const LAS float* tq_ = tql + 64 * tq;
#pragma unroll
            for (int r = 0; r < 16; ++r) { p0[r] = tq_[(r & 3) + 8 * (r >> 2)]; p1[r] = tq_[32 + (r & 3) + 8 * (r >> 2)]; }
            __builtin_amdgcn_s_setprio(1);
#pragma unroll
            for (int d0 = 0; d0 < 4; ++d0) { p0 = __builtin_amdgcn_mfma_f32_32x32x16_bf16(kf[2 * d0], qr[d0], p0, 0, 0, 0); p1 = __builtin_amdgcn_mfma_f32_32x32x16_bf16(kf[2 * d0 + 1], qr[d0], p1, 0, 0, 0); }
            bf16x8 vf[8];
#pragma unroll
            for (int i = 0; i < 8; ++i) { const s16x4 lo = vtr(vp + (i >> 2) * 4096 + (i & 3) * 1024), hh = vtr(vp + (i >> 2) * 4096 + (i & 3) * 1024 + 512); vf[i] = (bf16x8){lo[0], lo[1], lo[2], lo[3], hh[0], hh[1], hh[2], hh[3]}; }
#pragma unroll
            for (int ks = 0; ks < 4; ++ks) { o[0] = __builtin_amdgcn_mfma_f32_32x32x16_bf16(__builtin_bit_cast(bf16x8, pw[ks]), vf[ks], o[0], 0, 0, 0); o[1] = __builtin_amdgcn_mfma_f32_32x32x16_bf16(__builtin_bit_cast(bf16x8, pw[ks]), vf[4 + ks], o[1], 0, 0, 0); }
            __builtin_amdgcn_s_setprio(0);
        }
        if (p_last) {
            l_reg += __shfl_xor(l_reg, 32);
            l_reg += sinkp;
            if (hi == 0) wsf[r32] = l_reg;
            LDS_WAIT(); asm volatile("" ::: "memory");
            LAS unsigned short* stg = (LAS unsigned short*)(lds + A2_OST) + wid * 2048;
#pragma unroll
            for (int r = 0; r < 16; ++r) { const int orow = crow(r, hi); const float rl = __builtin_amdgcn_rcpf(wsf[orow]);
#pragma unroll
                for (int d0 = 0; d0 < 2; ++d0) stg[orow * 64 + d0 * 32 + r32] = (unsigned short)(f2bf(o[d0][r] * rl)); }
            LDS_WAIT(); asm volatile("" ::: "memory");
            const size_t qtok = QTOK_OF(pc);
#pragma unroll
            for (int i = 0; i < 4; ++i) { const int row = i * 8 + (lane >> 3), ch = lane & 7;
                const v4u ov = *(const LAS v4u*)(stg + row * 64 + ch * 8);
                const v4u gvv = gpre[i];
                v4u res;
#pragma unroll
                for (int e = 0; e < 4; ++e) { const float a0_ = __uint_as_float(ov[e] << 16) * __uint_as_float(gvv[e] << 16), a1_ = __uint_as_float(ov[e] & 0xffff0000u) * __uint_as_float(gvv[e] & 0xffff0000u); res[e] = cvtpk(a0_, a1_); }
                *(GAS v4u*)(O + (qtok + row) * DM + h * 64 + ch * 8) = res; }
            ops += 4;
            o[0] = f32x16{}; o[1] = f32x16{}; l_reg = 0.f;
            if (qk_on) {
                const size_t qt2 = QTOK_OF(c);
#pragma unroll
                for (int i = 0; i < 4; ++i) gpre[i] = *(const GAS v4u*)(Gt + (qt2 + i * 8 + (lane >> 3)) * DM + h * 64 + (lane & 7) * 8);
                ops += 4; }
        }
        if (!qk_on) break;
        if (c3 < c_hi) { if (NEW_OF(c3, t3)) { TILE_DMA_A(c3, t3); ops += 2; } STEP_NEXT(c3, t3); }
        if (ti == T0_OF(c) && c + 1 < c_hi) { asm volatile("s_waitcnt lgkmcnt(0)" ::: "memory"); Q_DMA_A(c + 1); ops += 4; }
        {
            float sacc = 0.f;
#pragma unroll
            for (int r = 0; r < 16; ++r) { p0[r] = __builtin_amdgcn_exp2f(p0[r]); p1[r] = __builtin_amdgcn_exp2f(p1[r]); sacc += p0[r] + p1[r]; }
            l_reg += sacc;
#pragma unroll
            for (int s = 0; s < 2; ++s)
#pragma unroll
                for (int i = 0; i < 4; ++i) { pw[s][i] = cvtpk(p0[8 * s + 2 * i], p0[8 * s + 2 * i + 1]); pw[2 + s][i] = cvtpk(p1[8 * s + 2 * i], p1[8 * s + 2 * i + 1]); }
        }
        const bool short_chunk = T0_OF(c) != 0;
        wait_bar_n<0>(short_chunk ? 0 : ops + ops_prev);
        ops_prev = ops;
        pc = c; pv_pos = POS_OF(c, ti); p_last = ti == 2;
        STEP_NEXT(c, ti);
    }
    asm volatile("s_waitcnt vmcnt(0) lgkmcnt(0)\n\ts_barrier" ::: "memory");
#undef T0_OF
#undef POS_OF
#undef NEW_OF
#undef QTOK_OF
#undef TILE_DMA_A
#undef Q_DMA_A
#undef STEP_NEXT
}
}

__global__ void __launch_bounds__(NWAVES * 64, 2) mk_fwd(Args args) {
    extern __shared__ __attribute__((aligned(16))) unsigned char lds[];
    Frame F; F.tacc = 0;
    F.lds = (LAS unsigned char*)lds;
    F.MISC = (volatile LAS unsigned*)(F.lds + MISC_OFF);
    F.tid = threadIdx.x; F.lane = F.tid & 63; F.wave = __builtin_amdgcn_readfirstlane(F.tid >> 6);
    F.G = gridDim.x; { const int bx = blockIdx.x; F.vcu = (F.G % 8 == 0) ? (bx % 8) * (F.G / 8) + bx / 8 : bx; }
    unsigned char* ws = args.ws;
    F.ctl = (gu32*)(ws + WS_CTL);
    for (int u = F.tid; u < (LDS_BYTES - LDSCTL_OFF) / 4; u += NWAVES * 64) ((LAS unsigned*)(F.lds + LDSCTL_OFF))[u] = 0u;
    __syncthreads();
    XcdBarrier bar = xcd_barrier_post((unsigned*)(F.ctl + CW_BAR), F.MISC + 8);
    bf16* XN = (bf16*)(ws + WS_XN);
    float* slab = (float*)(ws + WS_SLAB);
    float* out = args.out;

#ifndef DUP_PHASE
#define DUP_PHASE -1
#endif
#define REPS_ON(k) int nrep_##k = 2; asm volatile("" : "+s"(nrep_##k)); for (int rep_ = 0; rep_ < nrep_##k; ++rep_)
#define REPS_OFF(k)
#define REPS_SEL(k) REPS_SEL2(k, DUP_PHASE)
#define REPS(k) REPS_##k
#if DUP_PHASE == 0
#define REPS_0 REPS_ON(0)
#else
#define REPS_0
#endif
#if DUP_PHASE == 1
#define REPS_1 REPS_ON(1)
#else
#define REPS_1
#endif
#if DUP_PHASE == 2
#define REPS_2 REPS_ON(2)
#else
#define REPS_2
#endif
#if DUP_PHASE == 3
#define REPS_3 REPS_ON(3)
#else
#define REPS_3
#endif
#if DUP_PHASE == 4
#define REPS_4 REPS_ON(4)
#else
#define REPS_4
#endif
#if DUP_PHASE == 5
#define REPS_5 REPS_ON(5)
#else
#define REPS_5
#endif
#if DUP_PHASE == 6
#define REPS_6 REPS_ON(6)
#else
#define REPS_6
#endif
    KSEG_BEGIN(10) REPS(0) { p0_prologue(F, args);
    xcd_barrier(bar); } KSEG_END(10)
    KSEG_BEGIN(11) REPS(1) {
        pg8::Gemm g{XN, (const bf16*)(ws + WS_WINA), M, NIN_A, DM}; pg8::StaticOrder S; S.init(M, NIN_A, F.G, (int)blockIdx.x, WGM_P1);
        pg8::EpiIn E{0, (bf16*)(ws + WS_QA), (bf16*)(ws + WS_KA), (bf16*)(ws + WS_VA), (bf16*)(ws + WS_GA), 128, args.in[9], args.in[10], nullptr,
                     out + O_KAP, out + O_VAP, out + O_KAS, out + O_VAS, 128, 2, C2, nullptr};
        pg8::gemm_phase<pg8::EpiIn, pg8::StaticOrder, true, true>(F.lds + RING_OFF, g, S, E, PROBE_SEG == 31 ? &F.tacc : nullptr);
        { const int busy = (M / 256) * (NIN_A / 256) - 2 * F.G;
          if ((int)blockIdx.x >= busy && F.wave < 4) { side_weights(F, args, ((int)blockIdx.x - busy) * 4 + F.wave, (F.G - busy) * 4);
              side_cache_b_conv(F, args, ((int)blockIdx.x - busy) * 4 + F.wave, (F.G - busy) * 4, 0, NB * 256); } }
    xcd_barrier(bar); } KSEG_END(11)
    KSEG_BEGIN(12) REPS(2) { attn::attn_phase_a(F, args);
    xcd_barrier(bar); } KSEG_END(12)
    KSEG_BEGIN(13) REPS(3) {
        pg8::Gemm g{XN, (const bf16*)(ws + WS_WOUTA), SEQ, DM, DM}; pg8::StaticOrder S; S.init(SEQ, DM, F.G, (int)blockIdx.x);
        pg8::EpiOut E{0, args.in[0], args.in[1], (bf16*)(ws + WS_QA), nullptr, slab};
        KSEG_BEGIN(20) pg8::gemm_phase<pg8::EpiOut, pg8::StaticOrder, true, true>(F.lds + RING_OFF, g, S, E); KSEG_END(20)
        KSEG_BEGIN(21)
        tail_outproj<0>(F.lds + RING_OFF, XN, (const bf16*)(ws + WS_WOUTA), (int)blockIdx.x, args.in[1], (bf16*)(ws + WS_QA), slab, nullptr);
        KSEG_END(21)
    xcd_barrier(bar); } KSEG_END(13)
    KSEG_BEGIN(14) REPS(4) {
        pg8::Gemm g{(const bf16*)(ws + WS_QA), (const bf16*)(ws + WS_WINB), M, NIN_B, DM}; pg8::StaticOrder S; S.init(M, NIN_B, F.G, (int)blockIdx.x, WGM_P4);
        pg8::EpiIn E{1, (bf16*)(ws + WS_QB), (bf16*)(ws + WS_KB), (bf16*)(ws + WS_VB), (bf16*)(ws + WS_GB), 1024, args.in[15], args.in[16], slab,
                     out + O_KBP, out + O_VBP, out + O_KBS, out + O_VBS, 512, 16, C2, (LAS float*)(F.lds + RING_BYTES + 1024)};
        pg8::gemm_phase<pg8::EpiIn, pg8::StaticOrder, true, true>(F.lds + RING_OFF, g, S, E, PROBE_SEG == 30 ? &F.tacc : nullptr);
        { const int busy = (M / 256) * (NIN_B / 256) - 4 * F.G;
          if ((int)blockIdx.x >= busy && F.wave < 2) side_cache_b_conv(F, args, ((int)blockIdx.x - busy) * 2 + F.wave, (F.G - busy) * 2, NB * 256, NB * 512); }
    xcd_barrier(bar); } KSEG_END(14)
    KSEG_BEGIN(15) REPS(5) { attn::attn_phase<1>(F, args);
    xcd_barrier(bar); } KSEG_END(15)
    KSEG_BEGIN(16) REPS(6) {
        pg8::Gemm g{XN, (const bf16*)(ws + WS_WOUTB), SEQ, DM, DM}; pg8::StaticOrder S; S.init(SEQ, DM, F.G, (int)blockIdx.x);
        pg8::EpiOut E{1, nullptr, nullptr, (bf16*)(ws + WS_QA), out + O_Y, nullptr};
        pg8::gemm_phase<pg8::EpiOut, pg8::StaticOrder, true, true>(F.lds + RING_OFF, g, S, E);
        tail_outproj<1>(F.lds + RING_OFF, XN, (const bf16*)(ws + WS_WOUTB), (int)blockIdx.x, nullptr, (bf16*)(ws + WS_QA), nullptr, out + O_Y);
    }
    KSEG_END(16)
#if PROBE_SEG
    if (blockIdx.x == 0) {
        const unsigned long long t0 = __builtin_amdgcn_s_memrealtime(), dt = 8ull * (unsigned long long)__builtin_amdgcn_readfirstlane((unsigned)F.tacc);
        while (__builtin_amdgcn_s_memrealtime() - t0 < dt) __builtin_amdgcn_s_sleep(32);
    }
#endif
}
extern "C" void kernel_launch(void* const* d_in, const int* in_sizes, int n_in, void* d_out, int out_size, void* d_ws, size_t ws_size, hipStream_t stream) {
    static int grid = 0;
    if (grid == 0) {
        if (n_in != 19 || out_size != (int)O_END || ws_size < WS_END) { fprintf(stderr, "kernel_launch: unexpected shapes (n_in %d, out %d, ws %zu)\n", n_in, out_size, ws_size); grid = -1; return; }
        int dev = 0, cus = 0, per_cu = 0;
        if (hipGetDevice(&dev) != hipSuccess || hipDeviceGetAttribute(&cus, hipDeviceAttributeMultiprocessorCount, dev) != hipSuccess) { grid = -1; return; }
        if (hipFuncSetAttribute((const void*)mk_fwd, hipFuncAttributeMaxDynamicSharedMemorySize, LDS_BYTES) != hipSuccess) { fprintf(stderr, "kernel_launch: hipFuncSetAttribute failed\n"); grid = -1; return; }
        if (hipOccupancyMaxActiveBlocksPerMultiprocessor(&per_cu, (const void*)mk_fwd, NWAVES * 64, LDS_BYTES) != hipSuccess || per_cu < 1) { fprintf(stderr, "kernel_launch: occupancy query says %d blocks per CU\n", per_cu); }
        (void)hipGetLastError();
        grid = cus;
        if (grid != 256) { fprintf(stderr, "kernel_launch: built for 256 CUs, found %d\n", cus); grid = -1; return; }
    }
    if (grid < 0) return;
    (void)hipMemsetAsync((char*)d_ws + WS_CTL, 0, CTL_ZERO_BYTES, stream);
    Args a{};
    for (int i = 0; i < 19; ++i) a.in[i] = (const float*)d_in[i];
    a.out = (float*)d_out; a.ws = (unsigned char*)d_ws;
    hipLaunchKernelGGL(mk_fwd, dim3(grid), dim3(NWAVES * 64), LDS_BYTES, stream, a);
}
```

```cpp
#include <hip/hip_runtime.h>
#include <cstdio>
#include <cstdint>
#include <cmath>
namespace pg8 {
#define PG8_LAS __attribute__((address_space(3)))
typedef unsigned short bf16_t;
typedef short bf16x8 __attribute__((ext_vector_type(8)));
typedef float f32x4 __attribute__((ext_vector_type(4)));
typedef unsigned u32x4 __attribute__((ext_vector_type(4)));
constexpr int BM = 256, BK = 64, HALF = 128, HTB = HALF * BK * 2  , STAGE_BYTES = 8 * HTB, NXCD = 8, WGM = 4;

__host__ __device__ __forceinline__ int lds_byte(int r, int c) { const int st = (r >> 4) * 2 + (c >> 5), rr = r & 15, cc = c & 31, ob = rr * 64 + cc * 2; return st * 1024 + (ob ^ (((ob >> 9) & 1) << 5)); }
__host__ __device__ __forceinline__ void stage_rc(int b, int& R, int& C) { const int st = b / 1024, sb = b % 1024, swz = sb ^ (((sb >> 9) & 1) << 5); R = (st >> 1) * 16 + swz / 64; C = (st & 1) * 32 + (swz % 64) / 2; }
__host__ __device__ __forceinline__ int perm32(int rho) { const int n = rho >> 4, i = rho & 15; return 8 * (i >> 2) + 4 * n + (i & 3); }

struct Unit { int pm, pn; };
struct Gemm { const bf16_t* A; const bf16_t* Bt; int M, N, K; };

struct StaticOrder {
    int nM, nN, nwg, G, c, wgm;
    __host__ __device__ void init(int M, int N, int G_, int c_, int wgm_ = WGM) { nM = M / BM; nN = N / BM; nwg = nM * nN; G = G_; c = c_; wgm = wgm_; }
    __host__ __device__ bool next(int i, Unit& u) const {
        const long L = (long)i * G + c; if (L >= nwg) return false;
        int wgid = (int)L; { const int q = nwg / NXCD, r = nwg % NXCD, xcd = wgid % NXCD, off = wgid / NXCD; wgid = (xcd < r ? xcd * (q + 1) : r * (q + 1) + (xcd - r) * q) + off; }
        const int nig = wgm * nN, gid = wgid / nig, fm = gid * wgm, gsz = (nM - fm) < wgm ? (nM - fm) : wgm;
        u.pm = fm + ((wgid % nig) % gsz); u.pn = (wgid % nig) / gsz; return true;
    }
    __device__ __forceinline__ void a_ready(const Unit&) const {}
    __device__ __forceinline__ void done(const Unit&) const {}
};
__device__ __forceinline__ unsigned cvt_pk_bf16(float lo, float hi) { unsigned r; asm volatile("v_cvt_pk_bf16_f32 %0, %1, %2" : "=v"(r) : "v"(lo), "v"(hi)); return r; }
__device__ __forceinline__ void st16_wt(void* p, u32x4 v) { asm volatile("global_store_dwordx4 %0, %1, off sc1\n\ts_nop 1" :: "v"(p), "v"(v) : "memory"); }
__device__ __forceinline__ void st16_wt_s(const void* base, unsigned voff, u32x4 v) { asm volatile("global_store_dwordx4 %0, %1, %2 sc1\n\ts_nop 1" :: "v"(voff), "v"(v), "s"(base) : "memory"); }
constexpr int SEQ_ = 16384;
constexpr float NORM_EPS = 1e-6f;
struct EpiIn {
    static constexpr bool PERM = true, AFTER_DRAIN = false;
    int layer;
    bf16_t *Q, *Kb, *Vb, *G; int kvw;
    const float *qg, *kg;
    const float* slab;
    float *okp, *ovp, *oks, *ovs; int keep, nkv;
    float c2;
    PG8_LAS unsigned char* stg;
    template <int TYPE>
    __device__ __forceinline__ void tile(const f32x4 (&acc)[2][2][4][2], int rowb0, int fr, int rl0, int dcol, int fq, bf16_t* dsth, int ld, const float* gp, float sc, float* o_p, float* o_s, int head,
                                         PG8_LAS unsigned char* stw, const PG8_LAS unsigned char* str, unsigned lvo) const {
        f32x4 gv[2][2];
        if (TYPE < 2) {
#pragma unroll
            for (int bj = 0; bj < 2; ++bj)
#pragma unroll
                for (int n = 0; n < 2; ++n) gv[bj][n] = *(const f32x4*)(gp + 32 * bj + dcol + 4 * n) * sc; }
#pragma unroll
        for (int ai = 0; ai < 2; ++ai)
#pragma unroll
            for (int m = 0; m < 4; ++m) {
                const int rowb = rowb0 + ai * HALF + m * 16, row = rowb + fr;
                const float rs = slab ? ((const PG8_LAS float*)stg)[ai * HALF + rl0 + m * 16] : 1.f;
                f32x4 v[2][2];
#pragma unroll
                for (int bj = 0; bj < 2; ++bj)
#pragma unroll
                    for (int n = 0; n < 2; ++n) v[bj][n] = acc[ai][bj][m][n] * rs;
                if (TYPE < 2) {
                    float ss = 0.f;
#pragma unroll
                    for (int bj = 0; bj < 2; ++bj)
#pragma unroll
                        for (int n = 0; n < 2; ++n) { const f32x4 x = v[bj][n]; ss += (x[0] * x[0] + x[1] * x[1]) + (x[2] * x[2] + x[3] * x[3]); }
                    ss += __shfl_xor(ss, 16); ss += __shfl_xor(ss, 32);
                    const float r = rsqrtf(ss * (1.f / 64.f) + NORM_EPS);
#pragma unroll
                    for (int bj = 0; bj < 2; ++bj)
#pragma unroll
                        for (int n = 0; n < 2; ++n) v[bj][n] = v[bj][n] * r * gv[bj][n];
                } else if (TYPE == 3) {
#pragma unroll
                    for (int bj = 0; bj < 2; ++bj)
#pragma unroll
                        for (int n = 0; n < 2; ++n)
#pragma unroll
                            for (int e = 0; e < 4; ++e) { const float x = v[bj][n][e]; v[bj][n][e] = x * __builtin_amdgcn_rcpf(1.f + __builtin_amdgcn_exp2f(-1.4426950408889634f * x)); }
                }
                if ((TYPE == 1 || TYPE == 2) && row >= SEQ_ - keep) {
                    float* op;
                    if (row < SEQ_) op = o_p + ((size_t)(row - (SEQ_ - keep)) * nkv + head) * 64 + dcol;
                    else { const int r_ = row - SEQ_; op = o_s + (((size_t)(r_ >> 6) * keep + (keep - 64) + (r_ & 63)) * nkv + head) * 64 + dcol; }
#pragma unroll
                    for (int bj = 0; bj < 2; ++bj) { *(f32x4*)(op + 32 * bj) = v[bj][0]; *(f32x4*)(op + 32 * bj + 4) = v[bj][1]; }
                }
#pragma unroll
                for (int bj = 0; bj < 2; ++bj) { u32x4 w; w.x = cvt_pk_bf16(v[bj][0][0], v[bj][0][1]); w.y = cvt_pk_bf16(v[bj][0][2], v[bj][0][3]); w.z = cvt_pk_bf16(v[bj][1][0], v[bj][1][1]); w.w = cvt_pk_bf16(v[bj][1][2], v[bj][1][3]);
                    *(PG8_LAS u32x4*)(stw + 64 * bj) = w; }
                const u32x4 t0 = *(const PG8_LAS u32x4*)str, t1 = *(const PG8_LAS u32x4*)(str + 8 * 144);
                st16_wt_s(dsth + (size_t)rowb * ld, lvo, t0); st16_wt_s(dsth + (size_t)(rowb + 8) * ld, lvo, t1);
            }
    }
    __device__ __forceinline__ void operator()(const f32x4 (&acc)[2][2][4][2], const Unit& u, int wr, int wc, int fr, int fq) const {
        int type, head;
        if (layer == 0) { if (u.pn < 4) { type = 0; head = 4 * u.pn + wc; } else if (u.pn == 4) { type = wc < 2 ? 1 : 2; head = wc & 1; } else { type = 3; head = 4 * (u.pn - 5) + wc; } }
        else { type = u.pn >> 2; head = 4 * (u.pn & 3) + wc; }
        const int rowb0 = u.pm * BM + wr * 64, rl0 = wr * 64 + fr, dcol = 8 * fq, ho = head * 64;
        const int lane = fr + 16 * fq, lr = lane >> 3, lc = lane & 7;
        PG8_LAS unsigned char* sw = stg + 1024 + (wr * 4 + wc) * 2304;
        PG8_LAS unsigned char* stw = sw + fr * 144 + fq * 16;
        const PG8_LAS unsigned char* str = sw + lr * 144 + lc * 16;
        if (slab) {
            const int t = threadIdx.x;
            if (t < BM) { const f32x4* sp = (const f32x4*)(slab + (size_t)(u.pm * BM + t) * 16); const f32x4 a = sp[0], b = sp[1], c = sp[2], d = sp[3];
                const f32x4 s = (a + b) + (c + d); ((PG8_LAS float*)stg)[t] = rsqrtf(((s[0] + s[1]) + (s[2] + s[3])) * (1.f / 1024.f) + NORM_EPS); }
            asm volatile("s_waitcnt lgkmcnt(0)\n\ts_barrier" ::: "memory");
        }
        const unsigned lvo = (unsigned)(lr * ((type == 0 || type == 3) ? 1024 : kvw) + lc * 8) * 2u;
        if (type == 0) tile<0>(acc, rowb0, fr, rl0, dcol, fq, Q + ho, 1024, qg, c2, nullptr, nullptr, head, stw, str, lvo);
        else if (type == 1) tile<1>(acc, rowb0, fr, rl0, dcol, fq, Kb + ho, kvw, kg, 1.f, okp, oks, head, stw, str, lvo);
        else if (type == 2) tile<2>(acc, rowb0, fr, rl0, dcol, fq, Vb + ho, kvw, nullptr, 1.f, ovp, ovs, head, stw, str, lvo);
        else tile<3>(acc, rowb0, fr, rl0, dcol, fq, G + ho, 1024, nullptr, 1.f, nullptr, nullptr, head, stw, str, lvo);
    }
};
struct EpiOut {
    static constexpr bool PERM = true, AFTER_DRAIN = false;
    int layer;
    const float *base_p, *base_s;
    bf16_t* yb;
    float* out;
    float* slab;
    __device__ __forceinline__ void operator()(const f32x4 (&acc)[2][2][4][2], const Unit& u, int wr, int wc, int fr, int fq) const {
        const int row0 = u.pm * BM + wr * 64 + fr, col0 = u.pn * BM + wc * 32 + 8 * fq;
        if (layer == 0) {
#pragma unroll
            for (int ai = 0; ai < 2; ++ai) {
                f32x4 b[4][2][2];
#pragma unroll
                for (int m = 0; m < 4; ++m) { const int row = row0 + ai * HALF + m * 16;
                    const float* bp = (row < SEQ_ ? base_p + (size_t)row * 1024 : base_s + (size_t)(row - SEQ_) * 1024) + col0;
#pragma unroll
                    for (int bj = 0; bj < 2; ++bj) { b[m][bj][0] = __builtin_nontemporal_load((const f32x4*)(bp + bj * HALF)); b[m][bj][1] = __builtin_nontemporal_load((const f32x4*)(bp + bj * HALF + 4)); } }
#pragma unroll
                for (int m = 0; m < 4; ++m) { const int row = row0 + ai * HALF + m * 16; float ss = 0.f;
#pragma unroll
                    for (int bj = 0; bj < 2; ++bj) { const f32x4 y0 = acc[ai][bj][m][0] + b[m][bj][0], y1 = acc[ai][bj][m][1] + b[m][bj][1];
                        ss += ((y0[0] * y0[0] + y0[1] * y0[1]) + (y0[2] * y0[2] + y0[3] * y0[3])) + ((y1[0] * y1[0] + y1[1] * y1[1]) + (y1[2] * y1[2] + y1[3] * y1[3]));
                        u32x4 w; w.x = cvt_pk_bf16(y0[0], y0[1]); w.y = cvt_pk_bf16(y0[2], y0[3]); w.z = cvt_pk_bf16(y1[0], y1[1]); w.w = cvt_pk_bf16(y1[2], y1[3]);
                        *(u32x4*)(yb + (size_t)row * 1024 + col0 + bj * HALF) = w; }
                    ss += __shfl_xor(ss, 16); ss += __shfl_xor(ss, 32); if (fq == 0) slab[(size_t)row * 16 + 4 * u.pn + wc] = ss; }
            }
        } else {
#pragma unroll
            for (int ai = 0; ai < 2; ++ai) {
                u32x4 b[4][2];
#pragma unroll
                for (int m = 0; m < 4; ++m) { const int row = row0 + ai * HALF + m * 16;
#pragma unroll
                    for (int bj = 0; bj < 2; ++bj) b[m][bj] = *(const u32x4*)(yb + (size_t)row * 1024 + col0 + bj * HALF); }
#pragma unroll
                for (int m = 0; m < 4; ++m) { const int row = row0 + ai * HALF + m * 16; float* op = out + (size_t)row * 1024 + col0;
#pragma unroll
                    for (int bj = 0; bj < 2; ++bj) { const u32x4 w = b[m][bj];
                        const f32x4 r0 = {__uint_as_float(w.x << 16), __uint_as_float(w.x & 0xffff0000u), __uint_as_float(w.y << 16), __uint_as_float(w.y & 0xffff0000u)};
                        const f32x4 r1 = {__uint_as_float(w.z << 16), __uint_as_float(w.z & 0xffff0000u), __uint_as_float(w.w << 16), __uint_as_float(w.w & 0xffff0000u)};
                        *(f32x4*)(op + bj * HALF) = acc[ai][bj][m][0] + r0; *(f32x4*)(op + bj * HALF + 4) = acc[ai][bj][m][1] + r1; } }
            }
        }
    }
};
template <class Epi, class Sched, bool ALIGN_EPI = false, bool SP2 = false>
__device__ __forceinline__ void gemm_phase(PG8_LAS unsigned char* lds, const Gemm g, const Sched& S, const Epi& E, unsigned long long* tepi = nullptr) {
    int tid_ = threadIdx.x; asm volatile("" : "+v"(tid_));
    const int tid = tid_, wid = __builtin_amdgcn_readfirstlane(tid >> 6), lane = tid & 63, wr = wid >> 2, wc = wid & 3, fr = lane & 15, fq = lane >> 4;
    const int K = g.K, nt = K / BK;
    unsigned voffA[2], voffB[2];
#pragma unroll
    for (int i = 0; i < 2; ++i) { int R, C; stage_rc(tid * 16 + i * 8192, R, C); const int Rb = Epi::PERM ? ((R & ~31) + perm32(R & 31)) : R;
        voffA[i] = (unsigned)(R * K + C) * 2u; voffB[i] = (unsigned)(Rb * K + C) * 2u; }
    const size_t kstep = (size_t)(BK * 2);
    const size_t hstep = (size_t)HALF * K * 2;
    const size_t tstep = 2 * hstep;
    const unsigned ldsw = (unsigned)wid * 1024u;
    const int aoff = lds_byte(wr * 64 + fr, fq * 8), boff = lds_byte(wc * 32 + fr, fq * 8);
#define PG8_SA(b, h) (((b) * 2 + (h)) * HTB)
#define PG8_SB(b, h) ((4 + (b) * 2 + (h)) * HTB)
#define PG8_STAGE(bufoff, gbase, voff) do { _Pragma("unroll") for (int _i = 0; _i < 2; ++_i) \
        __builtin_amdgcn_global_load_lds((const unsigned*)((const char*)(gbase) + (voff)[_i]), (PG8_LAS unsigned*)(lds + (bufoff) + ldsw + _i * 8192), 16, 0, 0); } while (0)
#define PG8_LDA(dst, b, h) do { _Pragma("unroll") for (int m = 0; m < 4; ++m) _Pragma("unroll") for (int k = 0; k < 2; ++k) dst[m][k] = *(const PG8_LAS bf16x8*)(lds + PG8_SA(b, h) + aoff + m * 2048 + k * 1024); } while (0)
#define PG8_LDB(dst, b, h) do { _Pragma("unroll") for (int n = 0; n < 2; ++n) _Pragma("unroll") for (int k = 0; k < 2; ++k) dst[n][k] = *(const PG8_LAS bf16x8*)(lds + PG8_SB(b, h) + boff + n * 2048 + k * 1024); } while (0)
#define PG8_MMA(ai, bj, At, Bt) do { __builtin_amdgcn_s_setprio(1); _Pragma("unroll") for (int m = 0; m < 4; ++m) _Pragma("unroll") for (int n = 0; n < 2; ++n) _Pragma("unroll") for (int k = 0; k < 2; ++k) \
        acc[ai][bj][m][n] = __builtin_amdgcn_mfma_f32_16x16x32_bf16(Bt[n][k], At[m][k], acc[ai][bj][m][n], 0, 0, 0); __builtin_amdgcn_s_setprio(0); } while (0)
#define PG8_WAIT_V(n) asm volatile("s_waitcnt vmcnt(" #n ")" ::: "memory")
#define PG8_WAIT_L(n) asm volatile("s_waitcnt lgkmcnt(" #n ")" ::: "memory")
#define PG8_BAR __builtin_amdgcn_s_barrier()
#define PG8_SCHED __builtin_amdgcn_sched_barrier(0)
    Unit cur, nxt; int ui = 0;
    if (!S.next(0, cur)) return;
    f32x4 acc[2][2][4][2];
#pragma unroll
    for (int a = 0; a < 2; ++a)
#pragma unroll
        for (int b = 0; b < 2; ++b)
#pragma unroll
            for (int m = 0; m < 4; ++m)
#pragma unroll
                for (int n = 0; n < 2; ++n) acc[a][b][m][n] = (f32x4){0.f, 0.f, 0.f, 0.f};
    bf16x8 At[4][2], B0[2][2], B1[2][2];
    const char* cA = (const char*)g.A + (size_t)cur.pm * tstep; const char* cB = (const char*)g.Bt + (size_t)cur.pn * tstep;
    S.a_ready(cur);
    if constexpr (SP2) {
        PG8_STAGE(PG8_SB(0, 0), cB, voffB); PG8_STAGE(PG8_SB(0, 1), cB + hstep, voffB); PG8_STAGE(PG8_SA(0, 0), cA, voffA); PG8_STAGE(PG8_SA(0, 1), cA + hstep, voffA);
        if (wr == 1) PG8_BAR;
        PG8_WAIT_V(2); PG8_BAR;
        PG8_STAGE(PG8_SB(1, 0), cB + kstep, voffB); PG8_STAGE(PG8_SA(1, 0), cA + kstep, voffA); PG8_STAGE(PG8_SB(1, 1), cB + hstep + kstep, voffB);
        PG8_WAIT_V(6); PG8_BAR;
    } else {
        PG8_STAGE(PG8_SB(0, 0), cB, voffB); PG8_STAGE(PG8_SA(0, 0), cA, voffA); PG8_STAGE(PG8_SB(0, 1), cB + hstep, voffB); PG8_STAGE(PG8_SA(0, 1), cA + hstep, voffA);
        if (wr == 1) PG8_BAR;
        PG8_WAIT_V(4); PG8_BAR;
        PG8_STAGE(PG8_SB(1, 0), cB + kstep, voffB); PG8_STAGE(PG8_SA(1, 0), cA + kstep, voffA); PG8_STAGE(PG8_SB(1, 1), cB + hstep + kstep, voffB);
        PG8_WAIT_V(6); PG8_BAR;
    }
    for (;;) {
        const bool has_next = S.next(ui + 1, nxt);
        const char* nA = has_next ? (const char*)g.A + (size_t)nxt.pm * tstep : cA; const char* nB = has_next ? (const char*)g.Bt + (size_t)nxt.pn * tstep : cB;
        for (int t = 0; t < nt; t += 2) {
            const bool last = (t == nt - 2);
            const char* a1 = cA + (size_t)(t + 1) * kstep;
            const char* a2 = last ? nA : cA + (size_t)(t + 2) * kstep; const char* b2 = last ? nB : cB + (size_t)(t + 2) * kstep;
            const char* a3 = a2 + kstep; const char* b3 = b2 + kstep;
            if (last && has_next) S.a_ready(nxt);
            if constexpr (SP2) {
            PG8_LDB(B0, 0, 0); PG8_LDB(B1, 0, 1); PG8_SCHED; PG8_LDA(At, 0, 0); PG8_STAGE(PG8_SA(1, 1), a1 + hstep, voffA);
            PG8_WAIT_V(8); PG8_WAIT_L(0); PG8_BAR; PG8_MMA(0, 0, At, B0); PG8_MMA(0, 1, At, B1); PG8_BAR; PG8_SCHED;
            PG8_LDA(At, 0, 1); PG8_STAGE(PG8_SB(0, 0), b2, voffB); PG8_STAGE(PG8_SB(0, 1), b2 + hstep, voffB); PG8_STAGE(PG8_SA(0, 0), a2, voffA);
            PG8_WAIT_V(8); PG8_WAIT_L(0); PG8_BAR; PG8_MMA(1, 0, At, B0); PG8_MMA(1, 1, At, B1); PG8_BAR; PG8_SCHED;
            PG8_LDB(B0, 1, 0); PG8_LDB(B1, 1, 1); PG8_SCHED; PG8_LDA(At, 1, 0); PG8_STAGE(PG8_SA(0, 1), a2 + hstep, voffA);
            PG8_WAIT_V(8); PG8_WAIT_L(0); PG8_BAR; PG8_MMA(0, 0, At, B0); PG8_MMA(0, 1, At, B1); PG8_BAR; PG8_SCHED;
            PG8_LDA(At, 1, 1); PG8_STAGE(PG8_SB(1, 0), b3, voffB); PG8_STAGE(PG8_SB(1, 1), b3 + hstep, voffB); PG8_STAGE(PG8_SA(1, 0), a3, voffA);
            PG8_WAIT_V(8); PG8_WAIT_L(0); PG8_BAR; PG8_MMA(1, 0, At, B0); PG8_MMA(1, 1, At, B1); PG8_BAR; PG8_SCHED;
            } else {
            PG8_LDB(B0, 0, 0); PG8_SCHED; PG8_LDA(At, 0, 0); PG8_STAGE(PG8_SA(1, 1), a1 + hstep, voffA);
            PG8_WAIT_L(8); PG8_BAR; PG8_WAIT_L(0); PG8_MMA(0, 0, At, B0); PG8_BAR; PG8_SCHED;
            PG8_LDB(B1, 0, 1); PG8_STAGE(PG8_SB(0, 0), b2, voffB);
            PG8_BAR; PG8_WAIT_L(0); PG8_MMA(0, 1, At, B1); PG8_BAR;
            PG8_LDA(At, 0, 1); PG8_STAGE(PG8_SA(0, 0), a2, voffA);
            PG8_BAR; PG8_WAIT_L(0); PG8_MMA(1, 0, At, B0); PG8_BAR; PG8_SCHED;
            PG8_STAGE(PG8_SB(0, 1), b2 + hstep, voffB);
            PG8_WAIT_V(6); PG8_BAR; PG8_MMA(1, 1, At, B1); PG8_BAR;
            PG8_LDB(B0, 1, 0); PG8_SCHED; PG8_LDA(At, 1, 0); PG8_STAGE(PG8_SA(0, 1), a2 + hstep, voffA);
            PG8_WAIT_L(8); PG8_BAR; PG8_WAIT_L(0); PG8_MMA(0, 0, At, B0); PG8_BAR; PG8_SCHED;
            PG8_LDB(B1, 1, 1); PG8_STAGE(PG8_SB(1, 0), b3, voffB);
            PG8_BAR; PG8_WAIT_L(0); PG8_MMA(0, 1, At, B1); PG8_BAR;
            PG8_LDA(At, 1, 1); PG8_STAGE(PG8_SA(1, 0), a3, voffA);
            PG8_BAR; PG8_WAIT_L(0); PG8_MMA(1, 0, At, B0); PG8_BAR; PG8_SCHED;
            PG8_STAGE(PG8_SB(1, 1), b3 + hstep, voffB);
            PG8_WAIT_V(6); PG8_BAR; PG8_MMA(1, 1, At, B1); PG8_BAR;
            }
        }
        if constexpr (ALIGN_EPI) { if (wr == 0) PG8_BAR; }
        if constexpr (!Epi::AFTER_DRAIN) { unsigned long long te0_ = 0; if (tepi) te0_ = __builtin_amdgcn_s_memrealtime(); E(acc, cur, wr, wc, fr, fq); S.done(cur); if (tepi) *tepi += __builtin_amdgcn_s_memrealtime() - te0_; }
        if (!has_next) break;
#pragma unroll
        for (int a = 0; a < 2; ++a)
#pragma unroll
            for (int b = 0; b < 2; ++b)
#pragma unroll
                for (int m = 0; m < 4; ++m)
#pragma unroll
                    for (int n = 0; n < 2; ++n) acc[a][b][m][n] = (f32x4){0.f, 0.f, 0.f, 0.f};
        cur = nxt; cA = nA; cB = nB; ++ui;
        if constexpr (ALIGN_EPI) { if (wr == 1) PG8_BAR; }
    }
    PG8_WAIT_V(0);
    if constexpr (!ALIGN_EPI) { if (wr == 0) PG8_BAR; }
    PG8_BAR;
    if constexpr (Epi::AFTER_DRAIN) { E.fused(acc, cur, wr, wc, fr, fq, lds, wid, lane); S.done(cur); }
#undef PG8_SA
#undef PG8_SB
#undef PG8_STAGE
#undef PG8_LDA
#undef PG8_LDB
#undef PG8_MMA
#undef PG8_WAIT_V
#undef PG8_WAIT_L
#undef PG8_BAR
#undef PG8_SCHED
}
}
#define GAS __attribute__((address_space(1)))
#define LAS __attribute__((address_space(3)))
typedef unsigned short bf16;
typedef unsigned v4u __attribute__((ext_vector_type(4)));
typedef float f32x4 __attribute__((ext_vector_type(4)));
typedef short bf16x8 __attribute__((ext_vector_type(8)));
typedef GAS unsigned gu32;
typedef GAS unsigned long long gu64;
#define RLX_AGENT __ATOMIC_RELAXED, __HIP_MEMORY_SCOPE_AGENT
#define LDS_WAIT() asm volatile("s_waitcnt lgkmcnt(0)" ::: "memory")
#define VM_WAIT() asm volatile("s_waitcnt vmcnt(0)" ::: "memory")
__device__ __forceinline__ unsigned long long rt() { return __builtin_amdgcn_s_memrealtime(); }
__device__ __forceinline__ unsigned f2bf(float f) { unsigned u = __builtin_bit_cast(unsigned, f); return (u + 0x7fffu + ((u >> 16) & 1u)) >> 16; }
__device__ __forceinline__ unsigned pk2(float lo, float hi) { return f2bf(lo) | (f2bf(hi) << 16); }

#define XB_TMO      128
#define XB_XCNT(j)  (256  + 64 * (j))
#define XB_XSUB(j)  (1280 + 64 * (j))
#define XB_XGEN(j)  (2304 + 64 * (j))
#define XB_TOP      3328
#define XB_TOPGEN   3392
#define XCD_BAR_WORDS 3456
#define XB_SPIN_CAP (1u << 18)

__device__ __forceinline__ unsigned xb_ld(unsigned* p)              { return __hip_atomic_load(p, __ATOMIC_RELAXED, __HIP_MEMORY_SCOPE_AGENT); }
__device__ __forceinline__ unsigned xb_add(unsigned* p, unsigned v) { return __hip_atomic_fetch_add(p, v, __ATOMIC_RELAXED, __HIP_MEMORY_SCOPE_AGENT); }
__device__ __forceinline__ unsigned xb_xcc_id() { return (unsigned)__builtin_amdgcn_s_getreg((3 << 11) | 20) & 0xFu; }
#define XB_SPIN(cond, bar) do { unsigned _sp = 0; while (cond) { __builtin_amdgcn_s_sleep(1); \
    if ((++_sp & 255u) == 0u) { if (xb_ld(&(bar)[XB_TMO])) break; if (_sp > XB_SPIN_CAP) { atomicAdd(&(bar)[XB_TMO], 1u); break; } } } } while (0)

struct XcdBarrier {
    unsigned* bar; unsigned x;
    volatile LAS unsigned* st;
};

__device__ __forceinline__ XcdBarrier xcd_barrier_post(unsigned* bar, volatile LAS unsigned* st) {
    XcdBarrier b; b.bar = bar; b.x = xb_xcc_id(); b.st = st;
    if (threadIdx.x == 0) (void)xb_add(&bar[XB_XCNT(b.x)], 1u);
    return b;
}
__device__ __forceinline__ void xcd_barrier_complete(unsigned* bar, unsigned x, unsigned& nloc, unsigned& nx) {
    const unsigned G = gridDim.x * gridDim.y * gridDim.z;
    unsigned sum, cnt, mine, sp = 0u;
    for (;;) {
        sum = 0u; cnt = 0u; mine = 0u;
#pragma unroll
        for (unsigned j = 0; j < 16; ++j) { const unsigned c = xb_ld(&bar[XB_XCNT(j)]); sum += c; cnt += (c > 0u) ? 1u : 0u; mine = (j == x) ? c : mine; }
        if (sum == G) break;
        __builtin_amdgcn_s_sleep(1);
        if ((++sp & 255u) == 0u) { if (xb_ld(&bar[XB_TMO])) break; if (sp > XB_SPIN_CAP) { atomicAdd(&bar[XB_TMO], 1u); break; } }
    }
    nloc = mine > 0u ? mine : 1u; nx = cnt > 0u ? cnt : 1u;
}

__device__ __forceinline__ void xcd_barrier(const XcdBarrier& b) {
    asm volatile("s_waitcnt vmcnt(0)" ::: "memory");
    __syncthreads();
    if (threadIdx.x == 0) {
        unsigned* bar = b.bar;
        __builtin_amdgcn_s_waitcnt(0);
        unsigned nloc = b.st[0], nx = b.st[1];
        if (nloc == 0u) { xcd_barrier_complete(bar, b.x, nloc, nx); b.st[0] = nloc; b.st[1] = nx; }
        const unsigned old = xb_add(&bar[XB_XSUB(b.x)], 1u);
        const unsigned gen = old / nloc;
        if (old + 1u == (gen + 1u) * nloc) {
            __builtin_amdgcn_fence(__ATOMIC_RELEASE, "agent");
            asm volatile("s_waitcnt vmcnt(0)" ::: "memory");
            const unsigned og = xb_add(&bar[XB_TOP], 1u);
            const unsigned tg = og / nx;
            if (og + 1u == (tg + 1u) * nx) xb_add(&bar[XB_TOPGEN], 1u);
            else XB_SPIN(xb_ld(&bar[XB_TOPGEN]) == tg, bar);
            __builtin_amdgcn_fence(__ATOMIC_ACQUIRE, "agent");
            xb_add(&bar[XB_XGEN(b.x)], 1u);
            asm volatile("s_waitcnt vmcnt(0)" ::: "memory");
        } else {
            XB_SPIN(xb_ld(&bar[XB_XGEN(b.x)]) == gen, bar);
            __builtin_amdgcn_fence(__ATOMIC_ACQUIRE, "agent");
            asm volatile("s_waitcnt vmcnt(0)" ::: "memory");
        }
    }
    __syncthreads();
}
constexpr int NWAVES = 8;
#ifndef WGM_P1
#define WGM_P1 8
#endif
#ifndef WGM_P4
#define WGM_P4 4
#endif
constexpr int DM = 1024, SEQ = 16384, NB = 16, MS = NB * 64, M = SEQ + MS;
constexpr int NIN_A = 2304, NIN_B = 4096;
constexpr float EPS = 1e-6f, LOG2E = 1.4426950408889634f, C2 = 0.125f * 1.4426950408889634f;
constexpr size_t O_Y = 0, O_KAP = 17825792, O_VAP = 17842176, O_KBP = 17858560, O_VBP = 18382848, O_KAS = 18907136, O_VAS = 19169280, O_KBS = 19431424, O_VBS = 27820032, O_END = 36208640;
constexpr size_t KiB = 1024, MiB = 1u << 20;
constexpr size_t WS_CTL = 0, CTL_ZERO_BYTES = 256 * KiB;
constexpr size_t WS_WINA = 256 * KiB;
constexpr size_t WS_WOUTA = WS_WINA + (size_t)NIN_A * DM * 2;
constexpr size_t WS_WINB = WS_WOUTA + (size_t)DM * DM * 2;
constexpr size_t WS_WOUTB = WS_WINB + (size_t)NIN_B * DM * 2;
constexpr size_t WS_SLAB = WS_WOUTB + (size_t)DM * DM * 2;
constexpr size_t ACT = (size_t)M * DM * 2;
constexpr size_t WS_XN = 18 * MiB;
constexpr size_t WS_QA = WS_XN + ACT;
constexpr size_t WS_GA = WS_QA + ACT, WS_KA = WS_GA + ACT, WS_VA = WS_KA + (size_t)M * 128 * 2;
constexpr size_t WS_QB = WS_GA;
constexpr size_t WS_KB = WS_QB + ACT, WS_VB = WS_KB + ACT, WS_GB = WS_VB + ACT;
constexpr size_t WS_CKA = WS_GB + ACT, WS_CVA = WS_CKA + (size_t)NB * 128 * 128 * 2, WS_CKB = WS_CVA + (size_t)NB * 128 * 128 * 2, WS_CVB = WS_CKB + (size_t)NB * 512 * 1024 * 2;
constexpr size_t WS_END = WS_CVB + (size_t)NB * 512 * 1024 * 2;
static_assert(WS_SLAB + (size_t)M * 16 * 4 <= WS_XN && WS_VA + (size_t)M * 128 * 2 <= WS_CKA && WS_QB >= WS_QA + ACT && WS_END <= 256 * MiB, "d_ws map");
constexpr int CW_KMAX_A = 64, CW_KMAX_B = 128;
constexpr int CW_BAR = 4096;
constexpr int RING_OFF = 0, RING_BYTES = 131072;
constexpr int PHASE_BYTES = 159744;
constexpr int LDSCTL_OFF = PHASE_BYTES, MISC_OFF = LDSCTL_OFF + 320;
constexpr int EPI_STG_OFF = RING_BYTES + 1024;
static_assert(EPI_STG_OFF + 1024 + 8 * 2304 <= PHASE_BYTES, "epilogue staging rows");
constexpr int LDS_BYTES = 163840;
constexpr int AT_NS = 4;
constexpr int AT_SLOT = 0, AT_SLOTB = 16384  , AT_TAB = AT_NS * AT_SLOTB, AT_TABB = 49152, AT_WSF = AT_TAB + AT_TABB, AT_OST = AT_WSF + NWAVES * 256, AT_END = AT_OST + NWAVES * 4096;
static_assert(AT_END <= PHASE_BYTES && MISC_OFF + 128 <= LDS_BYTES, "attention LDS map");

#ifndef PROBE_SEG
#define PROBE_SEG 0
#endif
#ifndef PROBE_LAYER
#define PROBE_LAYER 1
#endif
#if PROBE_SEG
#define KSEG_BEGIN(s) unsigned long long ks_t0_##s = 0; if (PROBE_SEG == (s)) ks_t0_##s = __builtin_amdgcn_s_memrealtime();
#define KSEG_END(s) if (PROBE_SEG == (s)) F.tacc += __builtin_amdgcn_s_memrealtime() - ks_t0_##s;
#define PSEG_BEGIN(s) unsigned long long ps_t0_##s = 0; if (PROBE_SEG == (s) && LAYER == PROBE_LAYER) ps_t0_##s = __builtin_amdgcn_s_memrealtime();
#define PSEG_END(s) if (PROBE_SEG == (s) && LAYER == PROBE_LAYER) F.tacc += __builtin_amdgcn_s_memrealtime() - ps_t0_##s;
#else
#define PSEG_BEGIN(s)
#define PSEG_END(s)
#define KSEG_BEGIN(s)
#define KSEG_END(s)
#endif
struct Frame {
    unsigned long long tacc;
    LAS unsigned char* lds;
    volatile LAS unsigned* MISC;
    gu32* ctl;
    int tid, lane, wave;
    int vcu, G;
};
struct Args { const float* in[19]; float* out; unsigned char* ws; };

__device__ __forceinline__ float wave_sum(float v) {
#pragma unroll
    for (int o = 1; o < 64; o <<= 1) v += __shfl_xor(v, o);
    return v;
}
__device__ __forceinline__ float wave_max(float v) {
#pragma unroll
    for (int o = 1; o < 64; o <<= 1) v = fmaxf(v, __shfl_xor(v, o));
    return v;
}
__device__ __forceinline__ int phys_col(int c) { return (c & ~255) | (((c >> 5) & 1) << 7) | (((c >> 6) & 3) << 5) | (c & 31); }

__device__ __forceinline__ void p0_transpose_item(const float* W, int K, int N, bf16* WT, bool permute, const float* gain, LAS float* scr, int item, int lane) {
    const int nblk = N / 32, kb = item / nblk, nb = item % nblk, k0 = 64 * kb, n0 = 32 * nb;
    const float* src = W + (size_t)(k0 + (lane >> 5)) * N + n0 + (lane & 31);
    float w[32];
#pragma unroll
    for (int i = 0; i < 32; ++i) w[i] = __builtin_nontemporal_load(src + (size_t)(2 * i) * N);
    if (gain) {
#pragma unroll
        for (int i = 0; i < 32; ++i) w[i] *= gain[k0 + 2 * i + (lane >> 5)]; }
#pragma unroll
    for (int i = 0; i < 32; ++i) scr[(2 * i + (lane >> 5)) * 33 + (lane & 31)] = w[i];
    LDS_WAIT(); asm volatile("" ::: "memory");
    const int c = lane & 7;
    const int r0 = permute ? phys_col(n0) : n0;
#pragma unroll
    for (int j = 0; j < 4; ++j) { const int n = (lane >> 3) + 8 * j; const LAS float* s = scr + (8 * c) * 33 + n;
        v4u o; o.x = pk2(s[0 * 33], s[1 * 33]); o.y = pk2(s[2 * 33], s[3 * 33]); o.z = pk2(s[4 * 33], s[5 * 33]); o.w = pk2(s[6 * 33], s[7 * 33]);
        *(GAS v4u*)(WT + (size_t)(r0 + n) * K + k0 + 8 * c) = o; }
    LDS_WAIT(); asm volatile("" ::: "memory");
}
struct Row4 { f32x4 v[4]; };
__device__ __forceinline__ void row_load(Row4& r, const float* p, int lane) {
#pragma unroll
    for (int j = 0; j < 4; ++j) r.v[j] = __builtin_nontemporal_load((const GAS f32x4*)p + lane + 64 * j); }
__device__ __forceinline__ void row_store_bf16(const Row4& r, bf16* o, int lane) {
#pragma unroll
    for (int j = 0; j < 4; ++j) ((GAS unsigned long long*)o)[lane + 64 * j] = (unsigned long long)pk2(r.v[j].x, r.v[j].y) | ((unsigned long long)pk2(r.v[j].z, r.v[j].w) << 32); }
__device__ __forceinline__ void row_store_f32(const Row4& r, float* o, int lane) {
#pragma unroll
    for (int j = 0; j < 4; ++j) __builtin_nontemporal_store(r.v[j], (GAS f32x4*)o + lane + 64 * j); }
__device__ __forceinline__ const float* x_row(const Args& a, int m) { return m < SEQ ? a.in[0] + (size_t)m * DM : a.in[1] + (size_t)(m - SEQ) * DM; }
__device__ __forceinline__ void rms_finish(Row4& r, const Row4& g, bf16* o, int lane) {
    float s = 0.f;
#pragma unroll
    for (int j = 0; j < 4; ++j) s += (r.v[j].x * r.v[j].x + r.v[j].y * r.v[j].y) + (r.v[j].z * r.v[j].z + r.v[j].w * r.v[j].w);
    const float rs = rsqrtf(wave_sum(s) * (1.f / DM) + EPS);
#pragma unroll
    for (int j = 0; j < 4; ++j) r.v[j] = r.v[j] * rs * g.v[j];
    row_store_bf16(r, o, lane);
}
__device__ __forceinline__ float row_maxnorm2(const Row4& r) {
    float qm = 0.f;
#pragma unroll
    for (int j = 0; j < 4; ++j) { float q = (r.v[j].x * r.v[j].x + r.v[j].y * r.v[j].y) + (r.v[j].z * r.v[j].z + r.v[j].w * r.v[j].w);
#pragma unroll
        for (int d = 1; d < 16; d <<= 1) q += __shfl_xor(q, d);
        qm = fmaxf(qm, q); }
    return qm;
}
__device__ __forceinline__ void cache_rows_a(const float* srck, const float* srcv, bf16* dbk, bf16* dbv, float* dok, float* dov, int row, gu32* kmax, int lane) {
    constexpr int L = 128, W = 128;
    const int b = row / L, j = row % L;
    const size_t so = (size_t)row * W, oo = ((size_t)b * L + (j - 64)) * W;
    const float k0 = srck[so + 2 * lane], k1 = srck[so + 2 * lane + 1], v0 = srcv[so + 2 * lane], v1 = srcv[so + 2 * lane + 1];
    ((GAS unsigned*)(dbk + so))[lane] = pk2(k0, k1); ((GAS unsigned*)(dbv + so))[lane] = pk2(v0, v1);
    if (j >= 64) { dok[oo + 2 * lane] = k0; dok[oo + 2 * lane + 1] = k1; dov[oo + 2 * lane] = v0; dov[oo + 2 * lane + 1] = v1; }
    float q = k0 * k0 + k1 * k1;
#pragma unroll
    for (int d = 1; d < 32; d <<= 1) q += __shfl_xor(q, d);
    q = fmaxf(q, __shfl_xor(q, 32));
    if (lane == 0) __hip_atomic_fetch_max(kmax, __float_as_uint(q), __ATOMIC_RELAXED, __HIP_MEMORY_SCOPE_AGENT);
}
__device__ __forceinline__ void p0_prologue(Frame& F, const Args& a) {
    LAS float* scr = (LAS float*)(F.lds + RING_OFF + F.wave * 16384);
    const int gw = F.vcu * NWAVES + F.wave, NGW = F.G * NWAVES, lane = F.lane;
    unsigned char* ws = a.ws;
    bf16* XN = (bf16*)(ws + WS_XN);
    {
        Row4 g, a0, a1, b0, b1; row_load(g, a.in[7], lane);
        const int S = NGW;
        int m = gw;
#define XLOAD(R0, R1, mm) do { if ((mm) < M) row_load(R0, x_row(a, (mm)), lane); if ((mm) + S < M) row_load(R1, x_row(a, (mm) + S), lane); } while (0)
#define XFIN(R0, R1, mm) do { if ((mm) < M) rms_finish(R0, g, XN + (size_t)(mm) * DM, lane); if ((mm) + S < M) rms_finish(R1, g, XN + (size_t)((mm) + S) * DM, lane); } while (0)
        XLOAD(a0, a1, m);
        for (; m < M; m += 4 * S) {
            XLOAD(b0, b1, m + 2 * S);
            XFIN(a0, a1, m);
            XLOAD(a0, a1, m + 4 * S);
            XFIN(b0, b1, m + 2 * S);
        }
#undef XLOAD
#undef XFIN
    }
    constexpr int I_INA = (DM / 64) * (NIN_A / 32);
    for (int it = gw; it < I_INA; it += NGW) p0_transpose_item(a.in[8], DM, NIN_A, (bf16*)(ws + WS_WINA), true, nullptr, scr, it, lane);
    for (int r = gw; r < NB * 128; r += NGW)
        cache_rows_a(a.in[2], a.in[3], (bf16*)(ws + WS_CKA), (bf16*)(ws + WS_CVA), a.out + O_KAS, a.out + O_VAS, r, F.ctl + CW_KMAX_A, lane);
}
__device__ __forceinline__ void side_weights(Frame& F, const Args& a, int w, int nw) {
    LAS float* scr = (LAS float*)(F.lds + RING_OFF + F.wave * 16384);
    unsigned char* ws = a.ws;
    constexpr int I_O = (DM / 64) * (DM / 32), I_INB = (DM / 64) * (NIN_B / 32);
    for (int it = w; it < I_O + I_INB + I_O; it += nw) {
        int r = it;
        if (r < I_O) { p0_transpose_item(a.in[12], DM, DM, (bf16*)(ws + WS_WOUTA), false, nullptr, scr, r, F.lane); continue; } r -= I_O;
        if (r < I_INB) { p0_transpose_item(a.in[14], DM, NIN_B, (bf16*)(ws + WS_WINB), true, a.in[13], scr, r, F.lane); continue; } r -= I_INB;
        p0_transpose_item(a.in[18], DM, DM, (bf16*)(ws + WS_WOUTB), false, nullptr, scr, r, F.lane);
    }
}
__device__ __forceinline__ void side_cache_b_conv(Frame& F, const Args& a, int w, int nw, int r_lo, int r_hi) {
    unsigned char* ws = a.ws; const int lane = F.lane;
    const float* srck = a.in[4]; const float* srcv = a.in[5];
    bf16* dbk = (bf16*)(ws + WS_CKB); bf16* dbv = (bf16*)(ws + WS_CVB); float* dok = a.out + O_KBS; float* dov = a.out + O_VBS;
    const int NR = r_hi;
    Row4 ka, va, kb, vb; float qm = 0.f;
#define CB_LOAD(K_, V_, r) do { row_load(K_, srck + (size_t)(r) * DM, lane); row_load(V_, srcv + (size_t)(r) * DM, lane); } while (0)
#define CB_FIN(K_, V_, r) do { const size_t so_ = (size_t)(r) * DM; row_store_bf16(K_, dbk + so_, lane); row_store_bf16(V_, dbv + so_, lane); \
        if (((r) & 511) >= 64) { const size_t oo_ = so_ - 64 * DM; row_store_f32(K_, dok + oo_, lane); row_store_f32(V_, dov + oo_, lane); }     \
        qm = fmaxf(qm, row_maxnorm2(K_)); } while (0)
    int r = r_lo + w;
    if (r < NR) CB_LOAD(ka, va, r);
    for (; r < NR; r += 2 * nw) {
        const int r1 = r + nw, r2 = r + 2 * nw;
        if (r1 < NR) CB_LOAD(kb, vb, r1);
        CB_FIN(ka, va, r);
        if (r2 < NR) CB_LOAD(ka, va, r2);
        if (r1 < NR) CB_FIN(kb, vb, r1);
    }
#undef CB_LOAD
#undef CB_FIN
    qm = wave_max(qm);
    if (lane == 0) __hip_atomic_fetch_max(F.ctl + CW_KMAX_B, __float_as_uint(qm), __ATOMIC_RELAXED, __HIP_MEMORY_SCOPE_AGENT);
}
__device__ __forceinline__ void side_cache_b_copy(Frame& F, const Args& a, int w, int nw, int r_lo, int r_hi) {
    const int lane = F.lane;
    const float* srck = a.in[4]; const float* srcv = a.in[5]; float* dok = a.out + O_KBS; float* dov = a.out + O_VBS;
    const int NR = r_hi;
    Row4 ka, va, kb, vb;
#define CP_SRC(r) ((size_t)((r) / 448) * 512 + 64 + (r) % 448)
#define CP_DST(r) ((size_t)((r) / 448) * 512 + (r) % 448)
#define CP_LOAD(K_, V_, r) do { const size_t so_ = CP_SRC(r) * DM; row_load(K_, srck + so_, lane); row_load(V_, srcv + so_, lane); } while (0)
#define CP_FIN(K_, V_, r) do { const size_t oo_ = CP_DST(r) * DM; row_store_f32(K_, dok + oo_, lane); row_store_f32(V_, dov + oo_, lane); } while (0)
    int r = r_lo + w;
    if (r < NR) CP_LOAD(ka, va, r);
    for (; r < NR; r += 2 * nw) {
        const int r1 = r + nw, r2 = r + 2 * nw;
        if (r1 < NR) CP_LOAD(kb, vb, r1);
        CP_FIN(ka, va, r);
        if (r2 < NR) CP_LOAD(ka, va, r2);
        if (r1 < NR) CP_FIN(kb, vb, r1);
    }
#undef CP_SRC
#undef CP_DST
#undef CP_LOAD
#undef CP_FIN
}
template <int LAYER> __device__ __forceinline__ void tail_outproj(LAS unsigned char* lds, const bf16* A, const bf16* Bt, int c, const float* xs, bf16* yb, float* slab, float* out) {
    int tid_ = threadIdx.x; asm volatile("" : "+v"(tid_));
    const int tid = tid_, lane = tid & 63, wid = __builtin_amdgcn_readfirstlane(tid >> 6), fr = lane & 15, fq = lane >> 4;
    const int rb = c >> 4, cb = c & 15, row0 = SEQ + 64 * rb, col0 = 64 * cb;
    const bf16* ap = A + (size_t)(row0 + fr) * DM + 128 * wid + 8 * fq;
    const bf16* bp = Bt + (size_t)(col0 + fr) * DM + 128 * wid + 8 * fq;
    bf16x8 af[4][4], bfr[4][4];
#pragma unroll
    for (int m = 0; m < 4; ++m)
#pragma unroll
        for (int ks = 0; ks < 4; ++ks) { af[m][ks] = *(const GAS bf16x8*)(ap + (size_t)(16 * m) * DM + 32 * ks); bfr[m][ks] = *(const GAS bf16x8*)(bp + (size_t)(16 * m) * DM + 32 * ks); }
    f32x4 acc[4][4];
#pragma unroll
    for (int m = 0; m < 4; ++m)
#pragma unroll
        for (int n = 0; n < 4; ++n) { acc[m][n] = (f32x4){0.f, 0.f, 0.f, 0.f};
#pragma unroll
            for (int ks = 0; ks < 4; ++ks) acc[m][n] = __builtin_amdgcn_mfma_f32_16x16x32_bf16(bfr[n][ks], af[m][ks], acc[m][n], 0, 0, 0); }
    constexpr int PS = 68;
    LAS float* part = (LAS float*)lds + wid * (64 * PS);
#pragma unroll
    for (int m = 0; m < 4; ++m)
#pragma unroll
        for (int n = 0; n < 4; ++n) *(LAS f32x4*)(part + (16 * m + fr) * PS + 16 * n + 4 * fq) = acc[m][n];
    __syncthreads();
    const int r = tid >> 3, c8 = (tid & 7) * 8;
    f32x4 s0 = (f32x4){0.f, 0.f, 0.f, 0.f}, s1 = s0;
#pragma unroll
    for (int w = 0; w < 8; ++w) { const LAS float* p = (const LAS float*)lds + w * (64 * PS) + r * PS + c8; s0 += *(const LAS f32x4*)p; s1 += *(const LAS f32x4*)(p + 4); }
    const int row = row0 + r;
    if (LAYER == 1) {
        const v4u w = *(const GAS v4u*)(yb + (size_t)row * DM + col0 + c8);
        const f32x4 r0 = {__uint_as_float(w.x << 16), __uint_as_float(w.x & 0xffff0000u), __uint_as_float(w.y << 16), __uint_as_float(w.y & 0xffff0000u)};
        const f32x4 r1 = {__uint_as_float(w.z << 16), __uint_as_float(w.z & 0xffff0000u), __uint_as_float(w.w << 16), __uint_as_float(w.w & 0xffff0000u)};
        float* op = out + (size_t)row * DM + col0 + c8;
        *(GAS f32x4*)op = s0 + r0; *(GAS f32x4*)(op + 4) = s1 + r1;
        __syncthreads();
        return;
    }
    const float* xp = xs + (size_t)(row - SEQ) * DM + col0 + c8;
    const f32x4 y0 = s0 + *(const GAS f32x4*)xp, y1 = s1 + *(const GAS f32x4*)(xp + 4);
    v4u wv; wv.x = pk2(y0[0], y0[1]); wv.y = pk2(y0[2], y0[3]); wv.z = pk2(y1[0], y1[1]); wv.w = pk2(y1[2], y1[3]);
    *(GAS v4u*)(yb + (size_t)row * DM + col0 + c8) = wv;
    float ss = ((y0[0] * y0[0] + y0[1] * y0[1]) + (y0[2] * y0[2] + y0[3] * y0[3])) + ((y1[0] * y1[0] + y1[1] * y1[1]) + (y1[2] * y1[2] + y1[3] * y1[3]));
    ss += __shfl_xor(ss, 1); ss += __shfl_xor(ss, 2); ss += __shfl_xor(ss, 4);
    if ((tid & 7) == 0) slab[(size_t)row * 16 + cb] = ss;
    __syncthreads();
}

namespace attn {
using bf16x8 = __attribute__((ext_vector_type(8))) short;
using s16x4 = __attribute__((ext_vector_type(4))) short;
using f32x16 = __attribute__((ext_vector_type(16))) float;
using u32x4 = pg8::u32x4;
typedef short v4i16_t __attribute__((ext_vector_type(4)));
typedef __attribute__((address_space(3))) const char* lds_cptr;
__device__ __forceinline__ int crow(int r, int hi) { return (r & 3) + 8 * (r >> 2) + 4 * hi; }
__device__ __forceinline__ s16x4 vtr(lds_cptr p) { return __builtin_bit_cast(s16x4, __builtin_amdgcn_ds_read_tr16_b64_v4i16((__attribute__((address_space(3))) v4i16_t*)p)); }
typedef float f32x2_t __attribute__((ext_vector_type(2))); typedef __bf16 bf16x2_t __attribute__((ext_vector_type(2)));
__device__ __forceinline__ unsigned cvtpk(float lo, float hi) { f32x2_t v = {lo, hi}; bf16x2_t b = __builtin_convertvector(v, bf16x2_t); return __builtin_bit_cast(unsigned, b); }
__device__ __forceinline__ int t5_bucket(int rel) {
    const int n = rel < 0 ? -rel : rel;
    int b = n;
    if (n >= 8) b = 8 + (n >= 12) + (n >= 16) + (n >= 23) + (n >= 32) + (n >= 46) + (n >= 64) + (n >= 91);
    return b + (rel > 0 ? 16 : 0);
}
__device__ __forceinline__ void glds16(const void* gsrc, unsigned lds_dst) { unsigned keep;
    asm volatile("s_mov_b32 %0, m0\n\ts_mov_b32 m0, %2\n\ts_nop 0\n\tglobal_load_lds_dwordx4 %1, off\n\ts_mov_b32 m0, %0" : "=&s"(keep) : "v"(gsrc), "s"(lds_dst) : "memory"); }
__device__ __forceinline__ float bf2f(unsigned short h) { return __uint_as_float((unsigned)h << 16); }

template <int LAYER>
__device__ __forceinline__ void attn_phase(Frame& F, const Args& a) {
    constexpr int P = LAYER == 0 ? 2 : 8;
    constexpr int KVW = LAYER == 0 ? 128 : 1024;
    constexpr int L = P * 64;
    constexpr int RT0 = LAYER == 0 ? 0 : 6;
    unsigned char* ws = a.ws;
    const bf16* Q = (const bf16*)(ws + (LAYER == 0 ? WS_QA : WS_QB));
    const bf16* Kg = (const bf16*)(ws + (LAYER == 0 ? WS_KA : WS_KB));
    const bf16* Vg = (const bf16*)(ws + (LAYER == 0 ? WS_VA : WS_VB));
    const bf16* Gt = (const bf16*)(ws + (LAYER == 0 ? WS_GA : WS_GB));
    const bf16* CK = (const bf16*)(ws + (LAYER == 0 ? WS_CKA : WS_CKB));
    const bf16* CV = (const bf16*)(ws + (LAYER == 0 ? WS_CVA : WS_CVB));
    bf16* O = (bf16*)(ws + WS_XN);
    const float* qg = a.in[LAYER == 0 ? 9 : 15]; const float* kg = a.in[LAYER == 0 ? 10 : 16];
    const float* table = a.in[LAYER == 0 ? 6 : 17];
    int tid_ = threadIdx.x; asm volatile("" : "+v"(tid_));
    const int tid = tid_, lane = tid & 63, wid = __builtin_amdgcn_readfirstlane(tid >> 6), r32 = lane & 31, hi = lane >> 5;
    const int h = F.vcu >> 4, sub = F.vcu & 15;
    const int kvh = LAYER == 0 ? (h >> 3) : h;
    LAS unsigned char* lds = F.lds + RING_OFF;
    const int cw = wid >> 1, half = wid & 1;
    const unsigned lds0 = (unsigned)(size_t)lds;
#define UNIT_PARAMS(ui_, X) const bool X##sample = (ui_) == 4; const int X##u0 = 4 * (4 * sub + (ui_)); const int X##nt = X##sample ? P + 1 : P + 4; \
        const int X##tb = X##sample ? 0 : (X##u0 >= P ? 0 : P - X##u0); const bool X##won = !X##sample || cw == 0; \
        const size_t X##qtok = X##sample ? (size_t)SEQ + 64 * sub + 32 * half : (size_t)64 * (X##u0 + cw) + 32 * half;
#define TILE_DMA_U(X, t, slot_) do { const bf16 *kb_, *vb_; \
            if (!X##sample) { const size_t r0_ = (size_t)64 * (X##u0 - P + (t)) * KVW; kb_ = Kg + r0_; vb_ = Vg + r0_; } \
            else if ((t) < P) { const size_t r0_ = ((size_t)sub * L + 64 * (t)) * KVW; kb_ = CK + r0_; vb_ = CV + r0_; } \
            else { const size_t r0_ = ((size_t)SEQ + 64 * sub) * KVW; kb_ = Kg + r0_; vb_ = Vg + r0_; } \
            const unsigned s_ = (unsigned)__builtin_amdgcn_readfirstlane(lds0 + AT_SLOT + ((slot_) & 3) * AT_SLOTB + wid * 1024); \
            glds16(kb_ + koff, s_); glds16(vb_ + voff, s_ + 8192); } while (0)
#define Q_DMA_U(X) do { if (X##won) { _Pragma("unroll") for (int i_ = 0; i_ < 4; ++i_) glds16(Q + (X##qtok + 8 * i_ + (lane >> 3)) * DM + h * 64 + (lane & 7) * 8, (unsigned)__builtin_amdgcn_readfirstlane(lds0 + AT_OST + wid * 4096 + i_ * 1024)); } } while (0)
#define WAIT_BAR(N) asm volatile("s_waitcnt vmcnt(" #N ") lgkmcnt(0)\n\ts_barrier" ::: "memory")
    const size_t koff = (size_t)lane * KVW + kvh * 64 + wid * 8, voff = (size_t)(16 * (wid & 3) + (lane >> 2)) * KVW + kvh * 64 + (wid >> 2) * 32 + (lane & 3) * 8;
    int sb = 0;
    {
        UNIT_PARAMS(0, f_)
        Q_DMA_U(f_); TILE_DMA_U(f_, f_tb, 0); TILE_DMA_U(f_, f_tb + 1, 1);
    }
    PSEG_BEGIN(1) PSEG_BEGIN(5)
    constexpr int NBR = LAYER == 0 ? 32 : 257;
    LAS float* brow = (LAS float*)(lds + AT_WSF);
    for (int i = tid; i < NBR; i += NWAVES * 64) brow[i] = LAYER == 0 ? table[i * 16 + h] : table[h * 257 + i];
    const float gqa = fabsf(qg[lane]), gka = fabsf(kg[lane]);
    const unsigned kcb = __hip_atomic_load(F.ctl + (LAYER == 0 ? CW_KMAX_A : CW_KMAX_B), __ATOMIC_RELAXED, __HIP_MEMORY_SCOPE_AGENT);
    const float sinkv = LAYER == 0 ? a.in[11][h] : 0.f;
    __syncthreads();
    float bm = -1e30f;
    for (int i = lane; i < NBR; i += 64) bm = fmaxf(bm, brow[i]);
    bm = wave_max(bm);
    const float gqm = wave_max(gqa), gkm = wave_max(gka), kc = sqrtf(__uint_as_float(kcb));
    const float bound = gqm * fmaxf(8.f * gkm, kc) * 1.01f + bm;
    const float cconst = LAYER == 0 ? 0.f : (brow[256 % NBR] - bound) * LOG2E;
    const float sinkp = LAYER == 0 ? __builtin_amdgcn_exp2f((sinkv - bound) * LOG2E) : 0.f;
    {
        LAS float* tab = (LAS float*)(lds + AT_TAB);
        for (int i = tid; i < 3 * 2 * 8 * 64 * 4; i += NWAVES * 64) {
            const int e = i & 3, ln = (i >> 2) & 63, q4 = (i >> 8) & 7, half = (i >> 11) & 1, rtv = i >> 12;
            const int R = 4 * q4 + e, key = 32 * (R >> 4) + crow(R & 15, ln >> 5), qi = 32 * half + (ln & 31), j = 64 * (RT0 + rtv) + key;
            float bv;
            if (LAYER == 0) bv = brow[t5_bucket(j - (P * 64 + qi))];
            else { int idx = P * 64 + qi - j; idx = idx < -128 ? -128 : (idx > 128 ? 128 : idx); bv = brow[(idx + 128) % NBR]; }
            tab[i] = (bv - bound) * LOG2E;
        }
    }
    __syncthreads();
    f32x16 cc16;
#pragma unroll
    for (int r = 0; r < 16; ++r) cc16[r] = cconst;
    asm volatile("" : "+v"(cc16));
    PSEG_END(5)
    const lds_cptr lds3 = (lds_cptr)lds;
    const lds_cptr kp0 = lds3 + AT_SLOT + hi * 1024 + r32 * 16;
    const lds_cptr vp0 = lds3 + AT_SLOT + 8192 + ((lane >> 4) & 1) * 32 + (lane & 3) * 8 + (4 * hi + ((lane & 15) >> 2)) * 64;
    const LAS f32x4* tabl = (const LAS f32x4*)(lds + AT_TAB) + lane;
    LAS float* wsf = (LAS float*)(lds + AT_WSF) + wid * 64;
    for (int ui = 0; ui < 5; ++ui) {
        PSEG_BEGIN(2)
        UNIT_PARAMS(ui, c_)
        const bool sample = c_sample, wave_on = c_won, has_next = ui < 4; const int nt = c_nt, t_begin = c_tb; const size_t qtok = c_qtok;
        UNIT_PARAMS(ui + 1, n_)
        f32x16 o[2]; o[0] = f32x16{}; o[1] = f32x16{};
        float l_reg = 0.f;
        if (ui == 0) WAIT_BAR(2); else WAIT_BAR(4);
        PSEG_END(2) PSEG_BEGIN(3)
        bf16x8 qr[4];
#pragma unroll
        for (int d0 = 0; d0 < 4; ++d0) qr[d0] = *(const __attribute__((address_space(3))) bf16x8*)(lds3 + AT_OST + wid * 4096 + r32 * 128 + (2 * d0 + hi) * 16);
        u32x4 pw[4];
#pragma unroll
        for (int s = 0; s < 4; ++s) pw[s] = (u32x4){0u, 0u, 0u, 0u};
        v4u gpre[4];
#pragma unroll
        for (int i = 0; i < 4; ++i) gpre[i] = (v4u){0u, 0u, 0u, 0u};
#define STEP_HEAD(t) const int sl = (t) - t_begin + sb;                    \
            if ((t) + 2 < nt) TILE_DMA_U(c_, (t) + 2, sl + 2);             \
            if ((t) == nt - 1) { \
                if (wave_on) { _Pragma("unroll") for (int i = 0; i < 4; ++i) gpre[i] = *(const GAS v4u*)(Gt + (qtok + i * 8 + (lane >> 3)) * DM + h * 64 + (lane & 7) * 8); } \
                asm volatile("" ::: "memory"); \
                if (has_next) { Q_DMA_U(n_); TILE_DMA_U(n_, n_tb, sl + 1); } }     \
            if ((t) == nt && has_next) TILE_DMA_U(n_, n_tb + 1, sl + 1);
#define STEP_TAIL(t) if ((t) + 2 < nt) WAIT_BAR(2); else if ((t) + 2 == nt || !has_next) WAIT_BAR(0); else WAIT_BAR(63);
        const int a_lo = wave_on ? (cw > t_begin ? cw : t_begin) : nt + 1, a_hi = wave_on ? (cw + P + 1 < nt ? cw + P + 1 : nt) : nt;
        int t = t_begin;
        for (; t < a_lo && t <= nt; ++t) { STEP_HEAD(t) STEP_TAIL(t) }
        for (; t <= a_hi; ++t) {
            STEP_HEAD(t)
            const int rt = t - cw;
            {
                const bool last = rt == P + 1 || t == nt, first = rt == 0 || t == t_begin;
                const int rtb = last ? rt - 1 : rt;
                const int ko = ((last ? sl - 1 : sl) & 3) * AT_SLOTB, vo = ((first ? sl : sl - 1) & 3) * AT_SLOTB;
                const lds_cptr kp = kp0 + ko, vp = vp0 + vo;
                bf16x8 kf[8];
#pragma unroll
                for (int d0 = 0; d0 < 4; ++d0) { kf[2 * d0] = *(const __attribute__((address_space(3))) bf16x8*)(kp + d0 * 2048); kf[2 * d0 + 1] = *(const __attribute__((address_space(3))) bf16x8*)(kp + d0 * 2048 + 512); }
                f32x16 p0, p1;
                __builtin_amdgcn_s_setprio(1);
                if (rtb >= RT0) { const LAS f32x4* tp = tabl + ((rtb - RT0) * 2 + half) * 8 * 64;
                    const f32x16 t0 = __builtin_shufflevector(__builtin_shufflevector(tp[0], tp[64], 0, 1, 2, 3, 4, 5, 6, 7), __builtin_shufflevector(tp[128], tp[192], 0, 1, 2, 3, 4, 5, 6, 7), 0, 1, 2, 3, 4, 5, 6, 7, 8, 9, 10, 11, 12, 13, 14, 15);
                    const f32x16 t1 = __builtin_shufflevector(__builtin_shufflevector(tp[256], tp[320], 0, 1, 2, 3, 4, 5, 6, 7), __builtin_shufflevector(tp[384], tp[448], 0, 1, 2, 3, 4, 5, 6, 7), 0, 1, 2, 3, 4, 5, 6, 7, 8, 9, 10, 11, 12, 13, 14, 15);
                    p0 = __builtin_amdgcn_mfma_f32_32x32x16_bf16(kf[0], qr[0], t0, 0, 0, 0); p1 = __builtin_amdgcn_mfma_f32_32x32x16_bf16(kf[1], qr[0], t1, 0, 0, 0); }
                else { p0 = __builtin_amdgcn_mfma_f32_32x32x16_bf16(kf[0], qr[0], cc16, 0, 0, 0); p1 = __builtin_amdgcn_mfma_f32_32x32x16_bf16(kf[1], qr[0], cc16, 0, 0, 0); }
#pragma unroll
                for (int d0 = 1; d0 < 4; ++d0) { p0 = __builtin_amdgcn_mfma_f32_32x32x16_bf16(kf[2 * d0], qr[d0], p0, 0, 0, 0); p1 = __builtin_amdgcn_mfma_f32_32x32x16_bf16(kf[2 * d0 + 1], qr[d0], p1, 0, 0, 0); }
                bf16x8 vf[8];
#pragma unroll
                for (int i = 0; i < 8; ++i) { const s16x4 lo = vtr(vp + (i >> 2) * 4096 + (i & 3) * 1024), hh = vtr(vp + (i >> 2) * 4096 + (i & 3) * 1024 + 512); vf[i] = (bf16x8){lo[0], lo[1], lo[2], lo[3], hh[0], hh[1], hh[2], hh[3]}; }
#pragma unroll
                for (int ks = 0; ks < 4; ++ks) { o[0] = __builtin_amdgcn_mfma_f32_32x32x16_bf16(__builtin_bit_cast(bf16x8, pw[ks]), vf[ks], o[0], 0, 0, 0); o[1] = __builtin_amdgcn_mfma_f32_32x32x16_bf16(__builtin_bit_cast(bf16x8, pw[ks]), vf[4 + ks], o[1], 0, 0, 0); }
                __builtin_amdgcn_s_setprio(0);
                float sacc = 0.f;
#pragma unroll
                for (int r = 0; r < 16; ++r) { p0[r] = __builtin_amdgcn_exp2f(p0[r]); p1[r] = __builtin_amdgcn_exp2f(p1[r]); sacc += p0[r] + p1[r]; }
                l_reg += last ? 0.f : sacc;
#pragma unroll
                for (int s = 0; s < 2; ++s)
#pragma unroll
                    for (int i = 0; i < 4; ++i) { pw[s][i] = cvtpk(p0[8 * s + 2 * i], p0[8 * s + 2 * i + 1]); pw[2 + s][i] = cvtpk(p1[8 * s + 2 * i], p1[8 * s + 2 * i + 1]); }
            }
            STEP_TAIL(t)
        }
        for (; t <= nt; ++t) { STEP_HEAD(t) STEP_TAIL(t) }
#undef STEP_HEAD
#undef STEP_TAIL
        PSEG_END(3) PSEG_BEGIN(4)
#undef TILE_DMA
#undef WAIT_BAR
        if (wave_on) {
            l_reg += __shfl_xor(l_reg, 32);
            l_reg += sinkp;
            if (hi == 0) wsf[r32] = l_reg;
            LDS_WAIT(); asm volatile("" ::: "memory");
            LAS unsigned short* stg = (LAS unsigned short*)(lds + AT_SLOT + (((nt - 2 - t_begin + sb) + (wid >> 2)) & 3) * AT_SLOTB + (wid & 3) * 4096);
#pragma unroll
            for (int r = 0; r < 16; ++r) { const int orow = crow(r, hi); const float rl = __builtin_amdgcn_rcpf(wsf[orow]);
#pragma unroll
                for (int d0 = 0; d0 < 2; ++d0) stg[orow * 64 + d0 * 32 + r32] = (unsigned short)(f2bf(o[d0][r] * rl)); }
            LDS_WAIT(); asm volatile("" ::: "memory");
#pragma unroll
            for (int i = 0; i < 4; ++i) { const int row = i * 8 + (lane >> 3), ch = lane & 7;
                const v4u ov = *(const LAS v4u*)(stg + row * 64 + ch * 8);
                const size_t go = (qtok + row) * DM + h * 64 + ch * 8;
                const v4u gvv = gpre[i];
                v4u res;
#pragma unroll
                for (int e = 0; e < 4; ++e) { const float a0 = __uint_as_float(ov[e] << 16) * __uint_as_float(gvv[e] << 16), a1 = __uint_as_float(ov[e] & 0xffff0000u) * __uint_as_float(gvv[e] & 0xffff0000u); res[e] = cvtpk(a0, a1); }
                *(GAS v4u*)(O + go) = res; }
        }
        sb += nt - t_begin;
        PSEG_END(4)
    }
    __syncthreads();
    PSEG_END(1)
}
template <int NV> __device__ __forceinline__ void wait_bar_n(int n) {
#define WB_(N) case N: asm volatile("s_waitcnt vmcnt(" #N ") lgkmcnt(0)\n\ts_barrier" ::: "memory"); break;
    switch (n) { WB_(0) WB_(2) WB_(4) WB_(6) WB_(8) WB_(10) WB_(12) WB_(14) WB_(16) WB_(18) WB_(20) WB_(22) WB_(24) WB_(26) WB_(28) default: asm volatile("s_waitcnt vmcnt(0) lgkmcnt(0)\n\ts_barrier" ::: "memory"); break; }
#undef WB_
}
__device__ __forceinline__ void attn_phase_a(Frame& F, const Args& a) {
    constexpr int P = 2, KVW = 128, NCH = 272, NSL = 5, SLOTB = 16384;
    constexpr int A2_RING = 0, A2_TT = NSL * SLOTB, A2_WSF = A2_TT + 8192, A2_Q = A2_WSF + 3072, A2_OST = A2_Q + NWAVES * 4096, A2_END = A2_OST + NWAVES * 4096;
    static_assert(A2_Q % 1024 == 0 && A2_END <= PHASE_BYTES, "layer A attention LDS map");
    unsigned char* ws = a.ws;
    const bf16* Q = (const bf16*)(ws + WS_QA); const bf16* Kg = (const bf16*)(ws + WS_KA); const bf16* Vg = (const bf16*)(ws + WS_VA); const bf16* Gt = (const bf16*)(ws + WS_GA);
    const bf16* CK = (const bf16*)(ws + WS_CKA); const bf16* CV = (const bf16*)(ws + WS_CVA);
    bf16* O = (bf16*)(ws + WS_XN);
    const float* qg = a.in[9]; const float* kg = a.in[10]; const float* table = a.in[6];
    int tid_ = threadIdx.x; asm volatile("" : "+v"(tid_));
    const int tid = tid_, lane = tid & 63, wid = __builtin_amdgcn_readfirstlane(tid >> 6), r32 = lane & 31, hi = lane >> 5;
    const int combo = F.vcu >> 6, g = combo >> 1, half = combo & 1, cidx = F.vcu & 63;
    const int c_lo = (cidx * NCH) >> 6, c_hi = ((cidx + 1) * NCH) >> 6;
    const int h = 8 * g + wid;
    LAS unsigned char* lds = F.lds + RING_OFF;
    const unsigned lds0 = (unsigned)(size_t)lds;
    const lds_cptr lds3 = (lds_cptr)lds;
    const int cp_hi = c_hi < 256 ? c_hi : 256;
    const int a0 = c_lo >= 2 ? c_lo - 2 : 0;
    const int npt = c_lo < 256 ? (cp_hi - 1) - a0 + 1 : 0;
    const int cs_lo = c_lo > 256 ? c_lo : 256;
#define T0_OF(c) (((c) < 2) ? 2 - (c) : 0)
#define POS_OF(c, ti) ((c) < 256 ? ((c) - 2 + (ti)) - a0 : npt + 3 * ((c) - cs_lo) + (ti))
#define NEW_OF(c, ti) ((c) >= 256 || (c) == c_lo || (ti) == 2)
#define QTOK_OF(c) ((c) < 256 ? (size_t)64 * (c) + 32 * half : (size_t)SEQ + 64 * ((c) - 256) + 32 * half)
    const size_t koff = (size_t)lane * KVW + g * 64 + wid * 8, voff = (size_t)(16 * (wid & 3) + (lane >> 2)) * KVW + g * 64 + (wid >> 2) * 32 + (lane & 3) * 8;
#define TILE_DMA_A(c, ti) do { const bf16 *kb_, *vb_; \
        if ((c) < 256) { const size_t r0_ = (size_t)64 * ((c) - 2 + (ti)) * KVW; kb_ = Kg + r0_; vb_ = Vg + r0_; } \
        else if ((ti) < 2) { const size_t r0_ = ((size_t)((c) - 256) * 128 + 64 * (ti)) * KVW; kb_ = CK + r0_; vb_ = CV + r0_; } \
        else { const size_t r0_ = ((size_t)SEQ + 64 * ((c) - 256)) * KVW; kb_ = Kg + r0_; vb_ = Vg + r0_; } \
        const unsigned s_ = (unsigned)__builtin_amdgcn_readfirstlane(lds0 + A2_RING + (POS_OF(c, ti) % NSL) * SLOTB + wid * 1024); \
        glds16(kb_ + koff, s_); glds16(vb_ + voff, s_ + 8192); } while (0)
#define Q_DMA_A(c) do { const size_t qt_ = QTOK_OF(c); _Pragma("unroll") for (int i_ = 0; i_ < 4; ++i_) glds16(Q + (qt_ + 8 * i_ + (lane >> 3)) * DM + h * 64 + (lane & 7) * 8, (unsigned)__builtin_amdgcn_readfirstlane(lds0 + A2_Q + wid * 4096 + i_ * 1024)); } while (0)
#define STEP_NEXT(c, ti) do { if ((ti) < 2) ++(ti); else { ++(c); (ti) = T0_OF(c); } } while (0)
    int c3 = c_lo, t3 = T0_OF(c_lo);
    Q_DMA_A(c_lo);
#pragma unroll 1
    for (int k = 0; k < 3; ++k) { if (c3 < c_hi) { if (NEW_OF(c3, t3)) TILE_DMA_A(c3, t3); STEP_NEXT(c3, t3); } }
    const float gqm = wave_max(fabsf(qg[lane])), gkm = wave_max(fabsf(kg[lane]));
    const float kc = sqrtf(__uint_as_float(__hip_atomic_load(F.ctl + CW_KMAX_A, __ATOMIC_RELAXED, __HIP_MEMORY_SCOPE_AGENT)));
    const float bm = wave_max(lane < 32 ? table[lane * 16 + h] : -1e30f);
    const float bound = gqm * fmaxf(8.f * gkm, kc) * 1.01f + bm;
    const float sinkp = __builtin_amdgcn_exp2f((a.in[11][h] - bound) * LOG2E);
    LAS float* TTw = (LAS float*)(lds + A2_TT) + wid * 256;
    for (int i = lane; i < 255; i += 64) TTw[i] = (table[t5_bucket(i - 191) * 16 + h] - bound) * LOG2E;
    const LAS float* tql = TTw + (63 - 32 * half - r32 + 4 * hi);
    const lds_cptr kp0 = lds3 + A2_RING + hi * 1024 + r32 * 16;
    const lds_cptr vp0 = lds3 + A2_RING + 8192 + ((lane >> 4) & 1) * 32 + (lane & 3) * 8 + (4 * hi + ((lane & 15) >> 2)) * 64;
    LAS float* wsf = (LAS float*)(lds + A2_WSF) + wid * 64;
    asm volatile("s_waitcnt vmcnt(0) lgkmcnt(0)\n\ts_barrier" ::: "memory");
    f32x16 o[2]; o[0] = f32x16{}; o[1] = f32x16{};
    float l_reg = 0.f;
    u32x4 pw[4];
#pragma unroll
    for (int s = 0; s < 4; ++s) pw[s] = (u32x4){0u, 0u, 0u, 0u};
    bf16x8 qr[4];
    v4u gpre[4];
    { const size_t qt0 = QTOK_OF(c_lo);
#pragma unroll
      for (int i = 0; i < 4; ++i) gpre[i] = *(const GAS v4u*)(Gt + (qt0 + i * 8 + (lane >> 3)) * DM + h * 64 + (lane & 7) * 8); }
    int c = c_lo, ti = T0_OF(c_lo);
    int pc = -1, pv_pos = 0;
    bool p_last = false;
    int ops_prev = 4;
    for (;;) {
        const bool qk_on = c < c_hi;
        int ops = 0;
        if (qk_on && ti == T0_OF(c)) {
#pragma unroll
            for (int d0 = 0; d0 < 4; ++d0) qr[d0] = *(const __attribute__((address_space(3))) bf16x8*)(lds3 + A2_Q + wid * 4096 + r32 * 128 + (2 * d0 + hi) * 16);
        }
        f32x16 p0, p1;
        {
            const int pos = qk_on ? POS_OF(c, ti) : pv_pos;
            const int tq = qk_on ? ti : 2;
            const lds_cptr kp = kp0 + (pos % NSL) * SLOTB, vp = vp0 + ((pc >= 0 ? pv_pos : pos) % NSL) * SLOTB;
            bf16x8 kf[8];
#pragma unroll
            for (int d0 = 0; d0 < 4; ++d0) { kf[2 * d0] = *(const __attribute__((address_space(3))) bf16x8*)(kp + d0 * 2048); kf[2 * d0 + 1] = *(const __attribute__((address_space(3))) bf16x8*)(kp + d0 * 2048 + 512); }
            const LAS float* tq_ = tql + 64 * tq;
#pragma unroll
            for (int r = 0; r < 16; ++r) { p0[r] = tq_[(r & 3) + 8 * (r >> 2)]; p1[r] = tq_[32 + (r & 3) + 8 * (r >> 2)]; }
            __builtin_amdgcn_s_setprio(1);
#pragma unroll
            for (int d0 = 0; d0 < 4; ++d0) { p0 = __builtin_amdgcn_mfma_f32_32x32x16_bf16(kf[2 * d0], qr[d0], p0, 0, 0, 0); p1 = __builtin_amdgcn_mfma_f32_32x32x16_bf16(kf[2 * d0 + 1], qr[d0], p1, 0, 0, 0); }
            bf16x8 vf[8];
#pragma unroll
            for (int i = 0; i < 8; ++i) { const s16x4 lo = vtr(vp + (i >> 2) * 4096 + (i & 3) * 1024), hh = vtr(vp + (i >> 2) * 4096 + (i & 3) * 1024 + 512); vf[i] = (bf16x8){lo[0], lo[1], lo[2], lo[3], hh[0], hh[1], hh[2], hh[3]}; }
#pragma unroll
            for (int ks = 0; ks < 4; ++ks) { o[0] = __builtin_amdgcn_mfma_f32_32x32x16_bf16(__builtin_bit_cast(bf16x8, pw[ks]), vf[ks], o[0], 0, 0, 0); o[1] = __builtin_amdgcn_mfma_f32_32x32x16_bf16(__builtin_bit_cast(bf16x8, pw[ks]), vf[4 + ks], o[1], 0, 0, 0); }
            __builtin_amdgcn_s_setprio(0);
        }
        if (p_last) {
            l_reg += __shfl_xor(l_reg, 32);
            l_reg += sinkp;
            if (hi == 0) wsf[r32] = l_reg;
            LDS_WAIT(); asm volatile("" ::: "memory");
            LAS unsigned short* stg = (LAS unsigned short*)(lds + A2_OST) + wid * 2048;
#pragma unroll
            for (int r = 0; r < 16; ++r) { const int orow = crow(r, hi); const float rl = __builtin_amdgcn_rcpf(wsf[orow]);
#pragma unroll
                for (int d0 = 0; d0 < 2; ++d0) stg[orow * 64 + d0 * 32 + r32] = (unsigned short)(f2bf(o[d0][r] * rl)); }
            LDS_WAIT(); asm volatile("" ::: "memory");
            const size_t qtok = QTOK_OF(pc);
#pragma unroll
            for (int i = 0; i < 4; ++i) { const int row = i * 8 + (lane >> 3), ch = lane & 7;
                const v4u ov = *(const LAS v4u*)(stg + row * 64 + ch * 8);
                const v4u gvv = gpre[i];
                v4u res;
#pragma unroll
                for (int e = 0; e < 4; ++e) { const float a0_ = __uint_as_float(ov[e] << 16) * __uint_as_float(gvv[e] << 16), a1_ = __uint_as_float(ov[e] & 0xffff0000u) * __uint_as_float(gvv[e] & 0xffff0000u); res[e] = cvtpk(a0_, a1_); }
                *(GAS v4u*)(O + (qtok + row) * DM + h * 64 + ch * 8) = res; }
            ops += 4;
            o[0] = f32x16{}; o[1] = f32x16{}; l_reg = 0.f;
            if (qk_on) {
                const size_t qt2 = QTOK_OF(c);
#pragma unroll
                for (int i = 0; i < 4; ++i) gpre[i] = *(const GAS v4u*)(Gt + (qt2 + i * 8 + (lane >> 3)) * DM + h * 64 + (lane & 7) * 8);
                ops += 4; }
        }
        if (!qk_on) break;
        if (c3 < c_hi) { if (NEW_OF(c3, t3)) { TILE_DMA_A(c3, t3); ops += 2; } STEP_NEXT(c3, t3); }
        if (ti == T0_OF(c) && c + 1 < c_hi) { asm volatile("s_waitcnt lgkmcnt(0)" ::: "memory"); Q_DMA_A(c + 1); ops += 4; }
        {
            float sacc = 0.f;
#pragma unroll
            for (int r = 0; r < 16; ++r) { p0[r] = __builtin_amdgcn_exp2f(p0[r]); p1[r] = __builtin_amdgcn_exp2f(p1[r]); sacc += p0[r] + p1[r]; }
            l_reg += sacc;
#pragma unroll
            for (int s = 0; s < 2; ++s)
#pragma unroll
                for (int i = 0; i < 4; ++i) { pw[s][i] = cvtpk(p0[8 * s + 2 * i], p0[8 * s + 2 * i + 1]); pw[2 + s][i] = cvtpk(p1[8 * s + 2 * i], p1[8 * s + 2 * i + 1]); }
        }
        const bool short_chunk = T0_OF(c) != 0;
        wait_bar_n<0>(short_chunk ? 0 : ops + ops_prev);
        ops_prev = ops;
        pc = c; pv_pos = POS_OF(c, ti); p_last = ti == 2;
        STEP_NEXT(c, ti);
    }
    asm volatile("s_waitcnt vmcnt(0) lgkmcnt(0)\n\ts_barrier" ::: "memory");
#undef T0_OF
#undef POS_OF
#undef NEW_OF
#undef QTOK_OF
#undef TILE_DMA_A
#undef Q_DMA_A
#undef STEP_NEXT
}
}

__global__ void __launch_bounds__(NWAVES * 64, 2) mk_fwd(Args args) {
    extern __shared__ __attribute__((aligned(16))) unsigned char lds[];
    Frame F; F.tacc = 0;
    F.lds = (LAS unsigned char*)lds;
    F.MISC = (volatile LAS unsigned*)(F.lds + MISC_OFF);
    F.tid = threadIdx.x; F.lane = F.tid & 63; F.wave = __builtin_amdgcn_readfirstlane(F.tid >> 6);
    F.G = gridDim.x; { const int bx = blockIdx.x; F.vcu = (F.G % 8 == 0) ? (bx % 8) * (F.G / 8) + bx / 8 : bx; }
    unsigned char* ws = args.ws;
    F.ctl = (gu32*)(ws + WS_CTL);
    for (int u = F.tid; u < (LDS_BYTES - LDSCTL_OFF) / 4; u += NWAVES * 64) ((LAS unsigned*)(F.lds + LDSCTL_OFF))[u] = 0u;
    __syncthreads();
    XcdBarrier bar = xcd_barrier_post((unsigned*)(F.ctl + CW_BAR), F.MISC + 8);
    bf16* XN = (bf16*)(ws + WS_XN);
    float* slab = (float*)(ws + WS_SLAB);
    float* out = args.out;

#ifndef DUP_PHASE
#define DUP_PHASE -1
#endif
#define REPS_ON(k) int nrep_##k = 2; asm volatile("" : "+s"(nrep_##k)); for (int rep_ = 0; rep_ < nrep_##k; ++rep_)
#define REPS_OFF(k)
#define REPS_SEL(k) REPS_SEL2(k, DUP_PHASE)
#define REPS(k) REPS_##k
#if DUP_PHASE == 0
#define REPS_0 REPS_ON(0)
#else
#define REPS_0
#endif
#if DUP_PHASE == 1
#define REPS_1 REPS_ON(1)
#else
#define REPS_1
#endif
#if DUP_PHASE == 2
#define REPS_2 REPS_ON(2)
#else
#define REPS_2
#endif
#if DUP_PHASE == 3
#define REPS_3 REPS_ON(3)
#else
#define REPS_3
#endif
#if DUP_PHASE == 4
#define REPS_4 REPS_ON(4)
#else
#define REPS_4
#endif
#if DUP_PHASE == 5
#define REPS_5 REPS_ON(5)
#else
#define REPS_5
#endif
#if DUP_PHASE == 6
#define REPS_6 REPS_ON(6)
#else
#define REPS_6
#endif
    KSEG_BEGIN(10) REPS(0) { p0_prologue(F, args);
    xcd_barrier(bar); } KSEG_END(10)
    KSEG_BEGIN(11) REPS(1) {
        pg8::Gemm g{XN, (const bf16*)(ws + WS_WINA), M, NIN_A, DM}; pg8::StaticOrder S; S.init(M, NIN_A, F.G, (int)blockIdx.x, WGM_P1);
        pg8::EpiIn E{0, (bf16*)(ws + WS_QA), (bf16*)(ws + WS_KA), (bf16*)(ws + WS_VA), (bf16*)(ws + WS_GA), 128, args.in[9], args.in[10], nullptr,
                     out + O_KAP, out + O_VAP, out + O_KAS, out + O_VAS, 128, 2, C2, F.lds + EPI_STG_OFF};
        pg8::gemm_phase<pg8::EpiIn, pg8::StaticOrder, true, true>(F.lds + RING_OFF, g, S, E, PROBE_SEG == 31 ? &F.tacc : nullptr);
        { const int busy = (M / 256) * (NIN_A / 256) - 2 * F.G;
          if ((int)blockIdx.x >= busy && F.wave < 4) { side_weights(F, args, ((int)blockIdx.x - busy) * 4 + F.wave, (F.G - busy) * 4);
              side_cache_b_conv(F, args, ((int)blockIdx.x - busy) * 4 + F.wave, (F.G - busy) * 4, 0, NB * 256); } }
    xcd_barrier(bar); } KSEG_END(11)
    KSEG_BEGIN(12) REPS(2) { attn::attn_phase_a(F, args);
    xcd_barrier(bar); } KSEG_END(12)
    KSEG_BEGIN(13) REPS(3) {
        pg8::Gemm g{XN, (const bf16*)(ws + WS_WOUTA), SEQ, DM, DM}; pg8::StaticOrder S; S.init(SEQ, DM, F.G, (int)blockIdx.x);
        pg8::EpiOut E{0, args.in[0], args.in[1], (bf16*)(ws + WS_QA), nullptr, slab};
        KSEG_BEGIN(20) pg8::gemm_phase<pg8::EpiOut, pg8::StaticOrder, true, true>(F.lds + RING_OFF, g, S, E); KSEG_END(20)
        KSEG_BEGIN(21)
        tail_outproj<0>(F.lds + RING_OFF, XN, (const bf16*)(ws + WS_WOUTA), (int)blockIdx.x, args.in[1], (bf16*)(ws + WS_QA), slab, nullptr);
        KSEG_END(21)
    xcd_barrier(bar); } KSEG_END(13)
    KSEG_BEGIN(14) REPS(4) {
        pg8::Gemm g{(const bf16*)(ws + WS_QA), (const bf16*)(ws + WS_WINB), M, NIN_B, DM}; pg8::StaticOrder S; S.init(M, NIN_B, F.G, (int)blockIdx.x, WGM_P4);
        pg8::EpiIn E{1, (bf16*)(ws + WS_QB), (bf16*)(ws + WS_KB), (bf16*)(ws + WS_VB), (bf16*)(ws + WS_GB), 1024, args.in[15], args.in[16], slab,
                     out + O_KBP, out + O_VBP, out + O_KBS, out + O_VBS, 512, 16, C2, F.lds + EPI_STG_OFF};
        pg8::gemm_phase<pg8::EpiIn, pg8::StaticOrder, true, true>(F.lds + RING_OFF, g, S, E, PROBE_SEG == 30 ? &F.tacc : nullptr);
        { const int busy = (M / 256) * (NIN_B / 256) - 4 * F.G;
          if ((int)blockIdx.x >= busy && F.wave < 2) side_cache_b_conv(F, args, ((int)blockIdx.x - busy) * 2 + F.wave, (F.G - busy) * 2, NB * 256, NB * 512); }
    xcd_barrier(bar); } KSEG_END(14)
    KSEG_BEGIN(15) REPS(5) { attn::attn_phase<1>(F, args);
    xcd_barrier(bar); } KSEG_END(15)
    KSEG_BEGIN(16) REPS(6) {
        pg8::Gemm g{XN, (const bf16*)(ws + WS_WOUTB), SEQ, DM, DM}; pg8::StaticOrder S; S.init(SEQ, DM, F.G, (int)blockIdx.x);
        pg8::EpiOut E{1, nullptr, nullptr, (bf16*)(ws + WS_QA), out + O_Y, nullptr};
        pg8::gemm_phase<pg8::EpiOut, pg8::StaticOrder, true, true>(F.lds + RING_OFF, g, S, E);
        tail_outproj<1>(F.lds + RING_OFF, XN, (const bf16*)(ws + WS_WOUTB), (int)blockIdx.x, nullptr, (bf16*)(ws + WS_QA), nullptr, out + O_Y);
    }
    KSEG_END(16)
#if PROBE_SEG
    if (blockIdx.x == 0) {
        const unsigned long long t0 = __builtin_amdgcn_s_memrealtime(), dt = 8ull * (unsigned long long)__builtin_amdgcn_readfirstlane((unsigned)F.tacc);
        while (__builtin_amdgcn_s_memrealtime() - t0 < dt) __builtin_amdgcn_s_sleep(32);
    }
#endif
}
extern "C" void kernel_launch(void* const* d_in, const int* in_sizes, int n_in, void* d_out, int out_size, void* d_ws, size_t ws_size, hipStream_t stream) {
    static int grid = 0;
    if (grid == 0) {
        if (n_in != 19 || out_size != (int)O_END || ws_size < WS_END) { fprintf(stderr, "kernel_launch: unexpected shapes (n_in %d, out %d, ws %zu)\n", n_in, out_size, ws_size); grid = -1; return; }
        int dev = 0, cus = 0, per_cu = 0;
        if (hipGetDevice(&dev) != hipSuccess || hipDeviceGetAttribute(&cus, hipDeviceAttributeMultiprocessorCount, dev) != hipSuccess) { grid = -1; return; }
        if (hipFuncSetAttribute((const void*)mk_fwd, hipFuncAttributeMaxDynamicSharedMemorySize, LDS_BYTES) != hipSuccess) { fprintf(stderr, "kernel_launch: hipFuncSetAttribute failed\n"); grid = -1; return; }
        if (hipOccupancyMaxActiveBlocksPerMultiprocessor(&per_cu, (const void*)mk_fwd, NWAVES * 64, LDS_BYTES) != hipSuccess || per_cu < 1) { fprintf(stderr, "kernel_launch: occupancy query says %d blocks per CU\n", per_cu); }
        (void)hipGetLastError();
        grid = cus;
        if (grid != 256) { fprintf(stderr, "kernel_launch: built for 256 CUs, found %d\n", cus); grid = -1; return; }
    }
    if (grid < 0) return;
    (void)hipMemsetAsync((char*)d_ws + WS_CTL, 0, CTL_ZERO_BYTES, stream);
    Args a{};
    for (int i = 0; i < 19; ++i) a.in[i] = (const float*)d_in[i];
    a.out = (float*)d_out; a.ws = (unsigned char*)d_ws;
    hipLaunchKernelGGL(mk_fwd, dim3(grid), dim3(NWAVES * 64), LDS_BYTES, stream, a);
}
```
